# Optimizing an MI355X kernel written in HIP

```python
import math
import jax
import jax.numpy as jnp
from jax import lax
import numpy as np

D_MODEL = 2048
BATCH = 2
SEQ = 8192
DEPTH = 2
DEC_BATCH = 16
DEC_SEQ = 16
PAST_LEN = 4096

CHUNK = 64
N_META = 16
MIX_WIDTH = D_MODEL
LRU_WIDTH = MIX_WIDTH // 2
LRU_BLOCKS = 16
LRU_BLOCK = LRU_WIDTH // LRU_BLOCKS
LRU_C = 8.0
CONV_W = 4
GDN_HEADS = 8
GDN_DK = 128
GDN_DV = (MIX_WIDTH - LRU_WIDTH) // GDN_HEADS
GDN_QK = GDN_HEADS * GDN_DK
GDN_VW = GDN_HEADS * GDN_DV
GDN_QKV = 2 * GDN_QK + GDN_VW
N_IN = 2 * LRU_WIDTH + GDN_QKV + GDN_VW + 2 * GDN_HEADS
D_FF = 5632
EPS = 1e-6

kernel_name = 'hymba_rglru_gdn_macaron_stream_step'


def rms_norm(x, w):
    xf = x.astype(jnp.float32)
    y = xf * lax.rsqrt(jnp.mean(xf * xf, axis=-1, keepdims=True) + EPS)
    return (y * w.astype(jnp.float32)).astype(x.dtype)


def l2_normalize(x):
    return x * lax.rsqrt(jnp.sum(x * x, axis=-1, keepdims=True) + EPS)


def swiglu(h, w_gate, w_up, w_down):
    return (jax.nn.silu(h @ w_gate) * (h @ w_up)) @ w_down


def causal_conv(x, hist, w, b):
    t = x.shape[1]
    xp = jnp.concatenate([hist.astype(x.dtype), x], axis=1)
    y = xp[:, 0:t] * w[0]
    for i in range(1, CONV_W):
        y = y + xp[:, i:i + t] * w[i]
    if b is not None:
        y = y + b
    return y, xp[:, xp.shape[1] - (CONV_W - 1):]


def _lin_combine(earlier, later):
    a1, b1 = earlier
    a2, b2 = later
    return a1 * a2, a2 * b1 + b2


def rg_lru(x, rg_w, rg_b, ig_w, ig_b, lam, h0):
    bsz, t, _ = x.shape
    xf = x.astype(jnp.float32)
    xb = xf.reshape(bsz, t, LRU_BLOCKS, LRU_BLOCK)
    r = jax.nn.sigmoid(jnp.einsum('btni,nij->btnj', xb, rg_w.astype(jnp.float32)).reshape(bsz, t, LRU_WIDTH) + rg_b.astype(jnp.float32))
    ig = jax.nn.sigmoid(jnp.einsum('btni,nij->btnj', xb, ig_w.astype(jnp.float32)).reshape(bsz, t, LRU_WIDTH) + ig_b.astype(jnp.float32))
    log_a = -LRU_C * r * jax.nn.softplus(-lam.astype(jnp.float32))
    a = jnp.exp(log_a)
    b = jnp.sqrt(-jnp.expm1(2.0 * log_a)) * ig * xf
    a_cum, b_cum = lax.associative_scan(_lin_combine, (a, b), axis=1)
    h = a_cum * h0.astype(jnp.float32)[:, None, :] + b_cum
    return h, h[:, -1]


def _to_blocks(a, pad, n):
    a = jnp.pad(a, [(0, 0), (pad, 0)] + [(0, 0)] * (a.ndim - 2))
    a = a.reshape((a.shape[0], n, CHUNK) + a.shape[2:])
    return jnp.moveaxis(a, (1, 3), (0, 2))


def gated_delta_rule(q, k, v, g, beta, s0):
    bsz, t, h, _ = q.shape
    dv = v.shape[-1]
    pad = (-t) % CHUNK
    n = (t + pad) // CHUNK
    qb, kb, vb = _to_blocks(q, pad, n), _to_blocks(k, pad, n), _to_blocks(v, pad, n)
    gb, bb = _to_blocks(g, pad, n), _to_blocks(beta, pad, n)
    gc = jnp.cumsum(gb, axis=-1)
    idx = jnp.arange(CHUNK)
    incl = idx[:, None] >= idx[None, :]
    strict = idx[:, None] > idx[None, :]
    diff = gc[..., :, None] - gc[..., None, :]
    decay = jnp.where(incl, jnp.exp(jnp.where(incl, diff, 0.0)), 0.0)
    kk = jnp.einsum('nbhid,nbhjd->nbhij', kb, kb)
    lmat = jnp.where(strict, bb[..., :, None] * decay * kk, 0.0) + jnp.eye(CHUNK, dtype=jnp.float32)
    rhs = jnp.concatenate([bb[..., None] * vb, (bb * jnp.exp(gc))[..., None] * kb], axis=-1)
    sol = lax.linalg.triangular_solve(lmat, rhs, left_side=True, lower=True, unit_diagonal=True)
    u, wk = sol[..., :dv], sol[..., dv:]
    qk = jnp.einsum('nbhid,nbhjd->nbhij', qb, kb) * decay
    q_dec = qb * jnp.exp(gc)[..., None]
    k_end = kb * jnp.exp(gc[..., -1:] - gc)[..., None]
    g_end = jnp.exp(gc[..., -1])

    def step(s, xs):
        u_c, wk_c, qk_c, qd_c, ke_c, ge_c = xs
        w = u_c - jnp.einsum('bhik,bhkv->bhiv', wk_c, s)
        o = jnp.einsum('bhik,bhkv->bhiv', qd_c, s) + jnp.einsum('bhij,bhjv->bhiv', qk_c, w)
        s = ge_c[..., None, None] * s + jnp.einsum('bhjk,bhjv->bhkv', ke_c, w)
        return s, o

    s_last, o = lax.scan(step, s0.astype(jnp.float32), (u, wk, qk, q_dec, k_end, g_end))
    o = jnp.moveaxis(o, (0, 2), (1, 3)).reshape(bsz, n * CHUNK, h, dv)[:, pad:]
    return o, s_last


def mixer(h, conv_a_hist, lru_h0, conv_b_hist, s0, p, l):
    bsz, t, _ = h.shape
    proj = h @ p['w_in'][l]
    o1 = LRU_WIDTH
    o2 = 2 * LRU_WIDTH
    o3 = o2 + GDN_QKV
    o4 = o3 + GDN_VW
    o5 = o4 + GDN_HEADS
    xa, ga, qkv = proj[..., :o1], proj[..., o1:o2], proj[..., o2:o3]
    z, b_in, al_in = proj[..., o3:o4], proj[..., o4:o5], proj[..., o5:]
    xa_c, new_conv_a = causal_conv(xa, conv_a_hist, p['conv_a_w'][l], p['conv_a_b'][l])
    ha, lru_last = rg_lru(xa_c, p['rg_w'][l], p['rg_b'][l], p['ig_w'][l], p['ig_b'][l], p['lru_lambda'][l], lru_h0)
    ya = rms_norm(ha, p['norm_a'][l]) * jax.nn.gelu(ga.astype(jnp.float32))
    qkv_c, new_conv_b = causal_conv(qkv, conv_b_hist, p['conv_b_w'][l], None)
    qkv_c = jax.nn.silu(qkv_c.astype(jnp.float32))
    q = qkv_c[..., :GDN_QK].reshape(bsz, t, GDN_HEADS, GDN_DK)
    k = qkv_c[..., GDN_QK:2 * GDN_QK].reshape(bsz, t, GDN_HEADS, GDN_DK)
    v = qkv_c[..., 2 * GDN_QK:].reshape(bsz, t, GDN_HEADS, GDN_DV)
    q = l2_normalize(q) * (GDN_DK ** -0.5)
    k = l2_normalize(k)
    beta = jax.nn.sigmoid(b_in.astype(jnp.float32))
    g = -jnp.exp(p['a_log'][l].astype(jnp.float32)) * jax.nn.softplus(al_in.astype(jnp.float32) + p['dt_bias'][l].astype(jnp.float32))
    o, s_last = gated_delta_rule(q, k, v, g, beta, s0)
    yb = rms_norm(o, p['norm_b'][l]) * jax.nn.silu(z.astype(jnp.float32).reshape(bsz, t, GDN_HEADS, GDN_DV))
    y = jnp.concatenate([ya, yb.reshape(bsz, t, GDN_VW)], axis=-1).astype(h.dtype) @ p['w_out'][l]
    return y, new_conv_a, lru_last, new_conv_b, s_last


def trunk(x, conv_a_st, lru_st, conv_b_st, delta_st, p):
    ca, lr, cb, dl = [], [], [], []
    for l in range(DEPTH):
        x = x + 0.5 * swiglu(rms_norm(x, p['ffn1_norm'][l]), p['ffn1_w_gate'][l], p['ffn1_w_up'][l], p['ffn1_w_down'][l])
        y, nca, nlr, ncb, ndl = mixer(rms_norm(x, p['mix_norm'][l]), conv_a_st[l], lru_st[l], conv_b_st[l], delta_st[l], p, l)
        x = x + y
        x = x + 0.5 * swiglu(rms_norm(x, p['ffn2_norm'][l]), p['ffn2_w_gate'][l], p['ffn2_w_up'][l], p['ffn2_w_down'][l])
        ca.append(nca)
        lr.append(nlr)
        cb.append(ncb)
        dl.append(ndl)
    y = rms_norm(x, p['final_norm'])
    return y, jnp.stack(ca, 0), jnp.stack(lr, 0), jnp.stack(cb, 0), jnp.stack(dl, 0)


def setup_inputs(seed: int = 0) -> dict:
    key = jax.random.key(seed)
    ks = iter(jax.random.split(key, 48))
    f32 = jnp.float32

    def nrm(shape, scale):
        return jax.random.normal(next(ks), shape, f32) * scale

    def gain(shape):
        return 1.0 + nrm(shape, 0.02)

    x_prompt = nrm((BATCH, SEQ, D_MODEL), 1.0)
    x_sample = nrm((DEC_BATCH, DEC_SEQ, D_MODEL), 1.0)
    state_conv_a = nrm((DEPTH, DEC_BATCH, CONV_W - 1, LRU_WIDTH), 1.0)
    state_lru = nrm((DEPTH, DEC_BATCH, LRU_WIDTH), 0.5)
    state_conv_b = nrm((DEPTH, DEC_BATCH, CONV_W - 1, GDN_QKV), 1.0)
    state_delta = nrm((DEPTH, DEC_BATCH, GDN_HEADS, GDN_DK, GDN_DV), 0.05)
    meta_tokens = nrm((N_META, D_MODEL), 1.0)
    ffn1_norm = gain((DEPTH, D_MODEL))
    ffn1_w_gate = nrm((DEPTH, D_MODEL, D_FF), D_MODEL ** -0.5)
    ffn1_w_up = nrm((DEPTH, D_MODEL, D_FF), D_MODEL ** -0.5)
    ffn1_w_down = nrm((DEPTH, D_FF, D_MODEL), D_FF ** -0.5)
    mix_norm = gain((DEPTH, D_MODEL))
    w_in = nrm((DEPTH, D_MODEL, N_IN), D_MODEL ** -0.5)
    conv_a_w = nrm((DEPTH, CONV_W, LRU_WIDTH), CONV_W ** -0.5)
    conv_a_b = nrm((DEPTH, LRU_WIDTH), 0.01)
    rg_w = nrm((DEPTH, LRU_BLOCKS, LRU_BLOCK, LRU_BLOCK), LRU_BLOCK ** -0.5)
    rg_b = nrm((DEPTH, LRU_WIDTH), 0.01)
    ig_w = nrm((DEPTH, LRU_BLOCKS, LRU_BLOCK, LRU_BLOCK), LRU_BLOCK ** -0.5)
    ig_b = nrm((DEPTH, LRU_WIDTH), 0.01)
    a_pow = jax.random.uniform(next(ks), (DEPTH, LRU_WIDTH), f32, 0.9, 0.999) ** (1.0 / LRU_C)
    lru_lambda = jnp.log(a_pow) - jnp.log1p(-a_pow)
    norm_a = gain((DEPTH, LRU_WIDTH))
    conv_b_w = nrm((DEPTH, CONV_W, GDN_QKV), CONV_W ** -0.5)
    a_log = jnp.log(jax.random.uniform(next(ks), (DEPTH, GDN_HEADS), f32, 1.0, 16.0))
    dt = jnp.exp(jax.random.uniform(next(ks), (DEPTH, GDN_HEADS), f32, math.log(0.001), math.log(0.1)))
    dt_bias = dt + jnp.log(-jnp.expm1(-dt))
    norm_b = gain((DEPTH, GDN_DV))
    w_out = nrm((DEPTH, MIX_WIDTH, D_MODEL), MIX_WIDTH ** -0.5)
    ffn2_norm = gain((DEPTH, D_MODEL))
    ffn2_w_gate = nrm((DEPTH, D_MODEL, D_FF), D_MODEL ** -0.5)
    ffn2_w_up = nrm((DEPTH, D_MODEL, D_FF), D_MODEL ** -0.5)
    ffn2_w_down = nrm((DEPTH, D_FF, D_MODEL), D_FF ** -0.5)
    final_norm = gain((D_MODEL,))
    return {'x_prompt': x_prompt, 'x_sample': x_sample,
            'state_conv_a': state_conv_a, 'state_lru': state_lru,
            'state_conv_b': state_conv_b, 'state_delta': state_delta,
            'meta_tokens': meta_tokens,
            'ffn1_norm': ffn1_norm, 'ffn1_w_gate': ffn1_w_gate, 'ffn1_w_up': ffn1_w_up, 'ffn1_w_down': ffn1_w_down,
            'mix_norm': mix_norm, 'w_in': w_in,
            'conv_a_w': conv_a_w, 'conv_a_b': conv_a_b, 'rg_w': rg_w, 'rg_b': rg_b, 'ig_w': ig_w, 'ig_b': ig_b,
            'lru_lambda': lru_lambda, 'norm_a': norm_a,
            'conv_b_w': conv_b_w, 'a_log': a_log, 'dt_bias': dt_bias, 'norm_b': norm_b,
            'w_out': w_out,
            'ffn2_norm': ffn2_norm, 'ffn2_w_gate': ffn2_w_gate, 'ffn2_w_up': ffn2_w_up, 'ffn2_w_down': ffn2_w_down,
            'final_norm': final_norm}


def reference(x_prompt, x_sample, state_conv_a, state_lru, state_conv_b, state_delta, meta_tokens,
              ffn1_norm, ffn1_w_gate, ffn1_w_up, ffn1_w_down, mix_norm, w_in,
              conv_a_w, conv_a_b, rg_w, rg_b, ig_w, ig_b, lru_lambda, norm_a,
              conv_b_w, a_log, dt_bias, norm_b, w_out,
              ffn2_norm, ffn2_w_gate, ffn2_w_up, ffn2_w_down, final_norm):
    p = {'ffn1_norm': ffn1_norm, 'ffn1_w_gate': ffn1_w_gate, 'ffn1_w_up': ffn1_w_up, 'ffn1_w_down': ffn1_w_down,
         'mix_norm': mix_norm, 'w_in': w_in,
         'conv_a_w': conv_a_w, 'conv_a_b': conv_a_b, 'rg_w': rg_w, 'rg_b': rg_b, 'ig_w': ig_w, 'ig_b': ig_b,
         'lru_lambda': lru_lambda, 'norm_a': norm_a,
         'conv_b_w': conv_b_w, 'a_log': a_log, 'dt_bias': dt_bias, 'norm_b': norm_b, 'w_out': w_out,
         'ffn2_norm': ffn2_norm, 'ffn2_w_gate': ffn2_w_gate, 'ffn2_w_up': ffn2_w_up, 'ffn2_w_down': ffn2_w_down,
         'final_norm': final_norm}
    bp = x_prompt.shape[0]
    meta = jnp.broadcast_to(meta_tokens.astype(x_prompt.dtype)[None], (bp, N_META, D_MODEL))
    xp = jnp.concatenate([meta, x_prompt], axis=1)
    z_ca = jnp.zeros((DEPTH, bp, CONV_W - 1, LRU_WIDTH), x_prompt.dtype)
    z_lru = jnp.zeros((DEPTH, bp, LRU_WIDTH), jnp.float32)
    z_cb = jnp.zeros((DEPTH, bp, CONV_W - 1, GDN_QKV), x_prompt.dtype)
    z_dl = jnp.zeros((DEPTH, bp, GDN_HEADS, GDN_DK, GDN_DV), jnp.float32)
    yp, p_ca, p_lru, p_cb, p_dl = trunk(xp, z_ca, z_lru, z_cb, z_dl, p)
    ys, s_ca, s_lru, s_cb, s_dl = trunk(x_sample, state_conv_a, state_lru, state_conv_b, state_delta, p)
    return (yp[:, N_META:], ys, p_ca, p_lru, p_cb, p_dl, s_ca, s_lru, s_cb, s_dl)
```

```cpp
#include <hip/hip_runtime.h>
#include <hip/hip_cooperative_groups.h>
#include <cstdio>
namespace cg = cooperative_groups;
namespace pg8 {
#define PG8_LAS __attribute__((address_space(3)))
typedef unsigned short bf16_t;
typedef short bf16x8 __attribute__((ext_vector_type(8)));
typedef float f32x4 __attribute__((ext_vector_type(4)));
typedef unsigned u32x4 __attribute__((ext_vector_type(4)));
constexpr int BM = 256, BK = 64, HALF = 128, HTB = HALF * BK * 2  , STAGE_BYTES = 8 * HTB, NXCD = 8, WGM = 8;
__host__ __device__ __forceinline__ int lds_byte(int r, int c) { const int st = (r >> 4) * 2 + (c >> 5), rr = r & 15, cc = c & 31, ob = rr * 64 + cc * 2; return st * 1024 + (ob ^ (((ob >> 9) & 1) << 5)); }
__host__ __device__ __forceinline__ void stage_rc(int b, int& R, int& C) { const int st = b / 1024, sb = b % 1024, swz = sb ^ (((sb >> 9) & 1) << 5); R = (st >> 1) * 16 + swz / 64; C = (st & 1) * 32 + (swz % 64) / 2; }
__host__ __device__ __forceinline__ int perm32(int rho) { const int n = rho >> 4, i = rho & 15; return 8 * (i >> 2) + 4 * n + (i & 3); }
struct Unit { int pm, pn; };
struct Gemm { const bf16_t* A; const bf16_t* Bt; int M, N, K; };
struct StaticOrder {
    int nM, nN, nwg, G, c;
    __host__ __device__ void init(int M, int N, int G_, int c_) { nM = M / BM; nN = N / BM; nwg = nM * nN; G = G_; c = c_; }
    __host__ __device__ bool next(int i, Unit& u) const {
        const long L = (long)i * G + c; if (L >= nwg) return false;
        int wgid = (int)L; { const int q = nwg / NXCD, r = nwg % NXCD, xcd = wgid % NXCD, off = wgid / NXCD; wgid = (xcd < r ? xcd * (q + 1) : r * (q + 1) + (xcd - r) * q) + off; }
        const int nig = WGM * nN, gid = wgid / nig, fm = gid * WGM, gsz = (nM - fm) < WGM ? (nM - fm) : WGM;
        u.pm = fm + ((wgid % nig) % gsz); u.pn = (wgid % nig) / gsz; return true;
    }
    __device__ __forceinline__ void a_ready(const Unit&) const {}
    __device__ __forceinline__ void done(const Unit&) const {}
};
__device__ __forceinline__ unsigned cvt_pk_bf16(float lo, float hi) { unsigned r; asm volatile("v_cvt_pk_bf16_f32 %0, %1, %2" : "=v"(r) : "v"(lo), "v"(hi)); return r; }
template <class Epi, class Sched, bool STAMP = false>
__device__ __forceinline__ void gemm_phase(PG8_LAS unsigned char* lds, const Gemm g, const Sched& S, const Epi& E, unsigned long long* stamps) {
    int tid_ = threadIdx.x; asm volatile("" : "+v"(tid_)); const int tid = tid_, wid = __builtin_amdgcn_readfirstlane(tid >> 6), lane = tid & 63, wr = wid >> 2, wc = wid & 3, fr = lane & 15, fq = lane >> 4;
    const int K = g.K, nt = K / BK;
    int ts_lo = 0, ts_hi = 0, nts = 0; const unsigned long long rt_entry = STAMP ? (unsigned long long)wall_clock64() : 0ull;
#define PG8_STAMP() do { if (STAMP && wid == 0 && nts < 64) { const unsigned long long _c = (unsigned long long)clock64(); \
        ts_lo = (lane == nts) ? (int)(unsigned)_c : ts_lo; ts_hi = (lane == nts) ? (int)(unsigned)(_c >> 32) : ts_hi; ++nts; } } while (0)
    PG8_STAMP();
    unsigned voffA[2], voffB[2];
#pragma unroll
    for (int i = 0; i < 2; ++i) { int R, C; stage_rc(tid * 16 + i * 8192, R, C); const int Rb = E.perm() ? ((R & ~31) + perm32(R & 31)) : R;
        voffA[i] = (unsigned)(R * K + C) * 2u; voffB[i] = (unsigned)(Rb * K + C) * 2u; }
    const size_t kstep = (size_t)(BK * 2);
    const size_t hstep = (size_t)HALF * K * 2;
    const size_t tstep = 2 * hstep;
    const unsigned ldsw = (unsigned)wid * 1024u;
    const int aoff = lds_byte(wr * 64 + fr, fq * 8), boff = lds_byte(wc * 32 + fr, fq * 8);
#define PG8_SA(b, h) (((b) * 2 + (h)) * HTB)
#define PG8_SB(b, h) ((4 + (b) * 2 + (h)) * HTB)
#define PG8_STAGE(bufoff, gbase, voff) do { _Pragma("unroll") for (int _i = 0; _i < 2; ++_i) \
        __builtin_amdgcn_global_load_lds((const unsigned*)((const char*)(gbase) + (voff)[_i]), (PG8_LAS unsigned*)(lds + (bufoff) + ldsw + _i * 8192), 16, 0, 0); } while (0)
#define PG8_LDA(dst, b, h) do { _Pragma("unroll") for (int m = 0; m < 4; ++m) _Pragma("unroll") for (int k = 0; k < 2; ++k) dst[m][k] = *(const PG8_LAS bf16x8*)(lds + PG8_SA(b, h) + aoff + m * 2048 + k * 1024); } while (0)
#define PG8_LDB(dst, b, h) do { _Pragma("unroll") for (int n = 0; n < 2; ++n) _Pragma("unroll") for (int k = 0; k < 2; ++k) dst[n][k] = *(const PG8_LAS bf16x8*)(lds + PG8_SB(b, h) + boff + n * 2048 + k * 1024); } while (0)
#define PG8_MMA(ai, bj, At, Bt) do { __builtin_amdgcn_s_setprio(1); _Pragma("unroll") for (int m = 0; m < 4; ++m) _Pragma("unroll") for (int n = 0; n < 2; ++n) _Pragma("unroll") for (int k = 0; k < 2; ++k) \
        acc[ai][bj][m][n] = __builtin_amdgcn_mfma_f32_16x16x32_bf16(Bt[n][k], At[m][k], acc[ai][bj][m][n], 0, 0, 0); __builtin_amdgcn_s_setprio(0); } while (0)
#define PG8_WAIT_V(n) asm volatile("s_waitcnt vmcnt(" #n ")" ::: "memory")
#define PG8_WAIT_L(n) asm volatile("s_waitcnt lgkmcnt(" #n ")" ::: "memory")
#define PG8_BAR __builtin_amdgcn_s_barrier()
#define PG8_SCHED __builtin_amdgcn_sched_barrier(0)
    Unit cur, nxt; int ui = 0;
    if (!S.next(0, cur)) return;
    f32x4 acc[2][2][4][2];
#pragma unroll
    for (int a = 0; a < 2; ++a)
#pragma unroll
        for (int b = 0; b < 2; ++b)
#pragma unroll
            for (int m = 0; m < 4; ++m)
#pragma unroll
                for (int n = 0; n < 2; ++n) acc[a][b][m][n] = (f32x4){0.f, 0.f, 0.f, 0.f};
    bf16x8 At[4][2], B0[2][2], B1[2][2];
    const char* cA = (const char*)g.A + (size_t)cur.pm * tstep; const char* cB = (const char*)g.Bt + (size_t)cur.pn * tstep;
    S.a_ready(cur);
    PG8_STAGE(PG8_SB(0, 0), cB, voffB); PG8_STAGE(PG8_SA(0, 0), cA, voffA); PG8_STAGE(PG8_SB(0, 1), cB + hstep, voffB); PG8_STAGE(PG8_SA(0, 1), cA + hstep, voffA);
    if (wr == 1) PG8_BAR;
    PG8_WAIT_V(4); PG8_BAR;
    PG8_STAGE(PG8_SB(1, 0), cB + kstep, voffB); PG8_STAGE(PG8_SA(1, 0), cA + kstep, voffA); PG8_STAGE(PG8_SB(1, 1), cB + hstep + kstep, voffB);
    PG8_WAIT_V(6); PG8_BAR;
    PG8_STAMP();
    for (;;) {
        const bool has_next = S.next(ui + 1, nxt);
        const char* nA = has_next ? (const char*)g.A + (size_t)nxt.pm * tstep : cA; const char* nB = has_next ? (const char*)g.Bt + (size_t)nxt.pn * tstep : cB;
        for (int t = 0; t < nt; t += 2) {
            const bool last = (t == nt - 2);
            const char* a1 = cA + (size_t)(t + 1) * kstep;
            const char* a2 = last ? nA : cA + (size_t)(t + 2) * kstep; const char* b2 = last ? nB : cB + (size_t)(t + 2) * kstep;
            const char* a3 = a2 + kstep; const char* b3 = b2 + kstep;
            if (last && has_next) S.a_ready(nxt);
            PG8_LDB(B0, 0, 0); PG8_SCHED; PG8_LDA(At, 0, 0); PG8_STAGE(PG8_SA(1, 1), a1 + hstep, voffA);
            PG8_WAIT_L(8); PG8_BAR; PG8_WAIT_L(0); PG8_MMA(0, 0, At, B0); PG8_BAR; PG8_SCHED;
            PG8_LDB(B1, 0, 1); PG8_STAGE(PG8_SB(0, 0), b2, voffB);
            PG8_BAR; PG8_WAIT_L(0); PG8_MMA(0, 1, At, B1); PG8_BAR;
            PG8_LDA(At, 0, 1); PG8_STAGE(PG8_SA(0, 0), a2, voffA);
            PG8_BAR; PG8_WAIT_L(0); PG8_MMA(1, 0, At, B0); PG8_BAR; PG8_SCHED;
            PG8_STAGE(PG8_SB(0, 1), b2 + hstep, voffB);
            PG8_WAIT_V(6); PG8_BAR; PG8_MMA(1, 1, At, B1); PG8_BAR;
            PG8_LDB(B0, 1, 0); PG8_SCHED; PG8_LDA(At, 1, 0); PG8_STAGE(PG8_SA(0, 1), a2 + hstep, voffA);
            PG8_WAIT_L(8); PG8_BAR; PG8_WAIT_L(0); PG8_MMA(0, 0, At, B0); PG8_BAR; PG8_SCHED;
            PG8_LDB(B1, 1, 1); PG8_STAGE(PG8_SB(1, 0), b3, voffB);
            PG8_BAR; PG8_WAIT_L(0); PG8_MMA(0, 1, At, B1); PG8_BAR;
            PG8_LDA(At, 1, 1); PG8_STAGE(PG8_SA(1, 0), a3, voffA);
            PG8_BAR; PG8_WAIT_L(0); PG8_MMA(1, 0, At, B0); PG8_BAR; PG8_SCHED;
            PG8_STAGE(PG8_SB(1, 1), b3 + hstep, voffB);
            PG8_WAIT_V(6); PG8_BAR; PG8_MMA(1, 1, At, B1); PG8_BAR;
        }
        PG8_STAMP();
        if constexpr (!Epi::AFTER_DRAIN) { E(acc, cur, wr, wc, fr, fq); S.done(cur); }
        PG8_STAMP();
        if (!has_next) break;
#pragma unroll
        for (int a = 0; a < 2; ++a)
#pragma unroll
            for (int b = 0; b < 2; ++b)
#pragma unroll
                for (int m = 0; m < 4; ++m)
#pragma unroll
                    for (int n = 0; n < 2; ++n) acc[a][b][m][n] = (f32x4){0.f, 0.f, 0.f, 0.f};
        cur = nxt; cA = nA; cB = nB; ++ui;
    }
    PG8_WAIT_V(0);
    if (wr == 0) PG8_BAR;
    PG8_BAR;
    if constexpr (Epi::AFTER_DRAIN) { E.fused(acc, cur, wr, wc, fr, fq, lds, wid, lane); S.done(cur); }
    PG8_STAMP();
    if (STAMP && wid == 0) { stamps[lane] = lane < nts ? (((unsigned long long)(unsigned)ts_hi << 32) | (unsigned)ts_lo) : 0ull;
        if (lane == 62) stamps[62] = rt_entry; if (lane == 63) stamps[63] = (unsigned long long)wall_clock64(); }
#undef PG8_STAMP
#undef PG8_SA
#undef PG8_SB
#undef PG8_STAGE
#undef PG8_LDA
#undef PG8_LDB
#undef PG8_MMA
#undef PG8_WAIT_V
#undef PG8_WAIT_L
#undef PG8_BAR
#undef PG8_SCHED
}
}
using pg8::bf16_t; using pg8::bf16x8; using pg8::f32x4; using pg8::u32x4;
typedef unsigned u32x2 __attribute__((ext_vector_type(2)));

constexpr int D = 2048, TP = 8208, NSS = 16;
constexpr int MROWS = 16672, MP = 16896, SROW0 = 16416;
constexpr int DFF = 5632, NGU = 11264, NINP = 6400, PLD = 6144;
constexpr int NSC = 274;
constexpr float EPS = 1e-6f;
constexpr int LDS_BYTES = 147456;
#ifndef TEST_MEMSET
#define TEST_MEMSET 0
#endif
#ifndef TEST_SKIP
#define TEST_SKIP 0
#endif
#ifndef PH_MASK
#define PH_MASK 0x7fff
#endif
#define PH_ON(k) (((PH_MASK) >> (k)) & 1)
#ifndef N_LAUNCH_MODE
#define N_LAUNCH_MODE 1
#endif

constexpr size_t SZ_WGU = (size_t)NGU * D * 2, SZ_WD = (size_t)D * DFF * 2, SZ_WIN = (size_t)NINP * D * 2, SZ_WOUT = (size_t)D * D * 2;
constexpr size_t WS_WGU1 = 0, WS_WD1 = WS_WGU1 + SZ_WGU, WS_WGU2 = WS_WD1 + SZ_WD, WS_WD2 = WS_WGU2 + SZ_WGU, WS_WIN = WS_WD2 + SZ_WD, WS_WOUT = WS_WIN + SZ_WIN,
    WS_WG = WS_WOUT + SZ_WOUT, WS_X = WS_WG + 262144, WS_HN = WS_X + (size_t)MP * D * 4, WS_PROJ = WS_HN + (size_t)MP * D * 2, WS_GCH = WS_PROJ + (size_t)MP * PLD * 2,
    WS_BA = WS_GCH + (size_t)NSC * 8 * 73728, WS_GE = WS_BA + (size_t)MP * 16 * 4, WS_ACH = WS_GE + 16384, WS_BCH = WS_ACH + (size_t)NSC * 1024 * 4,
    WS_CARRY = WS_BCH + (size_t)NSC * 1024 * 4, WS_END = WS_CARRY + (size_t)NSC * 1024 * 4;
constexpr size_t O_YP = 0, O_YS = 33554432, O_PCA = 34078720, O_PLRU = 34091008, O_PCB = 34095104, O_PDL = 34131968, O_SCA = 34656256, O_SLRU = 34754560,
    O_SCB = 34787328, O_SDL = 35082240;
constexpr size_t OS_HL = 0, OS_AC = (size_t)MROWS * 1024;

__device__ __forceinline__ int fresh_tid() { int t = threadIdx.x; asm volatile("" : "+v"(t)); return t; }
struct Params { const float* in[31]; float* out; unsigned char* ws; int ph_lo, ph_hi; };

typedef __bf16 bf16v2 __attribute__((ext_vector_type(2)));
__device__ __forceinline__ unsigned pk2(float lo, float hi) { bf16v2 v; v[0] = (__bf16)lo; v[1] = (__bf16)hi; return __builtin_bit_cast(unsigned, v); }
__device__ __forceinline__ float bflo(unsigned u) { return __uint_as_float(u << 16); }
__device__ __forceinline__ float bfhi(unsigned u) { return __uint_as_float(u & 0xffff0000u); }
__device__ __forceinline__ float bf2f(bf16_t b) { return __uint_as_float(((unsigned)b) << 16); }
__device__ __forceinline__ float sigmoidf_(float x) { return 1.f / (1.f + __expf(-x)); }
__device__ __forceinline__ float siluf_(float x) { return x / (1.f + __expf(-x)); }
__device__ __forceinline__ float softplusf_(float x) { return x > 20.f ? x : log1pf(__expf(x)); }
__device__ __forceinline__ float gelu_tanh(float x) { const float y = 0.7978845608028654f * (x + 0.044715f * x * x * x); const float t = 1.f - 2.f / (1.f + __expf(2.f * y)); return 0.5f * x * (1.f + t); }
__device__ __forceinline__ void unpack8(const u32x4 v, float (&f)[8]) { f[0] = bflo(v.x); f[1] = bfhi(v.x); f[2] = bflo(v.y); f[3] = bfhi(v.y); f[4] = bflo(v.z); f[5] = bfhi(v.z); f[6] = bflo(v.w); f[7] = bfhi(v.w); }
__device__ __forceinline__ u32x4 pack8(const float (&f)[8]) { u32x4 o; o.x = pk2(f[0], f[1]); o.y = pk2(f[2], f[3]); o.z = pk2(f[4], f[5]); o.w = pk2(f[6], f[7]); return o; }
__device__ __forceinline__ f32x4 mfma16(bf16x8 a, bf16x8 b, f32x4 c) { return __builtin_amdgcn_mfma_f32_16x16x32_bf16(a, b, c, 0, 0, 0); }

struct EpiGU {
    static constexpr bool PERM = false, AFTER_DRAIN = false;
    bf16_t* H;
    __device__ __forceinline__ void operator()(const f32x4 (&acc)[2][2][4][2], const pg8::Unit& u, int wr, int wc, int fr, int fq) const {
        const int row0 = u.pm * 256 + wr * 64 + fr, hc0 = u.pn * 128 + wc * 16 + 4 * fq;
#pragma unroll
        for (int ai = 0; ai < 2; ++ai)
#pragma unroll
            for (int m = 0; m < 4; ++m) { bf16_t* rowp = H + (size_t)(row0 + ai * 128 + m * 16) * DFF + hc0;
#pragma unroll
                for (int bj = 0; bj < 2; ++bj) { const f32x4 g = acc[ai][bj][m][0], up = acc[ai][bj][m][1];
                    u32x2 o; o.x = pk2(siluf_(g[0]) * up[0], siluf_(g[1]) * up[1]); o.y = pk2(siluf_(g[2]) * up[2], siluf_(g[3]) * up[3]);
                    *(u32x2*)(rowp + bj * 64) = o; } }
    }
};
struct EpiRes {
    static constexpr bool PERM = false, AFTER_DRAIN = false;
    float* X; float scale;
    __device__ __forceinline__ void operator()(const f32x4 (&acc)[2][2][4][2], const pg8::Unit& u, int wr, int wc, int fr, int fq) const {
        const int row0 = u.pm * 256 + wr * 64 + fr, col0 = u.pn * 256 + wc * 32 + 4 * fq;
#pragma unroll
        for (int ai = 0; ai < 2; ++ai)
#pragma unroll
            for (int m = 0; m < 4; ++m) { float* rowp = X + (size_t)(row0 + ai * 128 + m * 16) * D + col0;
#pragma unroll
                for (int bj = 0; bj < 2; ++bj)
#pragma unroll
                    for (int n = 0; n < 2; ++n) { f32x4* q = (f32x4*)(rowp + bj * 128 + n * 16); *q = *q + acc[ai][bj][m][n] * scale; } }
    }
};
struct EpiProj {
    static constexpr bool PERM = true, AFTER_DRAIN = false;
    bf16_t* P; float* BA;
    __device__ __forceinline__ void operator()(const f32x4 (&acc)[2][2][4][2], const pg8::Unit& u, int wr, int wc, int fr, int fq) const {
        const int row0 = u.pm * 256 + wr * 64 + fr;
        if (u.pn < 24) {
            const int col0 = u.pn * 256 + wc * 32 + 8 * fq;
#pragma unroll
            for (int ai = 0; ai < 2; ++ai)
#pragma unroll
                for (int m = 0; m < 4; ++m) { bf16_t* rowp = P + (size_t)(row0 + ai * 128 + m * 16) * PLD + col0;
#pragma unroll
                    for (int bj = 0; bj < 2; ++bj) { const f32x4 v0 = acc[ai][bj][m][0], v1 = acc[ai][bj][m][1];
                        u32x4 w; w.x = pk2(v0[0], v0[1]); w.y = pk2(v0[2], v0[3]); w.z = pk2(v1[0], v1[1]); w.w = pk2(v1[2], v1[3]);
                        *(u32x4*)(rowp + bj * 128) = w; } }
        } else if (wc == 0 && fq < 2) {
#pragma unroll
            for (int ai = 0; ai < 2; ++ai)
#pragma unroll
                for (int m = 0; m < 4; ++m) { float* q = BA + (size_t)(row0 + ai * 128 + m * 16) * 16 + 8 * fq;
                    *(f32x4*)q = acc[ai][0][m][0]; *(f32x4*)(q + 4) = acc[ai][0][m][1]; }
        }
    }
};

struct EpiAll {
    static constexpr bool AFTER_DRAIN = false;
    int mode; bf16_t* Ob; float* Of; float* BA; float scale;
    __device__ __forceinline__ bool perm() const { return mode == 2; }
    __device__ __forceinline__ void operator()(const f32x4 (&acc)[2][2][4][2], const pg8::Unit& u, int wr, int wc, int fr, int fq) const {
        if (mode == 0) { EpiGU e; e.H = Ob; e(acc, u, wr, wc, fr, fq); }
        else if (mode == 1) { EpiRes e; e.X = Of; e.scale = scale; e(acc, u, wr, wc, fr, fq); }
        else { EpiProj e; e.P = Ob; e.BA = BA; e(acc, u, wr, wc, fr, fq); }
    }
};

__device__ __forceinline__ void tr_tile(const float* W, int K, int N, int kb, int nb, bf16_t* dst, int mode, float* tile) {
    const int tid = fresh_tid(), k0 = kb * 64, n0 = nb * 64;
    { const int nn = tid & 63, kq = tid >> 6, n = n0 + nn;
#pragma unroll
        for (int r = 0; r < 8; ++r) { const int kk = r * 8 + kq; tile[kk * 65 + nn] = (n < N) ? W[(size_t)(k0 + kk) * N + n] : 0.f; } }
    __syncthreads();
    { const int nn = tid >> 3, kc = tid & 7, n = n0 + nn; int drow = n;
        if (mode == 1) drow = (n >> 4) * 32 + (n & 15); else if (mode == 2) drow = (n >> 4) * 32 + 16 + (n & 15);
        const float* s = tile + (kc * 8) * 65 + nn; u32x4 o; o.x = pk2(s[0], s[65]); o.y = pk2(s[130], s[195]); o.z = pk2(s[260], s[325]); o.w = pk2(s[390], s[455]);
        *(u32x4*)(dst + (size_t)drow * K + k0 + kc * 8) = o; }
    __syncthreads();
}
__device__ __forceinline__ void prep_phase(const Params& p, int l, float* tile) {
    constexpr int NT = 6 * 2816 + 3200 + 1024 + 32;
    for (int it = blockIdx.x; it < NT; it += gridDim.x) {
        if (it < 16896) { const int m = it / 2816, r = it % 2816, f = m / 3, w = m % 3;
            const float* src = p.in[(f ? 27 : 8) + w] + (size_t)l * 2048 * 5632;
            if (w < 2) tr_tile(src, 2048, 5632, r / 88, r % 88, (bf16_t*)(p.ws + (f ? WS_WGU2 : WS_WGU1)), w + 1, tile);
            else tr_tile(src, 5632, 2048, r / 32, r % 32, (bf16_t*)(p.ws + (f ? WS_WD2 : WS_WD1)), 0, tile);
        } else if (it < 16896 + 3200) { const int r = it - 16896; tr_tile(p.in[12] + (size_t)l * 2048 * 6160, 2048, 6160, r / 100, r % 100, (bf16_t*)(p.ws + WS_WIN), 0, tile);
        } else if (it < 16896 + 3200 + 1024) { const int r = it - 16896 - 3200; tr_tile(p.in[25] + (size_t)l * 2048 * 2048, 2048, 2048, r / 32, r % 32, (bf16_t*)(p.ws + WS_WOUT), 0, tile);
        } else { const int r = it - 16896 - 3200 - 1024, n = r >> 1, g = r & 1; tr_tile(p.in[g ? 17 : 15] + (size_t)l * 65536 + n * 4096, 64, 64, 0, 0, (bf16_t*)(p.ws + WS_WG) + r * 4096, 0, tile); }
    }
}

template <int MODE>
__device__ __forceinline__ void norm_phase(const Params& p, const float* w) {
    const int tid = fresh_tid(), lane = tid & 63, wid = tid >> 6;
    float* X = (float*)(p.ws + WS_X); bf16_t* HN = (bf16_t*)(p.ws + WS_HN);
    for (int row = blockIdx.x * 8 + wid; row < MP; row += gridDim.x * 8) {
        if (row >= MROWS) {
            if (MODE != 2) {
#pragma unroll
                for (int q = 0; q < 8; ++q) { const int idx = 4 * lane + 256 * q; *(u32x2*)(HN + (size_t)row * D + idx) = (u32x2){0u, 0u};
                    if (MODE == 1) *(f32x4*)(X + (size_t)row * D + idx) = (f32x4){0.f, 0.f, 0.f, 0.f}; } }
            continue; }
        const float* src = X + (size_t)row * D; float* dsto = nullptr;
        if (MODE != 0) {
            if (row < SROW0) { const int b = row / TP, t = row % TP;
                if (MODE == 1) src = t < 16 ? p.in[6] + (size_t)t * D : p.in[0] + ((size_t)b * 8192 + (t - 16)) * D;
                else dsto = t < 16 ? nullptr : p.out + O_YP + ((size_t)b * 8192 + (t - 16)) * D;
            } else { const int r = row - SROW0; if (MODE == 1) src = p.in[1] + (size_t)r * D; else dsto = p.out + O_YS + (size_t)r * D; }
            if (MODE == 2 && dsto == nullptr) continue;
        }
        f32x4 v[8]; float ss = 0.f;
#pragma unroll
        for (int q = 0; q < 8; ++q) { v[q] = *(const f32x4*)(src + 4 * lane + 256 * q); ss += v[q][0] * v[q][0] + v[q][1] * v[q][1] + v[q][2] * v[q][2] + v[q][3] * v[q][3]; }
#pragma unroll
        for (int o = 1; o < 64; o <<= 1) ss += __shfl_xor(ss, o);
        const float rs = rsqrtf(ss * (1.f / 2048.f) + EPS);
#pragma unroll
        for (int q = 0; q < 8; ++q) { const int idx = 4 * lane + 256 * q; const f32x4 wv = *(const f32x4*)(w + idx); const f32x4 y = v[q] * rs * wv;
            if (MODE == 2) *(f32x4*)(dsto + idx) = y;
            else { u32x2 o; o.x = pk2(y[0], y[1]); o.y = pk2(y[2], y[3]); *(u32x2*)(HN + (size_t)row * D + idx) = o; if (MODE == 1) *(f32x4*)(X + (size_t)row * D + idx) = v[q]; } }
    }
}

struct ChunkGeo { int row0, tok0, valid_lo, samp; };
__device__ __forceinline__ ChunkGeo chunk_geo(int sc) {
    ChunkGeo g;
    if (sc < 258) { const int b = sc / 129, c = sc % 129; g.tok0 = 64 * c - 48; g.row0 = b * TP + g.tok0; g.valid_lo = c == 0 ? 48 : 0; g.samp = -1; }
    else { const int s = sc - 258; g.tok0 = -48; g.row0 = SROW0 + 16 * s - 48; g.valid_lo = 48; g.samp = s; }
    return g;
}

__device__ __forceinline__ void gdn_item(const Params& p, int l, int sc, int h, unsigned char* shm) {
    const int tid = fresh_tid(), L = tid & 63, w = tid >> 6;
    bf16_t* qs = (bf16_t*)shm; bf16_t* ks = (bf16_t*)(shm + 17408); float* sol = (float*)(shm + 34816); float* Lm = (float*)(shm + 100352); float* qkm = (float*)(shm + 116736);
    float* gcs = (float*)(shm + 134144); float* betas = gcs + 64; float* egcs = gcs + 128;
    const ChunkGeo G = chunk_geo(sc);
    const bf16_t* PROJ = (const bf16_t*)(p.ws + WS_PROJ); const float* BA = (const float*)(p.ws + WS_BA);
    const int item = sc * 8 + h; unsigned char* ib = p.ws + WS_GCH + (size_t)item * 73728;
    if (w == 0) {
        const int i = L; float beta = 0.f, g = 0.f;
        if (i >= G.valid_lo) { const float* ba = BA + (size_t)(G.row0 + i) * 16; beta = sigmoidf_(ba[h]); g = -__expf(p.in[22][l * 8 + h]) * softplusf_(ba[8 + h] + p.in[23][l * 8 + h]); }
#pragma unroll
        for (int o = 1; o < 64; o <<= 1) { const float v = __shfl_up(g, o); if (L >= o) g += v; }
        gcs[i] = g; betas[i] = beta; egcs[i] = __expf(g);
        if (L == 63) ((float*)(p.ws + WS_GE))[item] = __expf(g);
    }
    __syncthreads();
#pragma unroll 1
    for (int r = 0; r < 6; ++r) {
        const int e = tid + 512 * r, pos = e / 48, cgi = e % 48, typ = cgi >> 4, c8 = (cgi & 15) * 8, col = typ * 1024 + h * 128 + c8;
        const bool valid = pos >= G.valid_lo;
        float acc[8];
#pragma unroll
        for (int k = 0; k < 8; ++k) acc[k] = 0.f;
        if (valid) {
#pragma unroll
            for (int j = 0; j < 4; ++j) {
                const int m = G.tok0 + pos - 3 + j; float xv[8]; bool have = true;
                if (m >= 0) { const u32x4 raw = *(const u32x4*)(PROJ + (size_t)(G.row0 + pos - 3 + j) * PLD + 2048 + col); unpack8(raw, xv); }
                else if (G.samp >= 0) { const float* sp = p.in[4] + ((size_t)(l * 16 + G.samp) * 3 + (3 + m)) * 3072 + col; const f32x4 a = *(const f32x4*)sp, b = *(const f32x4*)(sp + 4);
                    xv[0] = a[0]; xv[1] = a[1]; xv[2] = a[2]; xv[3] = a[3]; xv[4] = b[0]; xv[5] = b[1]; xv[6] = b[2]; xv[7] = b[3]; }
                else have = false;
                if (have) { const float* wp = p.in[21] + (size_t)(l * 4 + j) * 3072 + col; const f32x4 wa = *(const f32x4*)wp, wb = *(const f32x4*)(wp + 4);
                    acc[0] += xv[0] * wa[0]; acc[1] += xv[1] * wa[1]; acc[2] += xv[2] * wa[2]; acc[3] += xv[3] * wa[3];
                    acc[4] += xv[4] * wb[0]; acc[5] += xv[5] * wb[1]; acc[6] += xv[6] * wb[2]; acc[7] += xv[7] * wb[3]; }
            }
        }
        float ss = 0.f;
#pragma unroll
        for (int k = 0; k < 8; ++k) { acc[k] = siluf_(acc[k]); ss += acc[k] * acc[k]; }
        ss += __shfl_xor(ss, 1); ss += __shfl_xor(ss, 2); ss += __shfl_xor(ss, 4); ss += __shfl_xor(ss, 8);
        if (typ < 2) { const float scl = rsqrtf(ss + EPS) * (typ == 0 ? 0.08838834764831845f : 1.f);
#pragma unroll
            for (int k = 0; k < 8; ++k) acc[k] *= scl;
            *(u32x4*)((typ == 0 ? qs : ks) + pos * 136 + c8) = pack8(acc);
            if (typ == 1) { const float f = betas[pos] * egcs[pos];
#pragma unroll
                for (int k = 0; k < 8; ++k) sol[pos * 256 + 128 + c8 + k] = f * acc[k]; }
        } else { const float f = betas[pos];
#pragma unroll
            for (int k = 0; k < 8; ++k) sol[pos * 256 + c8 + k] = f * acc[k]; }
    }
    __syncthreads();
    {
        const int mat = w >> 2, mt = w & 3, lr = L & 15, lq = L >> 4;
        const bf16_t* Asrc = mat ? qs : ks; bf16x8 a[4];
#pragma unroll
        for (int s = 0; s < 4; ++s) a[s] = *(const bf16x8*)(Asrc + (16 * mt + lr) * 136 + 32 * s + lq * 8);
#pragma unroll
        for (int nt = 0; nt < 4; ++nt) {
            f32x4 c = {0.f, 0.f, 0.f, 0.f};
#pragma unroll
            for (int s = 0; s < 4; ++s) { const bf16x8 b = *(const bf16x8*)(ks + (16 * nt + lr) * 136 + 32 * s + lq * 8); c = mfma16(a[s], b, c); }
            const int j = 16 * nt + lr; const float gj = gcs[j];
#pragma unroll
            for (int r = 0; r < 4; ++r) { const int i = 16 * mt + lq * 4 + r; const float dec = __expf(fminf(gcs[i] - gj, 0.f));
                if (mat == 0) Lm[i * 64 + j] = (i > j) ? betas[i] * dec * c[r] : 0.f;
                else qkm[i * 68 + j] = (i >= j) ? dec * c[r] : 0.f; }
        }
    }
    __syncthreads();
    if (tid < 256) {
        const int c = tid;
#pragma unroll 1
        for (int B = 0; B < 4; ++B) {
            float acc[16];
#pragma unroll
            for (int r = 0; r < 16; ++r) acc[r] = sol[(16 * B + r) * 256 + c];
#pragma unroll 1
            for (int jb = 0; jb < B; ++jb) {
                float xj[16];
#pragma unroll
                for (int k = 0; k < 16; ++k) xj[k] = sol[(16 * jb + k) * 256 + c];
#pragma unroll
                for (int r = 0; r < 16; ++r) { const float* lr = Lm + (16 * B + r) * 64 + 16 * jb;
#pragma unroll
                    for (int k4 = 0; k4 < 4; ++k4) { const f32x4 lv = *(const f32x4*)(lr + 4 * k4);
                        acc[r] -= lv[0] * xj[4 * k4]; acc[r] -= lv[1] * xj[4 * k4 + 1]; acc[r] -= lv[2] * xj[4 * k4 + 2]; acc[r] -= lv[3] * xj[4 * k4 + 3]; } }
            }
#pragma unroll
            for (int r = 1; r < 16; ++r) { const float* lr = Lm + (16 * B + r) * 64 + 16 * B;
#pragma unroll
                for (int k4 = 0; k4 < (r + 3) / 4; ++k4) { const f32x4 lv = *(const f32x4*)(lr + 4 * k4);
                    if (4 * k4 < r) acc[r] -= lv[0] * acc[4 * k4];
                    if (4 * k4 + 1 < r) acc[r] -= lv[1] * acc[4 * k4 + 1];
                    if (4 * k4 + 2 < r) acc[r] -= lv[2] * acc[4 * k4 + 2];
                    if (4 * k4 + 3 < r) acc[r] -= lv[3] * acc[4 * k4 + 3]; } }
#pragma unroll
            for (int r = 0; r < 16; ++r) sol[(16 * B + r) * 256 + c] = acc[r];
        }
    } else {
        const int t2 = tid - 256; const float gl = gcs[63];
#pragma unroll
        for (int r = 0; r < 4; ++r) {
            const int q = t2 + 256 * r, Lq = q & 63, f = q >> 6, mt = f >> 2, s = f & 3, i = 16 * mt + (Lq & 15), k0 = 32 * s + (Lq >> 4) * 8;
            float v[8]; unpack8(*(const u32x4*)(qs + i * 136 + k0), v); const float e = egcs[i];
#pragma unroll
            for (int k = 0; k < 8; ++k) v[k] *= e;
            *(u32x4*)(ib + 16384 + (size_t)q * 16) = pack8(v); }
#pragma unroll
        for (int r = 0; r < 4; ++r) {
            const int q = t2 + 256 * r, Lq = q & 63, f = q >> 6, mt = f >> 1, s = f & 1, dk = 16 * mt + (Lq & 15), j0 = 32 * s + (Lq >> 4) * 8;
            float v[8];
#pragma unroll
            for (int k = 0; k < 8; ++k) v[k] = bf2f(ks[(j0 + k) * 136 + dk]) * __expf(fminf(gl - gcs[j0 + k], 0.f));
            *(u32x4*)(ib + 32768 + (size_t)q * 16) = pack8(v); }
#pragma unroll
        for (int r = 0; r < 2; ++r) {
            const int q = t2 + 256 * r, Lq = q & 63, f = q >> 6, mt = f >> 1, s = f & 1, i = 16 * mt + (Lq & 15), j0 = 32 * s + (Lq >> 4) * 8;
            float v[8]; const f32x4 a = *(const f32x4*)(qkm + i * 68 + j0), b = *(const f32x4*)(qkm + i * 68 + j0 + 4);
            v[0] = a[0]; v[1] = a[1]; v[2] = a[2]; v[3] = a[3]; v[4] = b[0]; v[5] = b[1]; v[6] = b[2]; v[7] = b[3];
            *(u32x4*)(ib + 49152 + (size_t)q * 16) = pack8(v); }
    }
    __syncthreads();
#pragma unroll
    for (int r = 0; r < 2; ++r) {
        const int q = tid + 512 * r, Lq = q & 63, f = q >> 6, mt = f >> 2, s = f & 3, i = 16 * mt + (Lq & 15), k0 = 32 * s + (Lq >> 4) * 8;
        float v[8]; const f32x4 a = *(const f32x4*)(sol + i * 256 + 128 + k0), b = *(const f32x4*)(sol + i * 256 + 128 + k0 + 4);
        v[0] = a[0]; v[1] = a[1]; v[2] = a[2]; v[3] = a[3]; v[4] = b[0]; v[5] = b[1]; v[6] = b[2]; v[7] = b[3];
        *(u32x4*)(ib + (size_t)q * 16) = pack8(v); }
#pragma unroll
    for (int r = 0; r < 4; ++r) {
        const int q = tid + 512 * r, Lq = q & 63, f = q >> 6, mt = f >> 3, ntile = f & 7, i0 = 16 * mt + (Lq >> 4) * 4, cc = 16 * ntile + (Lq & 15);
        u32x2 o; o.x = pk2(sol[i0 * 256 + cc], sol[(i0 + 1) * 256 + cc]); o.y = pk2(sol[(i0 + 2) * 256 + cc], sol[(i0 + 3) * 256 + cc]);
        *(u32x2*)(ib + 57344 + (size_t)q * 8) = o; }
    __syncthreads();
}

__device__ __forceinline__ void lru_item(const Params& p, int l, int sc, int n, unsigned char* shm) {
    const int tid = fresh_tid(), L = tid & 63, w = tid >> 6;
    bf16_t* xs = (bf16_t*)shm; float* xf = (float*)(shm + 9216); float* gr = (float*)(shm + 25856);
    const ChunkGeo G = chunk_geo(sc);
    const bf16_t* PROJ = (const bf16_t*)(p.ws + WS_PROJ);
    {
        const int pos = tid >> 3, cgi = tid & 7, ch0 = n * 64 + cgi * 8; float acc[8];
        { const float* bp = p.in[14] + l * 1024 + ch0; const f32x4 a = *(const f32x4*)bp, b = *(const f32x4*)(bp + 4);
            acc[0] = a[0]; acc[1] = a[1]; acc[2] = a[2]; acc[3] = a[3]; acc[4] = b[0]; acc[5] = b[1]; acc[6] = b[2]; acc[7] = b[3]; }
        if (pos >= G.valid_lo) {
#pragma unroll
            for (int j = 0; j < 4; ++j) {
                const int m = G.tok0 + pos - 3 + j; float xv[8]; bool have = true;
                if (m >= 0) { unpack8(*(const u32x4*)(PROJ + (size_t)(G.row0 + pos - 3 + j) * PLD + ch0), xv); }
                else if (G.samp >= 0) { const float* sp = p.in[2] + ((size_t)(l * 16 + G.samp) * 3 + (3 + m)) * 1024 + ch0; const f32x4 a = *(const f32x4*)sp, b = *(const f32x4*)(sp + 4);
                    xv[0] = a[0]; xv[1] = a[1]; xv[2] = a[2]; xv[3] = a[3]; xv[4] = b[0]; xv[5] = b[1]; xv[6] = b[2]; xv[7] = b[3]; }
                else have = false;
                if (have) { const float* wp = p.in[13] + (size_t)(l * 4 + j) * 1024 + ch0; const f32x4 wa = *(const f32x4*)wp, wb = *(const f32x4*)(wp + 4);
                    acc[0] += xv[0] * wa[0]; acc[1] += xv[1] * wa[1]; acc[2] += xv[2] * wa[2]; acc[3] += xv[3] * wa[3];
                    acc[4] += xv[4] * wb[0]; acc[5] += xv[5] * wb[1]; acc[6] += xv[6] * wb[2]; acc[7] += xv[7] * wb[3]; }
            }
        }
        *(u32x4*)(xs + pos * 72 + cgi * 8) = pack8(acc);
#pragma unroll
        for (int k = 0; k < 8; ++k) xf[pos * 65 + cgi * 8 + k] = acc[k];
    }
    __syncthreads();
    {
        const int g = w >> 2, nt = w & 3, lr = L & 15, lq = L >> 4;
        const bf16_t* WG = (const bf16_t*)(p.ws + WS_WG) + (size_t)(n * 2 + g) * 4096;
        bf16x8 b[2];
#pragma unroll
        for (int s = 0; s < 2; ++s) b[s] = *(const bf16x8*)(WG + (16 * nt + lr) * 64 + 32 * s + lq * 8);
        const float bias = p.in[g ? 18 : 16][l * 1024 + n * 64 + 16 * nt + lr];
#pragma unroll
        for (int mt = 0; mt < 4; ++mt) {
            f32x4 c = {0.f, 0.f, 0.f, 0.f};
#pragma unroll
            for (int s = 0; s < 2; ++s) { const bf16x8 a = *(const bf16x8*)(xs + (16 * mt + lr) * 72 + 32 * s + lq * 8); c = mfma16(a, b[s], c); }
#pragma unroll
            for (int r = 0; r < 4; ++r) gr[g * 4160 + (16 * mt + lq * 4 + r) * 65 + 16 * nt + lr] = sigmoidf_(c[r] + bias);
        }
    }
    __syncthreads();
    {
        const int ch = tid & 63; const float sp = softplusf_(-p.in[19][l * 1024 + n * 64 + ch]);
#pragma unroll
        for (int k = 0; k < 8; ++k) { const int tok = (tid >> 6) + 8 * k, o = tok * 65 + ch;
            const float r = gr[o], ig = gr[4160 + o], x = xf[o]; const float la = -8.f * r * sp; float a = __expf(la); float bb = sqrtf(fmaxf(-expm1f(2.f * la), 0.f)) * ig * x;
            if (tok < G.valid_lo) { a = 1.f; bb = 0.f; }
            gr[o] = a; gr[4160 + o] = bb; }
    }
    __syncthreads();
    if (w == 0) {
        const int ch = L; float A = 1.f, hh = 0.f;
        float* HL = p.out + OS_HL; bf16_t* AC = (bf16_t*)(p.out + OS_AC);
#pragma unroll 4
        for (int tok = 0; tok < 64; ++tok) { const float a = gr[tok * 65 + ch], b = gr[4160 + tok * 65 + ch]; hh = a * hh + b; A *= a;
            if (tok >= G.valid_lo) { const size_t o = (size_t)(G.row0 + tok) * 1024 + n * 64 + ch; HL[o] = hh; AC[o] = (bf16_t)(pk2(A, 0.f) & 0xffffu); } }
        ((float*)(p.ws + WS_ACH))[sc * 1024 + n * 64 + ch] = A; ((float*)(p.ws + WS_BCH))[sc * 1024 + n * 64 + ch] = hh;
    }
    __syncthreads();
}

struct Frags { bf16x8 a1[4]; bf16x8 a2[2]; bf16x8 ke[2]; u32x2 u[2]; float ge; };
__device__ __forceinline__ void chain_load(Frags& f, const unsigned char* ib, const float* GE, int item, int role, int mt, int w, int d, int L) {
    const unsigned char* a1b = ib + (role ? 16384 : 0);
#pragma unroll
    for (int s = 0; s < 4; ++s) f.a1[s] = *(const bf16x8*)(a1b + (size_t)((mt * 4 + s) * 64 + L) * 16);
    if (role) {
#pragma unroll
        for (int s = 0; s < 2; ++s) f.a2[s] = *(const bf16x8*)(ib + 49152 + (size_t)((mt * 2 + s) * 64 + L) * 16);
    } else {
#pragma unroll
        for (int nt = 0; nt < 2; ++nt) f.u[nt] = *(const u32x2*)(ib + 57344 + (size_t)((mt * 8 + 2 * d + nt) * 64 + L) * 8);
    }
#pragma unroll
    for (int s = 0; s < 2; ++s) f.ke[s] = *(const bf16x8*)(ib + 32768 + (size_t)((w * 2 + s) * 64 + L) * 16);
    f.ge = GE[item];
}
__device__ __forceinline__ void chain_step(const Frags& f, f32x4 (&S)[2], unsigned char* St, unsigned char* wt, int role, int mt, int w, int L, float* Orow, int valid_lo) {
    const int lr = L & 15, lq = L >> 4;
    f32x4 acc[2]; acc[0] = (f32x4){0.f, 0.f, 0.f, 0.f}; acc[1] = acc[0];
#pragma unroll
    for (int s = 0; s < 4; ++s)
#pragma unroll
        for (int nt = 0; nt < 2; ++nt) { const bf16x8 b = *(const bf16x8*)(St + (16 * nt + lr) * 272 + (32 * s + lq * 8) * 2); acc[nt] = mfma16(f.a1[s], b, acc[nt]); }
    if (!role) {
#pragma unroll
        for (int nt = 0; nt < 2; ++nt) { u32x2 o; o.x = pk2(bflo(f.u[nt].x) - acc[nt][0], bfhi(f.u[nt].x) - acc[nt][1]); o.y = pk2(bflo(f.u[nt].y) - acc[nt][2], bfhi(f.u[nt].y) - acc[nt][3]);
            *(u32x2*)(wt + (16 * nt + lr) * 144 + (16 * mt + lq * 4) * 2) = o; }
    }
    __syncthreads();
    bf16x8 bw[2][2];
#pragma unroll
    for (int nt = 0; nt < 2; ++nt)
#pragma unroll
        for (int s = 0; s < 2; ++s) bw[nt][s] = *(const bf16x8*)(wt + (16 * nt + lr) * 144 + (32 * s + lq * 8) * 2);
    if (role) {
#pragma unroll
        for (int nt = 0; nt < 2; ++nt) {
#pragma unroll
            for (int s = 0; s < 2; ++s) acc[nt] = mfma16(f.a2[s], bw[nt][s], acc[nt]);
#pragma unroll
            for (int r = 0; r < 4; ++r) { const int i = 16 * mt + lq * 4 + r; if (i >= valid_lo) Orow[(ptrdiff_t)i * 1024 + 16 * nt + lr] = acc[nt][r]; } }
    }
#pragma unroll
    for (int nt = 0; nt < 2; ++nt) { S[nt] = S[nt] * f.ge;
#pragma unroll
        for (int s = 0; s < 2; ++s) S[nt] = mfma16(f.ke[s], bw[nt][s], S[nt]);
        u32x2 o; o.x = pk2(S[nt][0], S[nt][1]); o.y = pk2(S[nt][2], S[nt][3]);
        *(u32x2*)(St + (16 * nt + lr) * 272 + (16 * w + lq * 4) * 2) = o; }
    __syncthreads();
}
__device__ __forceinline__ void gdn_chain(const Params& p, int l, int stream, int h, int d, unsigned char* shm) {
    const int tid = fresh_tid(), L = tid & 63, w = tid >> 6, role = w >> 2, mt = w & 3, lr = L & 15, lq = L >> 4;
    const bool samp = stream >= 2; const int s = stream - 2;
    const int sc0 = samp ? 258 + s : stream * 129, nsteps = samp ? 1 : 129;
    unsigned char* St = shm; unsigned char* wt = shm + 8704;
    const float* GE = (const float*)(p.ws + WS_GE);
    float* O = (float*)(p.ws + WS_HN);
    f32x4 S[2];
#pragma unroll
    for (int nt = 0; nt < 2; ++nt)
#pragma unroll
        for (int r = 0; r < 4; ++r) S[nt][r] = samp ? p.in[5][((size_t)((l * 16 + s) * 8 + h) * 128 + 16 * w + lq * 4 + r) * 128 + 32 * d + 16 * nt + lr] : 0.f;
#pragma unroll
    for (int nt = 0; nt < 2; ++nt) { u32x2 o; o.x = pk2(S[nt][0], S[nt][1]); o.y = pk2(S[nt][2], S[nt][3]); *(u32x2*)(St + (16 * nt + lr) * 272 + (16 * w + lq * 4) * 2) = o; }
    Frags fa, fb;
    const unsigned char* gch = p.ws + WS_GCH;
    chain_load(fa, gch + (size_t)(sc0 * 8 + h) * 73728, GE, sc0 * 8 + h, role, mt, w, d, L);
    __syncthreads();
    const ptrdiff_t rbase = samp ? (ptrdiff_t)(SROW0 + 16 * s - 48) : (ptrdiff_t)(stream * TP - 48);
    for (int c = 0; c < nsteps; c += 2) {
        if (c + 1 < nsteps) { const int it = (sc0 + c + 1) * 8 + h; chain_load(fb, gch + (size_t)it * 73728, GE, it, role, mt, w, d, L); }
        chain_step(fa, S, St, wt, role, mt, w, L, O + (rbase + 64 * c) * 1024 + h * 128 + 32 * d, (c == 0) ? 48 : 0);
        if (c + 1 < nsteps) {
            if (c + 2 < nsteps) { const int it = (sc0 + c + 2) * 8 + h; chain_load(fa, gch + (size_t)it * 73728, GE, it, role, mt, w, d, L); }
            chain_step(fb, S, St, wt, role, mt, w, L, O + (rbase + 64 * (c + 1)) * 1024 + h * 128 + 32 * d, 0);
        }
    }
    float* dst = p.out + (samp ? O_SDL + (size_t)((l * 16 + s) * 8 + h) * 16384 : O_PDL + (size_t)((l * 2 + stream) * 8 + h) * 16384);
#pragma unroll
    for (int nt = 0; nt < 2; ++nt)
#pragma unroll
        for (int r = 0; r < 4; ++r) dst[(size_t)(16 * w + lq * 4 + r) * 128 + 32 * d + 16 * nt + lr] = S[nt][r];
}
__device__ __forceinline__ void chain_phase(const Params& p, int l, unsigned char* shm) {
    const int bid = blockIdx.x;
    if (bid < 64) { const int pair = (bid & 7) * 2 + ((bid >> 3) >> 2), d = (bid >> 3) & 3; gdn_chain(p, l, pair >> 3, pair & 7, d, shm); return; }
    const int r = bid - 64, nr = gridDim.x - 64;
    const float* ACH = (const float*)(p.ws + WS_ACH); const float* BCH = (const float*)(p.ws + WS_BCH); float* CARRY = (float*)(p.ws + WS_CARRY);
    for (int g = r * 512 + fresh_tid(); g < 2048 + 16384; g += nr * 512) {
        if (g < 2048) { const int b = g >> 10, ch = g & 1023; float carry = 0.f;
            for (int c = 0; c < 129; ++c) { const size_t o = (size_t)(b * 129 + c) * 1024 + ch; CARRY[o] = carry; carry = ACH[o] * carry + BCH[o]; }
        } else { const int e = g - 2048, s = e >> 10, ch = e & 1023; CARRY[(size_t)(258 + s) * 1024 + ch] = p.in[3][(size_t)(l * 16 + s) * 1024 + ch]; }
    }
    for (int q = r; q < 512; q += nr) { const int pair = q >> 2, d = q & 3; gdn_chain(p, l, 2 + (pair >> 3), pair & 7, d, shm); }
}

__device__ __forceinline__ void mix_out_phase(const Params& p, int l) {
    const int tid = fresh_tid(), lane = tid & 63, wid = tid >> 6;
    bf16_t* HN = (bf16_t*)(p.ws + WS_HN); const bf16_t* PROJ = (const bf16_t*)(p.ws + WS_PROJ);
    const float* HL = p.out + OS_HL; const bf16_t* AC = (const bf16_t*)(p.out + OS_AC); const float* CARRY = (const float*)(p.ws + WS_CARRY);
    for (int row = blockIdx.x * 8 + wid; row < MROWS; row += gridDim.x * 8) {
        int sc, t, T, stream; bool samp = row >= SROW0;
        if (!samp) { stream = row / TP; t = row % TP; T = TP; sc = stream * 129 + (t + 48) / 64; }
        else { const int r = row - SROW0; stream = r >> 4; t = r & 15; T = 16; sc = 258 + stream; }
        const float* Orow = (const float*)(HN + (size_t)row * D);
        f32x4 o4[4], h4[4]; float ssA = 0.f, ssB[4];
#pragma unroll
        for (int q = 0; q < 4; ++q) { const int idx = 4 * lane + 256 * q; o4[q] = *(const f32x4*)(Orow + idx);
            const f32x4 hl = *(const f32x4*)(HL + (size_t)row * 1024 + idx); const u32x2 ac = *(const u32x2*)(AC + (size_t)row * 1024 + idx); const f32x4 ci = *(const f32x4*)(CARRY + (size_t)sc * 1024 + idx);
            h4[q][0] = hl[0] + bflo(ac.x) * ci[0]; h4[q][1] = hl[1] + bfhi(ac.x) * ci[1]; h4[q][2] = hl[2] + bflo(ac.y) * ci[2]; h4[q][3] = hl[3] + bfhi(ac.y) * ci[3];
#if TEST_SKIP == 1 || TEST_SKIP == 3
            h4[q] = (f32x4){0.f, 0.f, 0.f, 0.f};
#elif TEST_SKIP == 2
            o4[q] = (f32x4){0.f, 0.f, 0.f, 0.f};
#endif
            ssA += h4[q][0] * h4[q][0] + h4[q][1] * h4[q][1] + h4[q][2] * h4[q][2] + h4[q][3] * h4[q][3];
            ssB[q] = o4[q][0] * o4[q][0] + o4[q][1] * o4[q][1] + o4[q][2] * o4[q][2] + o4[q][3] * o4[q][3]; }
#pragma unroll
        for (int o = 1; o < 64; o <<= 1) ssA += __shfl_xor(ssA, o);
#pragma unroll
        for (int q = 0; q < 4; ++q) {
#pragma unroll
            for (int o = 1; o < 32; o <<= 1) ssB[q] += __shfl_xor(ssB[q], o); }
        const float rsA = rsqrtf(ssA * (1.f / 1024.f) + EPS);
        u32x2 ga[4], zz[4];
#pragma unroll
        for (int q = 0; q < 4; ++q) { const int idx = 4 * lane + 256 * q; ga[q] = *(const u32x2*)(PROJ + (size_t)row * PLD + 1024 + idx); zz[q] = *(const u32x2*)(PROJ + (size_t)row * PLD + 5120 + idx); }
        asm volatile("s_waitcnt vmcnt(0)" ::: "memory");
#pragma unroll
        for (int q = 0; q < 4; ++q) { const int idx = 4 * lane + 256 * q;
            const f32x4 na = *(const f32x4*)(p.in[20] + l * 1024 + idx); const f32x4 nb = *(const f32x4*)(p.in[24] + l * 128 + (idx & 127));
            const float rsB = rsqrtf(ssB[q] * (1.f / 128.f) + EPS);
            const float g0 = gelu_tanh(bflo(ga[q].x)), g1 = gelu_tanh(bfhi(ga[q].x)), g2 = gelu_tanh(bflo(ga[q].y)), g3 = gelu_tanh(bfhi(ga[q].y));
            u32x2 ya; ya.x = pk2(h4[q][0] * rsA * na[0] * g0, h4[q][1] * rsA * na[1] * g1); ya.y = pk2(h4[q][2] * rsA * na[2] * g2, h4[q][3] * rsA * na[3] * g3);
            const float z0 = siluf_(bflo(zz[q].x)), z1 = siluf_(bfhi(zz[q].x)), z2 = siluf_(bflo(zz[q].y)), z3 = siluf_(bfhi(zz[q].y));
            u32x2 yb; yb.x = pk2(o4[q][0] * rsB * nb[0] * z0, o4[q][1] * rsB * nb[1] * z1); yb.y = pk2(o4[q][2] * rsB * nb[2] * z2, o4[q][3] * rsB * nb[3] * z3);
#if TEST_SKIP == 3
            yb.x = pk2(o4[q][0], o4[q][1]); yb.y = pk2(o4[q][2], o4[q][3]);
#endif
            *(u32x2*)(HN + (size_t)row * D + idx) = ya; *(u32x2*)(HN + (size_t)row * D + 1024 + idx) = yb; }
        if (t >= T - 3) {
            const int j = t - (T - 3);
            float* lru = p.out + (samp ? O_SLRU + (size_t)(l * 16 + stream) * 1024 : O_PLRU + (size_t)(l * 2 + stream) * 1024);
            float* ca = p.out + (samp ? O_SCA + ((size_t)(l * 16 + stream) * 3 + j) * 1024 : O_PCA + ((size_t)(l * 2 + stream) * 3 + j) * 1024);
            float* cb = p.out + (samp ? O_SCB + ((size_t)(l * 16 + stream) * 3 + j) * 3072 : O_PCB + ((size_t)(l * 2 + stream) * 3 + j) * 3072);
#pragma unroll
            for (int q = 0; q < 4; ++q) { const int idx = 4 * lane + 256 * q; if (t == T - 1) *(f32x4*)(lru + idx) = h4[q];
                const u32x2 v = *(const u32x2*)(PROJ + (size_t)row * PLD + idx); *(f32x4*)(ca + idx) = (f32x4){bflo(v.x), bfhi(v.x), bflo(v.y), bfhi(v.y)}; }
#pragma unroll
            for (int q = 0; q < 12; ++q) { const int idx = 4 * lane + 256 * q; const u32x2 v = *(const u32x2*)(PROJ + (size_t)row * PLD + 2048 + idx);
                *(f32x4*)(cb + idx) = (f32x4){bflo(v.x), bfhi(v.x), bflo(v.y), bfhi(v.y)}; }
        }
    }
}

template <class Epi> __device__ __forceinline__ void run_gemm(unsigned char* shm, const bf16_t* A, const bf16_t* Bt, int N, int K, const Epi& E) {
    pg8::Gemm g; g.A = A; g.Bt = Bt; g.M = MP; g.N = N; g.K = K;
    pg8::StaticOrder S; S.init(MP, N, (int)gridDim.x, (int)blockIdx.x);
    pg8::gemm_phase<Epi, pg8::StaticOrder, false>((PG8_LAS unsigned char*)shm, g, S, E, nullptr);
}

__global__ void __launch_bounds__(512, 2) mega(Params p) {
    extern __shared__ __attribute__((aligned(16))) unsigned char shm[];
    bf16_t* HN = (bf16_t*)(p.ws + WS_HN); bf16_t* HID = (bf16_t*)(p.ws + WS_PROJ); float* X = (float*)(p.ws + WS_X);
    for (int ph = p.ph_lo; ph < p.ph_hi; ++ph) {
        const int l = ph / 12, kind = (ph == 24) ? 12 : ph % 12;
        if (PH_ON(0) && kind == 0) { prep_phase(p, l, (float*)shm); if (l == 0) norm_phase<1>(p, p.in[7]); else norm_phase<0>(p, p.in[7] + l * D); }
        else if (PH_ON(1) && (kind == 1 || kind == 10 || kind == 2 || kind == 11 || kind == 8 || kind == 4)) {
            EpiAll E; E.mode = (kind == 1 || kind == 10) ? 0 : (kind == 4 ? 2 : 1); E.Ob = (E.mode == 0) ? HID : (bf16_t*)(p.ws + WS_PROJ); E.Of = X; E.BA = (float*)(p.ws + WS_BA); E.scale = kind == 8 ? 1.f : 0.5f;
            const bf16_t* A = (kind == 2 || kind == 11) ? HID : HN;
            size_t wo; int N, K;
            if (kind == 1) { wo = WS_WGU1; N = NGU; K = D; } else if (kind == 10) { wo = WS_WGU2; N = NGU; K = D; } else if (kind == 2) { wo = WS_WD1; N = D; K = DFF; }
            else if (kind == 11) { wo = WS_WD2; N = D; K = DFF; } else if (kind == 8) { wo = WS_WOUT; N = D; K = D; } else { wo = WS_WIN; N = NINP; K = D; }
            run_gemm(shm, A, (const bf16_t*)(p.ws + wo), N, K, E); }
        else if (PH_ON(3) && kind == 3) norm_phase<0>(p, p.in[11] + l * D);
        else if (PH_ON(3) && kind == 9) norm_phase<0>(p, p.in[26] + l * D);
        else if (PH_ON(5) && kind == 5) {
            for (int it = blockIdx.x; it < NSC * 8 + NSC * 16; it += gridDim.x) {
                if (it < NSC * 8) { if (PH_ON(13)) gdn_item(p, l, it >> 3, it & 7, shm); } else if (PH_ON(14)) { const int r = it - NSC * 8; lru_item(p, l, r >> 4, r & 15, shm); } }
        }
        else if (PH_ON(6) && kind == 6) chain_phase(p, l, shm);
        else if (PH_ON(7) && kind == 7) mix_out_phase(p, l);
        else if (PH_ON(12) && kind == 12) norm_phase<2>(p, p.in[30]);
        if (ph + 1 < p.ph_hi) { __threadfence(); cg::this_grid().sync(); }
    }
}

extern "C" void kernel_launch(void* const* d_in, const int* in_sizes, int n_in, void* d_out, int out_size, void* d_ws, size_t ws_size, hipStream_t stream) {
    static int grid = 0;
    if (grid == 0) {
        if (n_in != 31 || ws_size < WS_END) { fprintf(stderr, "kernel_launch: unexpected n_in %d or ws_size %zu (need %zu)\n", n_in, ws_size, (size_t)WS_END); grid = -1; return; }
        int dev = 0, cus = 0, per_cu = 0;
        hipGetDevice(&dev); hipDeviceGetAttribute(&cus, hipDeviceAttributeMultiprocessorCount, dev);
        if (hipFuncSetAttribute((const void*)mega, hipFuncAttributeMaxDynamicSharedMemorySize, LDS_BYTES) != hipSuccess) { fprintf(stderr, "kernel_launch: hipFuncSetAttribute failed\n"); grid = -1; return; }
        if (hipOccupancyMaxActiveBlocksPerMultiprocessor(&per_cu, (const void*)mega, 512, LDS_BYTES) != hipSuccess || per_cu < 1) { fprintf(stderr, "kernel_launch: occupancy query says %d\n", per_cu); per_cu = 1; }
        (void)hipGetLastError();
        grid = cus;
        if (grid < 128) { fprintf(stderr, "kernel_launch: only %d CUs\n", grid); grid = -1; return; }
    }
    if (grid < 0) return;
    Params p{};
#if TEST_MEMSET
    (void)hipMemsetAsync((unsigned char*)d_ws + WS_X, 0, WS_END - WS_X, stream);
#endif
    for (int i = 0; i < 31; ++i) p.in[i] = (const float*)d_in[i];
    p.out = (float*)d_out; p.ws = (unsigned char*)d_ws;
#if N_LAUNCH_MODE == 1
    p.ph_lo = 0; p.ph_hi = 25;
    void* args[] = {&p};
    hipError_t e = hipLaunchCooperativeKernel((const void*)mega, dim3(grid), dim3(512), args, LDS_BYTES, stream);
    if (e != hipSuccess) fprintf(stderr, "cooperative launch failed: %s (grid %d)\n", hipGetErrorString(e), grid);
#else
    for (int ph = 0; ph < 25; ++ph) { p.ph_lo = ph; p.ph_hi = ph + 1; hipLaunchKernelGGL(mega, dim3(grid), dim3(512), LDS_BYTES, stream, p); }
#endif
}
```

```cpp
#include <hip/hip_runtime.h>
#include <hip/hip_cooperative_groups.h>
#include <cstdio>
namespace cg = cooperative_groups;
namespace pg8 {
#define PG8_LAS __attribute__((address_space(3)))
typedef unsigned short bf16_t;
typedef short bf16x8 __attribute__((ext_vector_type(8)));
typedef float f32x4 __attribute__((ext_vector_type(4)));
typedef unsigned u32x4 __attribute__((ext_vector_type(4)));
constexpr int BM = 256, BK = 64, HALF = 128, HTB = HALF * BK * 2  , STAGE_BYTES = 8 * HTB, NXCD = 8, WGM = 8;
__host__ __device__ __forceinline__ int lds_byte(int r, int c) { const int st = (r >> 4) * 2 + (c >> 5), rr = r & 15, cc = c & 31, ob = rr * 64 + cc * 2; return st * 1024 + (ob ^ (((ob >> 9) & 1) << 5)); }
__host__ __device__ __forceinline__ void stage_rc(int b, int& R, int& C) { const int st = b / 1024, sb = b % 1024, swz = sb ^ (((sb >> 9) & 1) << 5); R = (st >> 1) * 16 + swz / 64; C = (st & 1) * 32 + (swz % 64) / 2; }
__host__ __device__ __forceinline__ int perm32(int rho) { const int n = rho >> 4, i = rho & 15; return 8 * (i >> 2) + 4 * n + (i & 3); }
struct Unit { int pm, pn, kt0, nkt, part; };
struct Gemm { const bf16_t* A; const bf16_t* Bt; int M, N, K, fake; };
struct StaticOrder {
    int nM, nN, nwg, G, c;
    __host__ __device__ void init(int M, int N, int G_, int c_) { nM = M / BM; nN = N / BM; nwg = nM * nN; G = G_; c = c_; }
    __host__ __device__ bool next(int i, Unit& u) const {
        const long L = (long)i * G + c; if (L >= nwg) return false;
        int wgid = (int)L; { const int q = nwg / NXCD, r = nwg % NXCD, xcd = wgid % NXCD, off = wgid / NXCD; wgid = (xcd < r ? xcd * (q + 1) : r * (q + 1) + (xcd - r) * q) + off; }
        const int nig = WGM * nN, gid = wgid / nig, fm = gid * WGM, gsz = (nM - fm) < WGM ? (nM - fm) : WGM;
        u.pm = fm + ((wgid % nig) % gsz); u.pn = (wgid % nig) / gsz; return true;
    }
    __device__ __forceinline__ void a_ready(const Unit&) const {}
    __device__ __forceinline__ void done(const Unit&) const {}
};
__device__ __forceinline__ unsigned cvt_pk_bf16(float lo, float hi) { unsigned r; asm volatile("v_cvt_pk_bf16_f32 %0, %1, %2" : "=v"(r) : "v"(lo), "v"(hi)); return r; }
template <class Epi, class Sched, bool STAMP = false>
__device__ __forceinline__ void gemm_phase(PG8_LAS unsigned char* lds, const Gemm g, const Sched& S, const Epi& E, unsigned long long* stamps) {
    int tid_ = threadIdx.x; asm volatile("" : "+v"(tid_)); const int tid = tid_, wid = __builtin_amdgcn_readfirstlane(tid >> 6), lane = tid & 63, wr = wid >> 2, wc = wid & 3, fr = lane & 15, fq = lane >> 4;
    const int K = g.K; int nt;
    int ts_lo = 0, ts_hi = 0, nts = 0; const unsigned long long rt_entry = STAMP ? (unsigned long long)wall_clock64() : 0ull;
#define PG8_STAMP() do { if (STAMP && wid == 0 && nts < 64) { const unsigned long long _c = (unsigned long long)clock64(); \
        ts_lo = (lane == nts) ? (int)(unsigned)_c : ts_lo; ts_hi = (lane == nts) ? (int)(unsigned)(_c >> 32) : ts_hi; ++nts; } } while (0)
    PG8_STAMP();
    unsigned voffA[2], voffB[2];
#pragma unroll
    for (int i = 0; i < 2; ++i) { int R, C; stage_rc(tid * 16 + i * 8192, R, C); const int Rb = E.perm() ? ((R & ~31) + perm32(R & 31)) : R;
        voffA[i] = (unsigned)(R * K + C) * 2u; voffB[i] = (unsigned)(Rb * K + C) * 2u; }
    const size_t kstep = (size_t)(BK * 2);
    const size_t hstep = (size_t)HALF * K * 2;
    const size_t tstep = 2 * hstep;
    const unsigned ldsw = (unsigned)wid * 1024u;
    const int aoff = lds_byte(wr * 64 + fr, fq * 8), boff = lds_byte(wc * 32 + fr, fq * 8);
#define PG8_SA(b, h) (((b) * 2 + (h)) * HTB)
#define PG8_SB(b, h) ((4 + (b) * 2 + (h)) * HTB)
#define PG8_STAGE(bufoff, gbase, voff) do { _Pragma("unroll") for (int _i = 0; _i < 2; ++_i) \
        __builtin_amdgcn_global_load_lds((const unsigned*)((const char*)(gbase) + (voff)[_i]), (PG8_LAS unsigned*)(lds + (bufoff) + ldsw + _i * 8192), 16, 0, 0); } while (0)
#define PG8_LDA(dst, b, h) do { _Pragma("unroll") for (int m = 0; m < 4; ++m) _Pragma("unroll") for (int k = 0; k < 2; ++k) dst[m][k] = *(const PG8_LAS bf16x8*)(lds + PG8_SA(b, h) + aoff + m * 2048 + k * 1024); } while (0)
#define PG8_LDB(dst, b, h) do { _Pragma("unroll") for (int n = 0; n < 2; ++n) _Pragma("unroll") for (int k = 0; k < 2; ++k) dst[n][k] = *(const PG8_LAS bf16x8*)(lds + PG8_SB(b, h) + boff + n * 2048 + k * 1024); } while (0)
#define PG8_MMA(ai, bj, At, Bt) do { __builtin_amdgcn_s_setprio(1); _Pragma("unroll") for (int m = 0; m < 4; ++m) _Pragma("unroll") for (int n = 0; n < 2; ++n) _Pragma("unroll") for (int k = 0; k < 2; ++k) \
        acc[ai][bj][m][n] = __builtin_amdgcn_mfma_f32_16x16x32_bf16(Bt[n][k], At[m][k], acc[ai][bj][m][n], 0, 0, 0); __builtin_amdgcn_s_setprio(0); } while (0)
#define PG8_WAIT_V(n) asm volatile("s_waitcnt vmcnt(" #n ")" ::: "memory")
#define PG8_WAIT_L(n) asm volatile("s_waitcnt lgkmcnt(" #n ")" ::: "memory")
#define PG8_BAR __builtin_amdgcn_s_barrier()
#define PG8_SCHED __builtin_amdgcn_sched_barrier(0)
    Unit cur, nxt; int ui = 0;
    if (!S.next(0, cur)) return;
    nt = cur.nkt;
    f32x4 acc[2][2][4][2];
#pragma unroll
    for (int a = 0; a < 2; ++a)
#pragma unroll
        for (int b = 0; b < 2; ++b)
#pragma unroll
            for (int m = 0; m < 4; ++m)
#pragma unroll
                for (int n = 0; n < 2; ++n) acc[a][b][m][n] = (f32x4){0.f, 0.f, 0.f, 0.f};
    bf16x8 At[4][2], B0[2][2], B1[2][2];
    const char* cA = (const char*)g.A + (g.fake ? (size_t)0 : (size_t)cur.pm * tstep) + (size_t)cur.kt0 * (size_t)(BK * 2); const char* cB = (const char*)g.Bt + (g.fake ? (size_t)0 : (size_t)cur.pn * tstep) + (size_t)cur.kt0 * (size_t)(BK * 2);
    S.a_ready(cur);
    PG8_STAGE(PG8_SB(0, 0), cB, voffB); PG8_STAGE(PG8_SA(0, 0), cA, voffA); PG8_STAGE(PG8_SB(0, 1), cB + hstep, voffB); PG8_STAGE(PG8_SA(0, 1), cA + hstep, voffA);
    if (wr == 1) PG8_BAR;
    PG8_WAIT_V(4); PG8_BAR;
    PG8_STAGE(PG8_SB(1, 0), cB + kstep, voffB); PG8_STAGE(PG8_SA(1, 0), cA + kstep, voffA); PG8_STAGE(PG8_SB(1, 1), cB + hstep + kstep, voffB);
    PG8_WAIT_V(6); PG8_BAR;
    PG8_STAMP();
    for (;;) {
        const bool has_next = S.next(ui + 1, nxt);
        const char* nA = has_next ? (const char*)g.A + (g.fake ? (size_t)0 : (size_t)nxt.pm * tstep) + (size_t)nxt.kt0 * kstep : cA; const char* nB = has_next ? (const char*)g.Bt + (g.fake ? (size_t)0 : (size_t)nxt.pn * tstep) + (size_t)nxt.kt0 * kstep : cB;
        for (int t = 0; t < nt; t += 2) {
            const bool last = (t == nt - 2);
            const char* a1 = cA + (size_t)(t + 1) * kstep;
            const char* a2 = last ? nA : cA + (size_t)(t + 2) * kstep; const char* b2 = last ? nB : cB + (size_t)(t + 2) * kstep;
            const char* a3 = a2 + kstep; const char* b3 = b2 + kstep;
            if (last && has_next) S.a_ready(nxt);
            PG8_LDB(B0, 0, 0); PG8_SCHED; PG8_LDA(At, 0, 0); PG8_STAGE(PG8_SA(1, 1), a1 + hstep, voffA);
            PG8_WAIT_L(8); PG8_BAR; PG8_WAIT_L(0); PG8_MMA(0, 0, At, B0); PG8_BAR; PG8_SCHED;
            PG8_LDB(B1, 0, 1); PG8_STAGE(PG8_SB(0, 0), b2, voffB);
            PG8_BAR; PG8_WAIT_L(0); PG8_MMA(0, 1, At, B1); PG8_BAR;
            PG8_LDA(At, 0, 1); PG8_STAGE(PG8_SA(0, 0), a2, voffA);
            PG8_BAR; PG8_WAIT_L(0); PG8_MMA(1, 0, At, B0); PG8_BAR; PG8_SCHED;
            PG8_STAGE(PG8_SB(0, 1), b2 + hstep, voffB);
            PG8_WAIT_V(6); PG8_BAR; PG8_MMA(1, 1, At, B1); PG8_BAR;
            PG8_LDB(B0, 1, 0); PG8_SCHED; PG8_LDA(At, 1, 0); PG8_STAGE(PG8_SA(0, 1), a2 + hstep, voffA);
            PG8_WAIT_L(8); PG8_BAR; PG8_WAIT_L(0); PG8_MMA(0, 0, At, B0); PG8_BAR; PG8_SCHED;
            PG8_LDB(B1, 1, 1); PG8_STAGE(PG8_SB(1, 0), b3, voffB);
            PG8_BAR; PG8_WAIT_L(0); PG8_MMA(0, 1, At, B1); PG8_BAR;
            PG8_LDA(At, 1, 1); PG8_STAGE(PG8_SA(1, 0), a3, voffA);
            PG8_BAR; PG8_WAIT_L(0); PG8_MMA(1, 0, At, B0); PG8_BAR; PG8_SCHED;
            PG8_STAGE(PG8_SB(1, 1), b3 + hstep, voffB);
            PG8_WAIT_V(6); PG8_BAR; PG8_MMA(1, 1, At, B1); PG8_BAR;
        }
        PG8_STAMP();
        if constexpr (!Epi::AFTER_DRAIN) { E(acc, cur, wr, wc, fr, fq); S.done(cur); }
        PG8_STAMP();
        if (!has_next) break;
#pragma unroll
        for (int a = 0; a < 2; ++a)
#pragma unroll
            for (int b = 0; b < 2; ++b)
#pragma unroll
                for (int m = 0; m < 4; ++m)
#pragma unroll
                    for (int n = 0; n < 2; ++n) acc[a][b][m][n] = (f32x4){0.f, 0.f, 0.f, 0.f};
        cur = nxt; cA = nA; cB = nB; ++ui; nt = cur.nkt;
    }
    PG8_WAIT_V(0);
    if (wr == 0) PG8_BAR;
    PG8_BAR;
    if constexpr (Epi::AFTER_DRAIN) { E.fused(acc, cur, wr, wc, fr, fq, lds, wid, lane); S.done(cur); }
    PG8_STAMP();
    if (STAMP && wid == 0) { stamps[lane] = lane < nts ? (((unsigned long long)(unsigned)ts_hi << 32) | (unsigned)ts_lo) : 0ull;
        if (lane == 62) stamps[62] = rt_entry; if (lane == 63) stamps[63] = (unsigned long long)wall_clock64(); }
#undef PG8_STAMP
#undef PG8_SA
#undef PG8_SB
#undef PG8_STAGE
#undef PG8_LDA
#undef PG8_LDB
#undef PG8_MMA
#undef PG8_WAIT_V
#undef PG8_WAIT_L
#undef PG8_BAR
#undef PG8_SCHED
}
}
using pg8::bf16_t; using pg8::bf16x8; using pg8::f32x4; using pg8::u32x4;
typedef unsigned u32x2 __attribute__((ext_vector_type(2)));

constexpr int D = 2048, TP = 8208, NSS = 16;
constexpr int MROWS = 16672, MP = 16896, SROW0 = 16416;
constexpr int DFF = 5632, NGU = 11264, NINP = 6400, PLD = 6144;
constexpr int NSC = 274;
constexpr float EPS = 1e-6f;
constexpr int LDS_BYTES = 147456;
#ifndef TEST_MEMSET
#define TEST_MEMSET 0
#endif
#ifndef LRU_KEEP
#define LRU_KEEP 0
#endif
#ifndef LRU_P5
#define LRU_P5 6
#endif
#ifndef PROBE_FAKE
#define PROBE_FAKE 1
#endif
#ifndef REP_MASK
#define REP_MASK 0
#endif
#ifndef TEST_SKIP
#define TEST_SKIP 0
#endif
#ifndef PH_MASK
#define PH_MASK 0x7fff
#endif
#define PH_ON(k) (((PH_MASK) >> (k)) & 1)
#ifndef N_LAUNCH_MODE
#define N_LAUNCH_MODE 1
#endif

constexpr size_t SZ_WGU = (size_t)NGU * D * 2, SZ_WD = (size_t)D * DFF * 2, SZ_WIN = (size_t)NINP * D * 2, SZ_WOUT = (size_t)D * D * 2;
constexpr size_t WS_WGU1 = 0, WS_WD1 = WS_WGU1 + SZ_WGU, WS_WGU2 = WS_WD1 + SZ_WD, WS_WD2 = WS_WGU2 + SZ_WGU, WS_WIN = WS_WD2 + SZ_WD, WS_WOUT = WS_WIN + SZ_WIN,
    WS_WG = WS_WOUT + SZ_WOUT, WS_X = WS_WG + 262144, WS_HN = WS_X + (size_t)MP * D * 4, WS_PROJ = WS_HN + (size_t)MP * D * 2, WS_GCH = WS_PROJ + (size_t)MP * PLD * 2,
    WS_BA = WS_GCH + (size_t)NSC * 8 * 73728, WS_GE = WS_BA + (size_t)MP * 16 * 4, WS_ACH = WS_GE + 16384, WS_BCH = WS_ACH + (size_t)NSC * 1024 * 4,
    WS_CARRY = WS_BCH + (size_t)NSC * 1024 * 4, WS_PART = WS_CARRY + (size_t)NSC * 1024 * 4, WS_BAR = WS_PART + (size_t)256 * 65536 * 4, WS_END = WS_BAR + 16384;
constexpr size_t O_YP = 0, O_YS = 33554432, O_PCA = 34078720, O_PLRU = 34091008, O_PCB = 34095104, O_PDL = 34131968, O_SCA = 34656256, O_SLRU = 34754560,
    O_SCB = 34787328, O_SDL = 35082240;
constexpr size_t OS_HL = 0, OS_AC = (size_t)MROWS * 1024;

__device__ __forceinline__ int fresh_tid() { int t = threadIdx.x; asm volatile("" : "+v"(t)); return t; }
__device__ __forceinline__ void unit_of(int L, int nM, int nN, int& pm, int& pn) {
    const int nwg = nM * nN; int wgid = L; { const int q = nwg / 8, r = nwg % 8, xcd = wgid % 8, off = wgid / 8; wgid = (xcd < r ? xcd * (q + 1) : r * (q + 1) + (xcd - r) * q) + off; }
    const int nig = 8 * nN, gid = wgid / nig, fm = gid * 8, gsz = (nM - fm) < 8 ? (nM - fm) : 8;
    pm = fm + ((wgid % nig) % gsz); pn = (wgid % nig) / gsz;
}
struct Params { const float* in[31]; float* out; unsigned char* ws; int ph_lo, ph_hi; };

typedef __bf16 bf16v2 __attribute__((ext_vector_type(2)));
__device__ __forceinline__ unsigned pk2(float lo, float hi) { bf16v2 v; v[0] = (__bf16)lo; v[1] = (__bf16)hi; return __builtin_bit_cast(unsigned, v); }
__device__ __forceinline__ float bflo(unsigned u) { return __uint_as_float(u << 16); }
__device__ __forceinline__ float bfhi(unsigned u) { return __uint_as_float(u & 0xffff0000u); }
__device__ __forceinline__ float bf2f(bf16_t b) { return __uint_as_float(((unsigned)b) << 16); }
__device__ __forceinline__ float sigmoidf_(float x) { return __builtin_amdgcn_rcpf(1.f + __expf(-x)); }
__device__ __forceinline__ float siluf_(float x) { return x * __builtin_amdgcn_rcpf(1.f + __expf(-x)); }
__device__ __forceinline__ float softplusf_(float x) { return x > 20.f ? x : log1pf(__expf(x)); }
__device__ __forceinline__ float gelu_tanh(float x) { const float y = 0.7978845608028654f * (x + 0.044715f * x * x * x); const float t = 1.f - 2.f * __builtin_amdgcn_rcpf(1.f + __expf(2.f * y)); return 0.5f * x * (1.f + t); }
__device__ __forceinline__ void unpack8(const u32x4 v, float (&f)[8]) { f[0] = bflo(v.x); f[1] = bfhi(v.x); f[2] = bflo(v.y); f[3] = bfhi(v.y); f[4] = bflo(v.z); f[5] = bfhi(v.z); f[6] = bflo(v.w); f[7] = bfhi(v.w); }
__device__ __forceinline__ u32x4 pack8(const float (&f)[8]) { u32x4 o; o.x = pk2(f[0], f[1]); o.y = pk2(f[2], f[3]); o.z = pk2(f[4], f[5]); o.w = pk2(f[6], f[7]); return o; }
__device__ __forceinline__ f32x4 mfma16(bf16x8 a, bf16x8 b, f32x4 c) { return __builtin_amdgcn_mfma_f32_16x16x32_bf16(a, b, c, 0, 0, 0); }

struct EpiGU {
    static constexpr bool PERM = false, AFTER_DRAIN = false;
    bf16_t* H;
    __device__ __forceinline__ void operator()(const f32x4 (&acc)[2][2][4][2], const pg8::Unit& u, int wr, int wc, int fr, int fq) const {
        const int row0 = u.pm * 256 + wr * 64 + fr, hc0 = u.pn * 128 + wc * 16 + 4 * fq;
#pragma unroll
        for (int ai = 0; ai < 2; ++ai)
#pragma unroll
            for (int m = 0; m < 4; ++m) { u32x2 o[2];
#pragma unroll
                for (int bj = 0; bj < 2; ++bj) { const f32x4 g = acc[ai][bj][m][0], up = acc[ai][bj][m][1];
                    o[bj].x = pk2(siluf_(g[0]) * up[0], siluf_(g[1]) * up[1]); o[bj].y = pk2(siluf_(g[2]) * up[2], siluf_(g[3]) * up[3]); }
                const auto rx = __builtin_amdgcn_permlane16_swap(o[0].x, o[1].x, false, false); const auto ry = __builtin_amdgcn_permlane16_swap(o[0].y, o[1].y, false, false);
                u32x4 w; w.x = rx[0]; w.y = ry[0]; w.z = rx[1]; w.w = ry[1];
                *(u32x4*)(H + (size_t)(row0 + ai * 128 + m * 16) * DFF + u.pn * 128 + 64 * (fq & 1) + wc * 16 + 8 * (fq >> 1)) = w; }
    }
};
struct EpiRes {
    static constexpr bool PERM = false, AFTER_DRAIN = false;
    float* X; float scale; float* PART;
    __device__ __forceinline__ void operator()(const f32x4 (&acc)[2][2][4][2], const pg8::Unit& u, int wr, int wc, int fr, int fq) const {
        const bool tail = u.part != 0;
        const int rl0 = wr * 64 + fr, cl0 = wc * 32 + 4 * fq;
        float* base = tail ? PART + (size_t)rl0 * 256 + cl0 : X + (size_t)(u.pm * 256 + rl0) * D + u.pn * 256 + cl0;
        const size_t ld = tail ? 256 : D;
#pragma unroll
        for (int ai = 0; ai < 2; ++ai)
#pragma unroll
            for (int m = 0; m < 4; ++m) { float* rowp = base + (size_t)(ai * 128 + m * 16) * ld;
#pragma unroll
                for (int bj = 0; bj < 2; ++bj)
#pragma unroll
                    for (int n = 0; n < 2; ++n) { f32x4* q = (f32x4*)(rowp + bj * 128 + n * 16); f32x4 v = acc[ai][bj][m][n] * scale; if (!tail) v = v + *q; *q = v; } }
    }
};
struct EpiProj {
    static constexpr bool PERM = true, AFTER_DRAIN = false;
    bf16_t* P; float* BA;
    __device__ __forceinline__ void operator()(const f32x4 (&acc)[2][2][4][2], const pg8::Unit& u, int wr, int wc, int fr, int fq) const {
        const int row0 = u.pm * 256 + wr * 64 + fr;
        if (u.pn < 24) {
            const int col0 = u.pn * 256 + wc * 32 + 8 * fq;
#pragma unroll
            for (int ai = 0; ai < 2; ++ai)
#pragma unroll
                for (int m = 0; m < 4; ++m) { bf16_t* rowp = P + (size_t)(row0 + ai * 128 + m * 16) * PLD + col0;
#pragma unroll
                    for (int bj = 0; bj < 2; ++bj) { const f32x4 v0 = acc[ai][bj][m][0], v1 = acc[ai][bj][m][1];
                        u32x4 w; w.x = pk2(v0[0], v0[1]); w.y = pk2(v0[2], v0[3]); w.z = pk2(v1[0], v1[1]); w.w = pk2(v1[2], v1[3]);
                        *(u32x4*)(rowp + bj * 128) = w; } }
        } else if (wc == 0 && fq < 2) {
#pragma unroll
            for (int ai = 0; ai < 2; ++ai)
#pragma unroll
                for (int m = 0; m < 4; ++m) { float* q = BA + (size_t)(row0 + ai * 128 + m * 16) * 16 + 8 * fq;
                    *(f32x4*)q = acc[ai][0][m][0]; *(f32x4*)(q + 4) = acc[ai][0][m][1]; }
        }
    }
};

struct EpiAll {
    static constexpr bool AFTER_DRAIN = false;
    int mode; bf16_t* Ob; float* Of; float* BA; float scale; float* PART;
    __device__ __forceinline__ bool perm() const { return mode == 2; }
    __device__ __forceinline__ void operator()(const f32x4 (&acc)[2][2][4][2], const pg8::Unit& u, int wr, int wc, int fr, int fq) const {
        if (mode == 3) {
            f32x4 s = {0.f, 0.f, 0.f, 0.f};
#pragma unroll
            for (int ai = 0; ai < 2; ++ai)
#pragma unroll
                for (int bj = 0; bj < 2; ++bj)
#pragma unroll
                    for (int m = 0; m < 4; ++m)
#pragma unroll
                        for (int n = 0; n < 2; ++n) s = s + acc[ai][bj][m][n];
            if (s[0] + s[1] + s[2] + s[3] == 12345.678f) BA[0] = s[0];
            return; }
        if (mode == 0) { EpiGU e; e.H = Ob; e(acc, u, wr, wc, fr, fq); }
        else if (mode == 1) { EpiRes e; e.X = Of; e.scale = scale; e.PART = PART; e(acc, u, wr, wc, fr, fq); }
        else { EpiProj e; e.P = Ob; e.BA = BA; e(acc, u, wr, wc, fr, fq); }
    }
};

__device__ __forceinline__ void tr_tile(const float* W, int K, int N, int kb, int nb, bf16_t* dst, int mode, float* tile) {
    const int tid = fresh_tid(), k0 = kb * 64, n0 = nb * 64;
    { const int nn = tid & 63, kq = tid >> 6, n = n0 + nn;
#pragma unroll
        for (int r = 0; r < 8; ++r) { const int kk = r * 8 + kq; tile[kk * 65 + nn] = (n < N) ? W[(size_t)(k0 + kk) * N + n] : 0.f; } }
    __syncthreads();
    { const int nn = tid >> 3, kc = tid & 7, n = n0 + nn; int drow = n;
        if (mode == 1) drow = (n >> 4) * 32 + (n & 15); else if (mode == 2) drow = (n >> 4) * 32 + 16 + (n & 15);
        const float* s = tile + (kc * 8) * 65 + nn; u32x4 o; o.x = pk2(s[0], s[65]); o.y = pk2(s[130], s[195]); o.z = pk2(s[260], s[325]); o.w = pk2(s[390], s[455]);
        *(u32x4*)(dst + (size_t)drow * K + k0 + kc * 8) = o; }
    __syncthreads();
}
struct TrJob { const float* W; bf16_t* dst; int K, N, mode, kb, nb; };
__device__ __forceinline__ TrJob prep_job(const Params& p, int l, int it) {
    TrJob j;
    if (it < 4224) { const int m = it / 704, r = it % 704, f = m / 3, w = m % 3;
        j.W = p.in[(f ? 27 : 8) + w] + (size_t)l * 2048 * 5632;
        if (w < 2) { j.K = 2048; j.N = 5632; j.kb = r / 22; j.nb = r % 22; j.mode = w + 1; j.dst = (bf16_t*)(p.ws + (f ? WS_WGU2 : WS_WGU1)); }
        else { j.K = 5632; j.N = 2048; j.kb = r / 8; j.nb = r % 8; j.mode = 0; j.dst = (bf16_t*)(p.ws + (f ? WS_WD2 : WS_WD1)); }
    } else if (it < 5024) { const int r = it - 4224; j.W = p.in[12] + (size_t)l * 2048 * 6160; j.K = 2048; j.N = 6160; j.kb = r / 25; j.nb = r % 25; j.mode = 0; j.dst = (bf16_t*)(p.ws + WS_WIN);
    } else { const int r = it - 5024; j.W = p.in[25] + (size_t)l * 2048 * 2048; j.K = 2048; j.N = 2048; j.kb = r / 8; j.nb = r % 8; j.mode = 0; j.dst = (bf16_t*)(p.ws + WS_WOUT); }
    return j;
}
__device__ __forceinline__ void tr_load(const TrJob& j, f32x4 (&v)[8], int tid) {
    const int lane = tid & 63, wid = tid >> 6, n = j.nb * 256 + lane * 4;
#pragma unroll
    for (int ps = 0; ps < 8; ++ps) v[ps] = (n < j.N) ? *(const f32x4*)(j.W + (size_t)(j.kb * 64 + ps * 8 + wid) * j.N + n) : (f32x4){0.f, 0.f, 0.f, 0.f};
}
__device__ __forceinline__ void prep_phase(const Params& p, int l, float* tile) {
    constexpr int NJ = 5280;
    const int tid = fresh_tid(), lane = tid & 63, wid = tid >> 6;
    int it = blockIdx.x; f32x4 v[8]; TrJob job;
    if (it < NJ) { job = prep_job(p, l, it); tr_load(job, v, tid); }
    while (it < NJ) {
#pragma unroll
        for (int ps = 0; ps < 8; ++ps) *(f32x4*)(tile + (ps * 8 + wid) * 260 + lane * 4) = v[ps];
        __syncthreads();
        const TrJob cur = job; it += gridDim.x;
        if (it < NJ) { job = prep_job(p, l, it); tr_load(job, v, tid); }
#pragma unroll
        for (int r = 0; r < 4; ++r) { const int q = tid + 512 * r, nl = q & 255, kc = q >> 8, n = cur.nb * 256 + nl; int drow = n;
            if (cur.mode == 1) drow = (n >> 4) * 32 + (n & 15); else if (cur.mode == 2) drow = (n >> 4) * 32 + 16 + (n & 15);
            const float* s = tile + (kc * 8) * 260 + nl; u32x4 o; o.x = pk2(s[0], s[260]); o.y = pk2(s[520], s[780]); o.z = pk2(s[1040], s[1300]); o.w = pk2(s[1560], s[1820]);
            *(u32x4*)(cur.dst + (size_t)drow * cur.K + cur.kb * 64 + kc * 8) = o; }
        __syncthreads();
    }
    for (int r = blockIdx.x; r < 32; r += gridDim.x) { const int n = r >> 1, g = r & 1; tr_tile(p.in[g ? 17 : 15] + (size_t)l * 65536 + n * 4096, 64, 64, 0, 0, (bf16_t*)(p.ws + WS_WG) + r * 4096, 0, tile); }
}

template <int MODE>
__device__ __forceinline__ void norm_phase(const Params& p, const float* w, int ndp) {
    const int tid = fresh_tid(), lane = tid & 63, wid = tid >> 6;
    float* X = (float*)(p.ws + WS_X); bf16_t* HN = (bf16_t*)(p.ws + WS_HN);
    for (int row = blockIdx.x * 8 + wid; row < MP; row += gridDim.x * 8) {
        if (row >= MROWS) {
            if (MODE != 2) {
#pragma unroll
                for (int q = 0; q < 8; ++q) { const int idx = 4 * lane + 256 * q; *(u32x2*)(HN + (size_t)row * D + idx) = (u32x2){0u, 0u};
                    if (MODE == 1) *(f32x4*)(X + (size_t)row * D + idx) = (f32x4){0.f, 0.f, 0.f, 0.f}; } }
            continue; }
        const float* src = X + (size_t)row * D; float* dsto = nullptr;
        if (MODE != 0) {
            if (row < SROW0) { const int b = row / TP, t = row % TP;
                if (MODE == 1) src = t < 16 ? p.in[6] + (size_t)t * D : p.in[0] + ((size_t)b * 8192 + (t - 16)) * D;
                else dsto = t < 16 ? nullptr : p.out + O_YP + ((size_t)b * 8192 + (t - 16)) * D;
            } else { const int r = row - SROW0; if (MODE == 1) src = p.in[1] + (size_t)r * D; else dsto = p.out + O_YS + (size_t)r * D; }
            if (MODE == 2 && dsto == nullptr) continue;
        }
        f32x4 v[8]; float ss = 0.f;
#pragma unroll
        for (int q = 0; q < 8; ++q) v[q] = *(const f32x4*)(src + 4 * lane + 256 * q);
        if (MODE != 1 && ndp > 0 && gridDim.x == 256) {
            const int pm = row >> 8, rl = row & 255;
#pragma unroll 1
            for (int j = 0; j < 16; ++j) { int upm, upn; unit_of(512 + j, MP / 256, 8, upm, upn);
                if (upm == pm) {
                    f32x4 s = {0.f, 0.f, 0.f, 0.f};
                    for (int ks = 0; ks < ndp; ++ks) s = s + *(const f32x4*)((const float*)(p.ws + WS_PART) + (size_t)(j * ndp + ks) * 65536 + rl * 256 + 4 * lane);
#pragma unroll
                    for (int q = 0; q < 8; ++q) if (upn == q) { v[q] = v[q] + s; *(f32x4*)(X + (size_t)row * D + 4 * lane + 256 * q) = v[q]; }
                } }
        }
#pragma unroll
        for (int q = 0; q < 8; ++q) { ss += v[q][0] * v[q][0] + v[q][1] * v[q][1] + v[q][2] * v[q][2] + v[q][3] * v[q][3]; }
#pragma unroll
        for (int o = 1; o < 64; o <<= 1) ss += __shfl_xor(ss, o);
        const float rs = rsqrtf(ss * (1.f / 2048.f) + EPS);
#pragma unroll
        for (int q = 0; q < 8; ++q) { const int idx = 4 * lane + 256 * q; const f32x4 wv = *(const f32x4*)(w + idx); const f32x4 y = v[q] * rs * wv;
            if (MODE == 2) *(f32x4*)(dsto + idx) = y;
            else { u32x2 o; o.x = pk2(y[0], y[1]); o.y = pk2(y[2], y[3]); *(u32x2*)(HN + (size_t)row * D + idx) = o; if (MODE == 1) *(f32x4*)(X + (size_t)row * D + idx) = v[q]; } }
    }
}

template <int MODE>
__device__ __forceinline__ void norm_phase2(const Params& p, const float* w, int ndp) {
    const int tid = fresh_tid(), lane = tid & 63, wid = tid >> 6;
    float* X = (float*)(p.ws + WS_X); bf16_t* HN = (bf16_t*)(p.ws + WS_HN);
    const int stride = gridDim.x * 8;
    for (int row0 = blockIdx.x * 8 + wid; row0 < MP; row0 += 2 * stride) {
        f32x4 v[2][8]; float* dsto[2]; bool act[2];
#pragma unroll
        for (int t = 0; t < 2; ++t) {
            const int row = row0 + t * stride; act[t] = row < MROWS; dsto[t] = nullptr;
            if (MODE == 0 && row >= MROWS && row < MP) {
#pragma unroll
                for (int q = 0; q < 8; ++q) *(u32x2*)(HN + (size_t)row * D + 4 * lane + 256 * q) = (u32x2){0u, 0u}; }
            if (MODE == 2 && act[t]) {
                if (row < SROW0) { const int b = row / TP, tt = row % TP; dsto[t] = tt < 16 ? nullptr : p.out + O_YP + ((size_t)b * 8192 + (tt - 16)) * D; }
                else dsto[t] = p.out + O_YS + (size_t)(row - SROW0) * D;
                act[t] = dsto[t] != nullptr; }
            if (act[t]) {
#pragma unroll
                for (int q = 0; q < 8; ++q) v[t][q] = *(const f32x4*)(X + (size_t)row * D + 4 * lane + 256 * q); }
        }
#pragma unroll
        for (int t = 0; t < 2; ++t) {
            if (!act[t]) continue;
            const int row = row0 + t * stride;
            if (ndp > 0 && gridDim.x == 256) {
                const int pm = row >> 8, rl = row & 255;
#pragma unroll 1
                for (int j = 0; j < 16; ++j) { int upm, upn; unit_of(512 + j, MP / 256, 8, upm, upn);
                    if (upm == pm) {
                        f32x4 s = {0.f, 0.f, 0.f, 0.f};
                        for (int ks = 0; ks < ndp; ++ks) s = s + *(const f32x4*)((const float*)(p.ws + WS_PART) + (size_t)(j * ndp + ks) * 65536 + rl * 256 + 4 * lane);
#pragma unroll
                        for (int q = 0; q < 8; ++q) if (upn == q) { v[t][q] = v[t][q] + s; *(f32x4*)(X + (size_t)row * D + 4 * lane + 256 * q) = v[t][q]; }
                    } }
            }
            float ss = 0.f;
#pragma unroll
            for (int q = 0; q < 8; ++q) ss += v[t][q][0] * v[t][q][0] + v[t][q][1] * v[t][q][1] + v[t][q][2] * v[t][q][2] + v[t][q][3] * v[t][q][3];
#pragma unroll
            for (int o = 1; o < 64; o <<= 1) ss += __shfl_xor(ss, o);
            const float rs = rsqrtf(ss * (1.f / 2048.f) + EPS);
#pragma unroll
            for (int q = 0; q < 8; ++q) { const int idx = 4 * lane + 256 * q; const f32x4 wv = *(const f32x4*)(w + idx); const f32x4 y = v[t][q] * rs * wv;
                if (MODE == 2) *(f32x4*)(dsto[t] + idx) = y;
                else { u32x2 o; o.x = pk2(y[0], y[1]); o.y = pk2(y[2], y[3]); *(u32x2*)(HN + (size_t)row * D + idx) = o; } }
        }
    }
}

struct ChunkGeo { int row0, tok0, valid_lo, samp; };
__device__ __forceinline__ ChunkGeo chunk_geo(int sc) {
    ChunkGeo g;
    if (sc < 258) { const int b = sc / 129, c = sc % 129; g.tok0 = 64 * c - 48; g.row0 = b * TP + g.tok0; g.valid_lo = c == 0 ? 48 : 0; g.samp = -1; }
    else { const int s = sc - 258; g.tok0 = -48; g.row0 = SROW0 + 16 * s - 48; g.valid_lo = 48; g.samp = s; }
    return g;
}

__device__ __forceinline__ void gdn_item(const Params& p, int l, int sc, int h, unsigned char* shm) {
    const int tid = fresh_tid(), L = tid & 63, w = tid >> 6;
    bf16_t* qs = (bf16_t*)shm; bf16_t* ks = (bf16_t*)(shm + 17408); float* sol = (float*)(shm + 34816); float* Lm = (float*)(shm + 100352); float* qkm = (float*)(shm + 116736);
    float* gcs = (float*)(shm + 134144); float* betas = gcs + 64; float* egcs = gcs + 128;
    const ChunkGeo G = chunk_geo(sc);
    const bf16_t* PROJ = (const bf16_t*)(p.ws + WS_PROJ); const float* BA = (const float*)(p.ws + WS_BA);
    const int item = sc * 8 + h; unsigned char* ib = p.ws + WS_GCH + (size_t)item * 73728;
    if (w == 0) {
        const int i = L; float beta = 0.f, g = 0.f;
        if (i >= G.valid_lo) { const float* ba = BA + (size_t)(G.row0 + i) * 16; beta = sigmoidf_(ba[h]); g = -__expf(p.in[22][l * 8 + h]) * softplusf_(ba[8 + h] + p.in[23][l * 8 + h]); }
#pragma unroll
        for (int o = 1; o < 64; o <<= 1) { const float v = __shfl_up(g, o); if (L >= o) g += v; }
        gcs[i] = g; betas[i] = beta; egcs[i] = __expf(g);
        if (L == 63) ((float*)(p.ws + WS_GE))[item] = __expf(g);
    }
    __syncthreads();
#pragma unroll 3
    for (int r = 0; r < 6; ++r) {
        const int e = tid + 512 * r, pos = e / 48, cgi = e % 48, typ = cgi >> 4, c8 = (cgi & 15) * 8, col = typ * 1024 + h * 128 + c8;
        const bool valid = pos >= G.valid_lo;
        float acc[8];
#pragma unroll
        for (int k = 0; k < 8; ++k) acc[k] = 0.f;
        if (valid) {
#pragma unroll
            for (int j = 0; j < 4; ++j) {
                const int m = G.tok0 + pos - 3 + j; float xv[8]; bool have = true;
                if (m >= 0) { const u32x4 raw = *(const u32x4*)(PROJ + (size_t)(G.row0 + pos - 3 + j) * PLD + 2048 + col); unpack8(raw, xv); }
                else if (G.samp >= 0) { const float* sp = p.in[4] + ((size_t)(l * 16 + G.samp) * 3 + (3 + m)) * 3072 + col; const f32x4 a = *(const f32x4*)sp, b = *(const f32x4*)(sp + 4);
                    xv[0] = a[0]; xv[1] = a[1]; xv[2] = a[2]; xv[3] = a[3]; xv[4] = b[0]; xv[5] = b[1]; xv[6] = b[2]; xv[7] = b[3]; }
                else have = false;
                if (have) { const float* wp = p.in[21] + (size_t)(l * 4 + j) * 3072 + col; const f32x4 wa = *(const f32x4*)wp, wb = *(const f32x4*)(wp + 4);
                    acc[0] += xv[0] * wa[0]; acc[1] += xv[1] * wa[1]; acc[2] += xv[2] * wa[2]; acc[3] += xv[3] * wa[3];
                    acc[4] += xv[4] * wb[0]; acc[5] += xv[5] * wb[1]; acc[6] += xv[6] * wb[2]; acc[7] += xv[7] * wb[3]; }
            }
        }
        float ss = 0.f;
#pragma unroll
        for (int k = 0; k < 8; ++k) { acc[k] = siluf_(acc[k]); ss += acc[k] * acc[k]; }
        ss += __shfl_xor(ss, 1); ss += __shfl_xor(ss, 2); ss += __shfl_xor(ss, 4); ss += __shfl_xor(ss, 8);
        if (typ < 2) { const float scl = rsqrtf(ss + EPS) * (typ == 0 ? 0.08838834764831845f : 1.f);
#pragma unroll
            for (int k = 0; k < 8; ++k) acc[k] *= scl;
            *(u32x4*)((typ == 0 ? qs : ks) + pos * 136 + c8) = pack8(acc);
            if (typ == 1) { const float f = betas[pos] * egcs[pos];
#pragma unroll
                for (int k = 0; k < 8; ++k) sol[pos * 256 + 128 + c8 + k] = f * acc[k]; }
        } else { const float f = betas[pos];
#pragma unroll
            for (int k = 0; k < 8; ++k) sol[pos * 256 + c8 + k] = f * acc[k]; }
    }
    __syncthreads();
    {
        const int mat = w >> 2, mt = w & 3, lr = L & 15, lq = L >> 4;
        const bf16_t* Asrc = mat ? qs : ks; bf16x8 a[4];
#pragma unroll
        for (int s = 0; s < 4; ++s) a[s] = *(const bf16x8*)(Asrc + (16 * mt + lr) * 136 + 32 * s + lq * 8);
#pragma unroll
        for (int nt = 0; nt < 4; ++nt) {
            f32x4 c = {0.f, 0.f, 0.f, 0.f};
#pragma unroll
            for (int s = 0; s < 4; ++s) { const bf16x8 b = *(const bf16x8*)(ks + (16 * nt + lr) * 136 + 32 * s + lq * 8); c = mfma16(a[s], b, c); }
            const int j = 16 * nt + lr; const float gj = gcs[j];
#pragma unroll
            for (int r = 0; r < 4; ++r) { const int i = 16 * mt + lq * 4 + r; const float dec = __expf(fminf(gcs[i] - gj, 0.f));
                if (mat == 0) Lm[i * 64 + j] = (i > j) ? betas[i] * dec * c[r] : 0.f;
                else qkm[i * 68 + j] = (i >= j) ? dec * c[r] : 0.f; }
        }
    }
    __syncthreads();
    if (tid < 256) {
        const int c = tid;
#pragma unroll 1
        for (int B = 0; B < 4; ++B) {
            float acc[16];
#pragma unroll
            for (int r = 0; r < 16; ++r) acc[r] = sol[(16 * B + r) * 256 + c];
#pragma unroll 1
            for (int jb = 0; jb < B; ++jb) {
                float xj[16];
#pragma unroll
                for (int k = 0; k < 16; ++k) xj[k] = sol[(16 * jb + k) * 256 + c];
#pragma unroll
                for (int r = 0; r < 16; ++r) { const float* lr = Lm + (16 * B + r) * 64 + 16 * jb;
#pragma unroll
                    for (int k4 = 0; k4 < 4; ++k4) { const f32x4 lv = *(const f32x4*)(lr + 4 * k4);
                        acc[r] -= lv[0] * xj[4 * k4]; acc[r] -= lv[1] * xj[4 * k4 + 1]; acc[r] -= lv[2] * xj[4 * k4 + 2]; acc[r] -= lv[3] * xj[4 * k4 + 3]; } }
            }
#pragma unroll
            for (int r = 1; r < 16; ++r) { const float* lr = Lm + (16 * B + r) * 64 + 16 * B;
#pragma unroll
                for (int k4 = 0; k4 < (r + 3) / 4; ++k4) { const f32x4 lv = *(const f32x4*)(lr + 4 * k4);
                    if (4 * k4 < r) acc[r] -= lv[0] * acc[4 * k4];
                    if (4 * k4 + 1 < r) acc[r] -= lv[1] * acc[4 * k4 + 1];
                    if (4 * k4 + 2 < r) acc[r] -= lv[2] * acc[4 * k4 + 2];
                    if (4 * k4 + 3 < r) acc[r] -= lv[3] * acc[4 * k4 + 3]; } }
#pragma unroll
            for (int r = 0; r < 16; ++r) sol[(16 * B + r) * 256 + c] = acc[r];
        }
    } else {
        const int t2 = tid - 256; const float gl = gcs[63];
#pragma unroll
        for (int r = 0; r < 4; ++r) {
            const int q = t2 + 256 * r, Lq = q & 63, f = q >> 6, mt = f >> 2, s = f & 3, i = 16 * mt + (Lq & 15), k0 = 32 * s + (Lq >> 4) * 8;
            float v[8]; unpack8(*(const u32x4*)(qs + i * 136 + k0), v); const float e = egcs[i];
#pragma unroll
            for (int k = 0; k < 8; ++k) v[k] *= e;
            *(u32x4*)(ib + 16384 + (size_t)q * 16) = pack8(v); }
#pragma unroll
        for (int r = 0; r < 4; ++r) {
            const int q = t2 + 256 * r, Lq = q & 63, f = q >> 6, mt = f >> 1, s = f & 1, dk = 16 * mt + (Lq & 15), j0 = 32 * s + (Lq >> 4) * 8;
            float v[8];
#pragma unroll
            for (int k = 0; k < 8; ++k) v[k] = bf2f(ks[(j0 + k) * 136 + dk]) * __expf(fminf(gl - gcs[j0 + k], 0.f));
            *(u32x4*)(ib + 32768 + (size_t)q * 16) = pack8(v); }
#pragma unroll
        for (int r = 0; r < 2; ++r) {
            const int q = t2 + 256 * r, Lq = q & 63, f = q >> 6, mt = f >> 1, s = f & 1, i = 16 * mt + (Lq & 15), j0 = 32 * s + (Lq >> 4) * 8;
            float v[8]; const f32x4 a = *(const f32x4*)(qkm + i * 68 + j0), b = *(const f32x4*)(qkm + i * 68 + j0 + 4);
            v[0] = a[0]; v[1] = a[1]; v[2] = a[2]; v[3] = a[3]; v[4] = b[0]; v[5] = b[1]; v[6] = b[2]; v[7] = b[3];
            *(u32x4*)(ib + 49152 + (size_t)q * 16) = pack8(v); }
    }
    __syncthreads();
#pragma unroll
    for (int r = 0; r < 2; ++r) {
        const int q = tid + 512 * r, Lq = q & 63, f = q >> 6, mt = f >> 2, s = f & 3, i = 16 * mt + (Lq & 15), k0 = 32 * s + (Lq >> 4) * 8;
        float v[8]; const f32x4 a = *(const f32x4*)(sol + i * 256 + 128 + k0), b = *(const f32x4*)(sol + i * 256 + 128 + k0 + 4);
        v[0] = a[0]; v[1] = a[1]; v[2] = a[2]; v[3] = a[3]; v[4] = b[0]; v[5] = b[1]; v[6] = b[2]; v[7] = b[3];
        *(u32x4*)(ib + (size_t)q * 16) = pack8(v); }
#pragma unroll
    for (int r = 0; r < 4; ++r) {
        const int q = tid + 512 * r, Lq = q & 63, f = q >> 6, mt = f >> 3, ntile = f & 7, i0 = 16 * mt + (Lq >> 4) * 4, cc = 16 * ntile + (Lq & 15);
        u32x2 o; o.x = pk2(sol[i0 * 256 + cc], sol[(i0 + 1) * 256 + cc]); o.y = pk2(sol[(i0 + 2) * 256 + cc], sol[(i0 + 3) * 256 + cc]);
        *(u32x2*)(ib + 57344 + (size_t)q * 8) = o; }
    __syncthreads();
}

__device__ __forceinline__ void lru_item(const Params& p, int l, int sc, int n, unsigned char* shm) {
    const int tid = fresh_tid(), L = tid & 63, w = tid >> 6;
    bf16_t* xs = (bf16_t*)shm; float* xf = (float*)(shm + 9216); float* gr = (float*)(shm + 25856);
    const ChunkGeo G = chunk_geo(sc);
    const bf16_t* PROJ = (const bf16_t*)(p.ws + WS_PROJ);
    const int g_ = w >> 2, nt_ = w & 3, lr_ = L & 15, lq_ = L >> 4;
    bf16x8 bfr[2];
    { const bf16_t* WG = (const bf16_t*)(p.ws + WS_WG) + (size_t)(n * 2 + g_) * 4096;
#pragma unroll
        for (int s = 0; s < 2; ++s) bfr[s] = *(const bf16x8*)(WG + (16 * nt_ + lr_) * 64 + 32 * s + lq_ * 8); }
    const float bias_ = p.in[g_ ? 18 : 16][l * 1024 + n * 64 + 16 * nt_ + lr_];
    const float lam_ = p.in[19][l * 1024 + n * 64 + (tid & 63)];
    {
        const int pos = tid >> 3, cgi = tid & 7, ch0 = n * 64 + cgi * 8; float acc[8];
        { const float* bp = p.in[14] + l * 1024 + ch0; const f32x4 a = *(const f32x4*)bp, b = *(const f32x4*)(bp + 4);
            acc[0] = a[0]; acc[1] = a[1]; acc[2] = a[2]; acc[3] = a[3]; acc[4] = b[0]; acc[5] = b[1]; acc[6] = b[2]; acc[7] = b[3]; }
        if (pos >= G.valid_lo) {
#pragma unroll
            for (int j = 0; j < 4; ++j) {
                const int m = G.tok0 + pos - 3 + j; float xv[8]; bool have = true;
                if (m >= 0) { unpack8(*(const u32x4*)(PROJ + (size_t)(G.row0 + pos - 3 + j) * PLD + ch0), xv); }
                else if (G.samp >= 0) { const float* sp = p.in[2] + ((size_t)(l * 16 + G.samp) * 3 + (3 + m)) * 1024 + ch0; const f32x4 a = *(const f32x4*)sp, b = *(const f32x4*)(sp + 4);
                    xv[0] = a[0]; xv[1] = a[1]; xv[2] = a[2]; xv[3] = a[3]; xv[4] = b[0]; xv[5] = b[1]; xv[6] = b[2]; xv[7] = b[3]; }
                else have = false;
                if (have) { const float* wp = p.in[13] + (size_t)(l * 4 + j) * 1024 + ch0; const f32x4 wa = *(const f32x4*)wp, wb = *(const f32x4*)(wp + 4);
                    acc[0] += xv[0] * wa[0]; acc[1] += xv[1] * wa[1]; acc[2] += xv[2] * wa[2]; acc[3] += xv[3] * wa[3];
                    acc[4] += xv[4] * wb[0]; acc[5] += xv[5] * wb[1]; acc[6] += xv[6] * wb[2]; acc[7] += xv[7] * wb[3]; }
            }
        }
        *(u32x4*)(xs + pos * 72 + cgi * 8) = pack8(acc);
#pragma unroll
        for (int k = 0; k < 8; ++k) xf[pos * 65 + cgi * 8 + k] = acc[k];
    }
    __syncthreads();
    {
        const int g = g_, nt = nt_, lr = lr_, lq = lq_;
#pragma unroll
        for (int mt = 0; mt < 4; ++mt) {
            f32x4 c = {0.f, 0.f, 0.f, 0.f};
#pragma unroll
            for (int s = 0; s < 2; ++s) { const bf16x8 a = *(const bf16x8*)(xs + (16 * mt + lr) * 72 + 32 * s + lq * 8); c = mfma16(a, bfr[s], c); }
#pragma unroll
            for (int r = 0; r < 4; ++r) gr[g * 4160 + (16 * mt + lq * 4 + r) * 65 + 16 * nt + lr] = sigmoidf_(c[r] + bias_);
        }
    }
    __syncthreads();
    {
        const int ch = tid & 63; const float sp = softplusf_(-lam_);
#pragma unroll
        for (int k = 0; k < 8; ++k) { const int tok = (tid >> 6) + 8 * k, o = tok * 65 + ch;
            const float r = gr[o], ig = gr[4160 + o], x = xf[o]; const float la = -8.f * r * sp; float a = __expf(la); float bb = sqrtf(fmaxf(-expm1f(2.f * la), 0.f)) * ig * x;
            if (tok < G.valid_lo) { a = 1.f; bb = 0.f; }
            gr[o] = a; gr[4160 + o] = bb; }
    }
    __syncthreads();
    {
        const int ch = L; float A = 1.f, hh = 0.f, hs[8], As[8];
#pragma unroll
        for (int k = 0; k < 8; ++k) { const int tok = 8 * w + k; const float a = gr[tok * 65 + ch], b2 = gr[4160 + tok * 65 + ch]; hh = a * hh + b2; A *= a; hs[k] = hh; As[k] = A; }
        xf[w * 64 + ch] = A; xf[512 + w * 64 + ch] = hh;
        __syncthreads();
        float cA = 1.f, cH = 0.f;
#pragma unroll
        for (int j = 0; j < 7; ++j) { if (j < w) { const float sa = xf[j * 64 + ch], sh = xf[512 + j * 64 + ch]; cH = sa * cH + sh; cA *= sa; } }
        float* HL = p.out + OS_HL; bf16_t* AC = (bf16_t*)(p.out + OS_AC);
#pragma unroll
        for (int k = 0; k < 8; ++k) { const int tok = 8 * w + k; const float ht = hs[k] + As[k] * cH, At = As[k] * cA;
            if (tok >= G.valid_lo) { const size_t o = (size_t)(G.row0 + tok) * 1024 + n * 64 + ch; HL[o] = ht; AC[o] = (bf16_t)(pk2(At, 0.f) & 0xffffu); }
            if (w == 7 && k == 7) { ((float*)(p.ws + WS_ACH))[sc * 1024 + n * 64 + ch] = At; ((float*)(p.ws + WS_BCH))[sc * 1024 + n * 64 + ch] = ht; } }
    }
    __syncthreads();
}

struct Frags { bf16x8 a1[4]; bf16x8 a2[2]; bf16x8 ke[2]; u32x2 u[2]; float ge; };
__device__ __forceinline__ void chain_load(Frags& f, const unsigned char* ib, const float* GE, int item, int role, int mt, int w, int d, int L) {
    const unsigned char* a1b = ib + (role ? 16384 : 0);
#pragma unroll
    for (int s = 0; s < 4; ++s) f.a1[s] = *(const bf16x8*)(a1b + (size_t)((mt * 4 + s) * 64 + L) * 16);
    if (role) {
#pragma unroll
        for (int s = 0; s < 2; ++s) f.a2[s] = *(const bf16x8*)(ib + 49152 + (size_t)((mt * 2 + s) * 64 + L) * 16);
    } else {
#pragma unroll
        for (int nt = 0; nt < 2; ++nt) f.u[nt] = *(const u32x2*)(ib + 57344 + (size_t)((mt * 8 + 2 * d + nt) * 64 + L) * 8);
    }
#pragma unroll
    for (int s = 0; s < 2; ++s) f.ke[s] = *(const bf16x8*)(ib + 32768 + (size_t)((w * 2 + s) * 64 + L) * 16);
    f.ge = GE[item];
}
__device__ __forceinline__ void chain_step(const Frags& f, f32x4 (&S)[2], unsigned char* St, unsigned char* wt, int role, int mt, int w, int L, float* Orow, int valid_lo) {
    const int lr = L & 15, lq = L >> 4;
    f32x4 acc[2]; acc[0] = (f32x4){0.f, 0.f, 0.f, 0.f}; acc[1] = acc[0];
#pragma unroll
    for (int s = 0; s < 4; ++s)
#pragma unroll
        for (int nt = 0; nt < 2; ++nt) { const bf16x8 b = *(const bf16x8*)(St + (16 * nt + lr) * 272 + (32 * s + lq * 8) * 2); acc[nt] = mfma16(f.a1[s], b, acc[nt]); }
    if (!role) {
#pragma unroll
        for (int nt = 0; nt < 2; ++nt) { u32x2 o; o.x = pk2(bflo(f.u[nt].x) - acc[nt][0], bfhi(f.u[nt].x) - acc[nt][1]); o.y = pk2(bflo(f.u[nt].y) - acc[nt][2], bfhi(f.u[nt].y) - acc[nt][3]);
            *(u32x2*)(wt + (16 * nt + lr) * 144 + (16 * mt + lq * 4) * 2) = o; }
    }
    __syncthreads();
    bf16x8 bw[2][2];
#pragma unroll
    for (int nt = 0; nt < 2; ++nt)
#pragma unroll
        for (int s = 0; s < 2; ++s) bw[nt][s] = *(const bf16x8*)(wt + (16 * nt + lr) * 144 + (32 * s + lq * 8) * 2);
    if (role) {
#pragma unroll
        for (int nt = 0; nt < 2; ++nt) {
#pragma unroll
            for (int s = 0; s < 2; ++s) acc[nt] = mfma16(f.a2[s], bw[nt][s], acc[nt]);
#pragma unroll
            for (int r = 0; r < 4; ++r) { const int i = 16 * mt + lq * 4 + r; if (i >= valid_lo) Orow[(ptrdiff_t)i * 1024 + 16 * nt + lr] = acc[nt][r]; } }
    }
#pragma unroll
    for (int nt = 0; nt < 2; ++nt) { S[nt] = S[nt] * f.ge;
#pragma unroll
        for (int s = 0; s < 2; ++s) S[nt] = mfma16(f.ke[s], bw[nt][s], S[nt]);
        u32x2 o; o.x = pk2(S[nt][0], S[nt][1]); o.y = pk2(S[nt][2], S[nt][3]);
        *(u32x2*)(St + (16 * nt + lr) * 272 + (16 * w + lq * 4) * 2) = o; }
    __syncthreads();
}
__device__ __forceinline__ void gdn_chain(const Params& p, int l, int stream, int h, int d, unsigned char* shm) {
    const int tid = fresh_tid(), L = tid & 63, w = tid >> 6, role = w >> 2, mt = w & 3, lr = L & 15, lq = L >> 4;
    const bool samp = stream >= 2; const int s = stream - 2;
    const int sc0 = samp ? 258 + s : stream * 129, nsteps = samp ? 1 : 129;
    unsigned char* St = shm; unsigned char* wt = shm + 8704;
    const float* GE = (const float*)(p.ws + WS_GE);
    float* O = (float*)(p.ws + WS_HN);
    f32x4 S[2];
#pragma unroll
    for (int nt = 0; nt < 2; ++nt)
#pragma unroll
        for (int r = 0; r < 4; ++r) S[nt][r] = samp ? p.in[5][((size_t)((l * 16 + s) * 8 + h) * 128 + 16 * w + lq * 4 + r) * 128 + 32 * d + 16 * nt + lr] : 0.f;
#pragma unroll
    for (int nt = 0; nt < 2; ++nt) { u32x2 o; o.x = pk2(S[nt][0], S[nt][1]); o.y = pk2(S[nt][2], S[nt][3]); *(u32x2*)(St + (16 * nt + lr) * 272 + (16 * w + lq * 4) * 2) = o; }
    Frags fa, fb;
    const unsigned char* gch = p.ws + WS_GCH;
    chain_load(fa, gch + (size_t)(sc0 * 8 + h) * 73728, GE, sc0 * 8 + h, role, mt, w, d, L);
    __syncthreads();
    const ptrdiff_t rbase = samp ? (ptrdiff_t)(SROW0 + 16 * s - 48) : (ptrdiff_t)(stream * TP - 48);
    for (int c = 0; c < nsteps; c += 2) {
        if (c + 1 < nsteps) { const int it = (sc0 + c + 1) * 8 + h; chain_load(fb, gch + (size_t)it * 73728, GE, it, role, mt, w, d, L); }
        chain_step(fa, S, St, wt, role, mt, w, L, O + (rbase + 64 * c) * 1024 + h * 128 + 32 * d, (c == 0) ? 48 : 0);
        if (c + 1 < nsteps) {
            if (c + 2 < nsteps) { const int it = (sc0 + c + 2) * 8 + h; chain_load(fa, gch + (size_t)it * 73728, GE, it, role, mt, w, d, L); }
            chain_step(fb, S, St, wt, role, mt, w, L, O + (rbase + 64 * (c + 1)) * 1024 + h * 128 + 32 * d, 0);
        }
    }
    float* dst = p.out + (samp ? O_SDL + (size_t)((l * 16 + s) * 8 + h) * 16384 : O_PDL + (size_t)((l * 2 + stream) * 8 + h) * 16384);
#pragma unroll
    for (int nt = 0; nt < 2; ++nt)
#pragma unroll
        for (int r = 0; r < 4; ++r) dst[(size_t)(16 * w + lq * 4 + r) * 128 + 32 * d + 16 * nt + lr] = S[nt][r];
}
__device__ __forceinline__ void chain_phase(const Params& p, int l, unsigned char* shm) {
    const int bid = blockIdx.x;
    if (bid < 64) { const int pair = (bid & 7) * 2 + ((bid >> 3) >> 2), d = (bid >> 3) & 3; gdn_chain(p, l, pair >> 3, pair & 7, d, shm);
#if REP_MASK & 0x8000
        __syncthreads(); gdn_chain(p, l, pair >> 3, pair & 7, d, shm);
#endif
        return; }
#if REP_MASK & 0x10000
    for (int rr = 0; rr < 2; ++rr) {
#else
    {
#endif
    const int r = bid - 64, nr = gridDim.x - 64;
    const float* ACH = (const float*)(p.ws + WS_ACH); const float* BCH = (const float*)(p.ws + WS_BCH); float* CARRY = (float*)(p.ws + WS_CARRY);
    for (int g = r * 512 + fresh_tid(); g < 16384; g += nr * 512) { const int s = g >> 10, ch = g & 1023; CARRY[(size_t)(258 + s) * 1024 + ch] = p.in[3][(size_t)(l * 16 + s) * 1024 + ch]; }
    for (int q = r; q < 512; q += nr) { const int pair = q >> 2, d = q & 3; gdn_chain(p, l, 2 + (pair >> 3), pair & 7, d, shm); }
    __syncthreads();
    for (int li = (gridDim.x == 256 ? 112 * LRU_P5 : 0) + r; li < NSC * 16; li += nr) lru_item(p, l, li >> 4, li & 15, shm);
    unsigned* cnt = (unsigned*)(p.ws + WS_BAR) + 3600 + 64 * l;
    __syncthreads();
    if (threadIdx.x == 0) { __threadfence(); __hip_atomic_fetch_add(cnt, 1u, __ATOMIC_RELAXED, __HIP_MEMORY_SCOPE_AGENT); }
    if (r < 4) {
        if (threadIdx.x == 0) { unsigned sp = 0; while (__hip_atomic_load(cnt, __ATOMIC_RELAXED, __HIP_MEMORY_SCOPE_AGENT) < (unsigned)nr && ++sp < (1u << 22)) __builtin_amdgcn_s_sleep(2); __threadfence(); }
        __syncthreads();
        const int g = r * 512 + fresh_tid(), b2 = g >> 10, ch = g & 1023; float carry = 0.f;
#pragma unroll 1
        for (int c0 = 0; c0 < 129; c0 += 16) {
            float av[16], bv[16];
#pragma unroll
            for (int k = 0; k < 16; ++k) { const int c = (c0 + k < 129) ? c0 + k : 128; const size_t o = (size_t)(b2 * 129 + c) * 1024 + ch; av[k] = ACH[o]; bv[k] = BCH[o]; }
#pragma unroll
            for (int k = 0; k < 16; ++k) if (c0 + k < 129) { CARRY[(size_t)(b2 * 129 + c0 + k) * 1024 + ch] = carry; carry = av[k] * carry + bv[k]; }
        }
    }
    }
}

__device__ __forceinline__ void mix_out_phase(const Params& p, int l) {
    const int tid = fresh_tid(), lane = tid & 63, wid = tid >> 6;
    bf16_t* HN = (bf16_t*)(p.ws + WS_HN); const bf16_t* PROJ = (const bf16_t*)(p.ws + WS_PROJ);
    const float* HL = p.out + OS_HL; const bf16_t* AC = (const bf16_t*)(p.out + OS_AC); const float* CARRY = (const float*)(p.ws + WS_CARRY);
    for (int row = blockIdx.x * 8 + wid; row < MROWS; row += gridDim.x * 8) {
        int sc, t, T, stream; bool samp = row >= SROW0;
        if (!samp) { stream = row / TP; t = row % TP; T = TP; sc = stream * 129 + (t + 48) / 64; }
        else { const int r = row - SROW0; stream = r >> 4; t = r & 15; T = 16; sc = 258 + stream; }
        const float* Orow = (const float*)(HN + (size_t)row * D);
        f32x4 o4[4], h4[4]; float ssA = 0.f, ssB[4];
#pragma unroll
        for (int q = 0; q < 4; ++q) { const int idx = 4 * lane + 256 * q; o4[q] = *(const f32x4*)(Orow + idx);
            const f32x4 hl = *(const f32x4*)(HL + (size_t)row * 1024 + idx); const u32x2 ac = *(const u32x2*)(AC + (size_t)row * 1024 + idx); const f32x4 ci = *(const f32x4*)(CARRY + (size_t)sc * 1024 + idx);
            h4[q][0] = hl[0] + bflo(ac.x) * ci[0]; h4[q][1] = hl[1] + bfhi(ac.x) * ci[1]; h4[q][2] = hl[2] + bflo(ac.y) * ci[2]; h4[q][3] = hl[3] + bfhi(ac.y) * ci[3];
#if TEST_SKIP == 1 || TEST_SKIP == 3
            h4[q] = (f32x4){0.f, 0.f, 0.f, 0.f};
#elif TEST_SKIP == 2
            o4[q] = (f32x4){0.f, 0.f, 0.f, 0.f};
#endif
            ssA += h4[q][0] * h4[q][0] + h4[q][1] * h4[q][1] + h4[q][2] * h4[q][2] + h4[q][3] * h4[q][3];
            ssB[q] = o4[q][0] * o4[q][0] + o4[q][1] * o4[q][1] + o4[q][2] * o4[q][2] + o4[q][3] * o4[q][3]; }
#pragma unroll
        for (int o = 1; o < 64; o <<= 1) ssA += __shfl_xor(ssA, o);
#pragma unroll
        for (int q = 0; q < 4; ++q) {
#pragma unroll
            for (int o = 1; o < 32; o <<= 1) ssB[q] += __shfl_xor(ssB[q], o); }
        const float rsA = rsqrtf(ssA * (1.f / 1024.f) + EPS);
        u32x2 ga[4], zz[4];
#pragma unroll
        for (int q = 0; q < 4; ++q) { const int idx = 4 * lane + 256 * q; ga[q] = *(const u32x2*)(PROJ + (size_t)row * PLD + 1024 + idx); zz[q] = *(const u32x2*)(PROJ + (size_t)row * PLD + 5120 + idx); }
        asm volatile("s_waitcnt vmcnt(0)" ::: "memory");
#pragma unroll
        for (int q = 0; q < 4; ++q) { const int idx = 4 * lane + 256 * q;
            const f32x4 na = *(const f32x4*)(p.in[20] + l * 1024 + idx); const f32x4 nb = *(const f32x4*)(p.in[24] + l * 128 + (idx & 127));
            const float rsB = rsqrtf(ssB[q] * (1.f / 128.f) + EPS);
            const float g0 = gelu_tanh(bflo(ga[q].x)), g1 = gelu_tanh(bfhi(ga[q].x)), g2 = gelu_tanh(bflo(ga[q].y)), g3 = gelu_tanh(bfhi(ga[q].y));
            u32x2 ya; ya.x = pk2(h4[q][0] * rsA * na[0] * g0, h4[q][1] * rsA * na[1] * g1); ya.y = pk2(h4[q][2] * rsA * na[2] * g2, h4[q][3] * rsA * na[3] * g3);
            const float z0 = siluf_(bflo(zz[q].x)), z1 = siluf_(bfhi(zz[q].x)), z2 = siluf_(bflo(zz[q].y)), z3 = siluf_(bfhi(zz[q].y));
            u32x2 yb; yb.x = pk2(o4[q][0] * rsB * nb[0] * z0, o4[q][1] * rsB * nb[1] * z1); yb.y = pk2(o4[q][2] * rsB * nb[2] * z2, o4[q][3] * rsB * nb[3] * z3);
#if TEST_SKIP == 3
            yb.x = pk2(o4[q][0], o4[q][1]); yb.y = pk2(o4[q][2], o4[q][3]);
#endif
            *(u32x2*)(HN + (size_t)row * D + idx) = ya; *(u32x2*)(HN + (size_t)row * D + 1024 + idx) = yb; }
        if (t >= T - 3) {
            const int j = t - (T - 3);
            float* lru = p.out + (samp ? O_SLRU + (size_t)(l * 16 + stream) * 1024 : O_PLRU + (size_t)(l * 2 + stream) * 1024);
            float* ca = p.out + (samp ? O_SCA + ((size_t)(l * 16 + stream) * 3 + j) * 1024 : O_PCA + ((size_t)(l * 2 + stream) * 3 + j) * 1024);
            float* cb = p.out + (samp ? O_SCB + ((size_t)(l * 16 + stream) * 3 + j) * 3072 : O_PCB + ((size_t)(l * 2 + stream) * 3 + j) * 3072);
#pragma unroll
            for (int q = 0; q < 4; ++q) { const int idx = 4 * lane + 256 * q; if (t == T - 1) *(f32x4*)(lru + idx) = h4[q];
                const u32x2 v = *(const u32x2*)(PROJ + (size_t)row * PLD + idx); *(f32x4*)(ca + idx) = (f32x4){bflo(v.x), bfhi(v.x), bflo(v.y), bfhi(v.y)}; }
#pragma unroll
            for (int q = 0; q < 12; ++q) { const int idx = 4 * lane + 256 * q; const u32x2 v = *(const u32x2*)(PROJ + (size_t)row * PLD + 2048 + idx);
                *(f32x4*)(cb + idx) = (f32x4){bflo(v.x), bfhi(v.x), bflo(v.y), bfhi(v.y)}; }
        }
    }
}

#define XB_TMO      128
#define XB_XCNT(j)  (256  + 64 * (j))
#define XB_XSUB(j)  (1280 + 64 * (j))
#define XB_XGEN(j)  (2304 + 64 * (j))
#define XB_TOP      3328
#define XB_TOPGEN   3392
#define XCD_BAR_WORDS 3456
#define XB_SPIN_CAP (1u << 18)
#define XB_LAS __attribute__((address_space(3)))

__device__ __forceinline__ unsigned xb_ld(unsigned* p)              { return __hip_atomic_load(p, __ATOMIC_RELAXED, __HIP_MEMORY_SCOPE_AGENT); }
__device__ __forceinline__ unsigned xb_add(unsigned* p, unsigned v) { return __hip_atomic_fetch_add(p, v, __ATOMIC_RELAXED, __HIP_MEMORY_SCOPE_AGENT); }
__device__ __forceinline__ unsigned xb_xcc_id() { return (unsigned)__builtin_amdgcn_s_getreg((3 << 11) | 20) & 0xFu; }
#define XB_SPIN(cond, bar) do { unsigned _sp = 0; while (cond) { __builtin_amdgcn_s_sleep(1); \
    if ((++_sp & 255u) == 0u) { if (xb_ld(&(bar)[XB_TMO])) break; if (_sp > XB_SPIN_CAP) { atomicAdd(&(bar)[XB_TMO], 1u); break; } } } } while (0)

struct XcdBarrier {
    unsigned* bar; unsigned x;
    volatile XB_LAS unsigned* st;
};

__device__ __forceinline__ XcdBarrier xcd_barrier_post(unsigned* bar, volatile XB_LAS unsigned* st) {
    XcdBarrier b; b.bar = bar; b.x = xb_xcc_id(); b.st = st;
    if (threadIdx.x == 0) (void)xb_add(&bar[XB_XCNT(b.x)], 1u);
    return b;
}
__device__ __forceinline__ void xcd_barrier_complete(unsigned* bar, unsigned x, unsigned& nloc, unsigned& nx) {
    const unsigned G = gridDim.x * gridDim.y * gridDim.z;
    unsigned sum, cnt, mine, sp = 0u;
    for (;;) {
        sum = 0u; cnt = 0u; mine = 0u;
#pragma unroll
        for (unsigned j = 0; j < 16; ++j) { const unsigned c = xb_ld(&bar[XB_XCNT(j)]); sum += c; cnt += (c > 0u) ? 1u : 0u; mine = (j == x) ? c : mine; }
        if (sum == G) break;
        __builtin_amdgcn_s_sleep(1);
        if ((++sp & 255u) == 0u) { if (xb_ld(&bar[XB_TMO])) break; if (sp > XB_SPIN_CAP) { atomicAdd(&bar[XB_TMO], 1u); break; } }
    }
    nloc = mine > 0u ? mine : 1u; nx = cnt > 0u ? cnt : 1u;
}

__device__ __forceinline__ void xcd_barrier(const XcdBarrier& b) {
    asm volatile("s_waitcnt vmcnt(0)" ::: "memory");
    __syncthreads();
    if (threadIdx.x == 0) {
        unsigned* bar = b.bar;
        __builtin_amdgcn_s_waitcnt(0);
        unsigned nloc = b.st[0], nx = b.st[1];
        if (nloc == 0u) { xcd_barrier_complete(bar, b.x, nloc, nx); b.st[0] = nloc; b.st[1] = nx; }
        const unsigned old = xb_add(&bar[XB_XSUB(b.x)], 1u);
        const unsigned gen = old / nloc;
        if (old + 1u == (gen + 1u) * nloc) {
            __builtin_amdgcn_fence(__ATOMIC_RELEASE, "agent");
            asm volatile("s_waitcnt vmcnt(0)" ::: "memory");
            const unsigned og = xb_add(&bar[XB_TOP], 1u);
            const unsigned tg = og / nx;
            if (og + 1u == (tg + 1u) * nx) xb_add(&bar[XB_TOPGEN], 1u);
            else XB_SPIN(xb_ld(&bar[XB_TOPGEN]) == tg, bar);
            __builtin_amdgcn_fence(__ATOMIC_ACQUIRE, "agent");
            xb_add(&bar[XB_XGEN(b.x)], 1u);
            asm volatile("s_waitcnt vmcnt(0)" ::: "memory");
        } else {
            XB_SPIN(xb_ld(&bar[XB_XGEN(b.x)]) == gen, bar);
            __builtin_amdgcn_fence(__ATOMIC_ACQUIRE, "agent");
            asm volatile("s_waitcnt vmcnt(0)" ::: "memory");
        }
    }
    __syncthreads();
}

struct SchedAll {
    pg8::StaticOrder so; int mode, nkt_full, nM, nN, nsplit, G, c;
    __device__ __forceinline__ void init(int M, int N, int K, int G_, int c_, int mode_) {
        mode = mode_; nkt_full = K / 64; nM = M / 256; nN = N / 256; G = G_; c = c_; so.init(M, N, G_, c_);
        nsplit = (K == DFF) ? 11 : 8;
    }
    __device__ __forceinline__ bool next(int i, pg8::Unit& u) const {
        const int nwg = nM * nN, nfull = nwg / G;
        if (!mode || i < nfull) { if (!so.next(i, u)) return false; u.kt0 = 0; u.nkt = nkt_full; u.part = 0; return true; }
        if (i > nfull) return false;
        const int left = nwg - nfull * G;
        if (c >= left * nsplit) return false;
        const int j = c / nsplit, ks = c - j * nsplit;
        unit_of(nfull * G + j, nM, nN, u.pm, u.pn); u.nkt = nkt_full / nsplit; u.kt0 = ks * u.nkt; u.part = 1; return true;
    }
    __device__ __forceinline__ void a_ready(const pg8::Unit&) const {}
    __device__ __forceinline__ void done(const pg8::Unit&) const {}
};
template <class Epi> __device__ __forceinline__ void run_gemm_sk(unsigned char* shm, const bf16_t* A, const bf16_t* Bt, int N, int K, const Epi& E, int mode, int fake = 0) {
    pg8::Gemm g; g.A = A; g.Bt = Bt; g.M = MP; g.N = N; g.K = K; g.fake = fake;
    SchedAll S; S.init(MP, N, K, (int)gridDim.x, (int)blockIdx.x, mode);
    pg8::gemm_phase<Epi, SchedAll, false>((PG8_LAS unsigned char*)shm, g, S, E, nullptr);
}
template <class Epi> __device__ __forceinline__ void run_gemm(unsigned char* shm, const bf16_t* A, const bf16_t* Bt, int N, int K, const Epi& E) {
    pg8::Gemm g; g.A = A; g.Bt = Bt; g.M = MP; g.N = N; g.K = K; g.fake = 0;
    pg8::StaticOrder S; S.init(MP, N, (int)gridDim.x, (int)blockIdx.x);
    pg8::gemm_phase<Epi, pg8::StaticOrder, false>((PG8_LAS unsigned char*)shm, g, S, E, nullptr);
}

__global__ void __launch_bounds__(512, 2) mega(Params p) {
    extern __shared__ __attribute__((aligned(16))) unsigned char shm[];
    bf16_t* HN = (bf16_t*)(p.ws + WS_HN); bf16_t* HID = (bf16_t*)(p.ws + WS_PROJ); float* X = (float*)(p.ws + WS_X);
#if N_LAUNCH_MODE == 1
    volatile XB_LAS unsigned* xbw = (volatile XB_LAS unsigned*)(shm + LDS_BYTES - 16);
    if (threadIdx.x == 0) { xbw[0] = 0u; xbw[1] = 0u; }
    __syncthreads();
    const XcdBarrier xb = xcd_barrier_post((unsigned*)(p.ws + WS_BAR), xbw);
#endif
    for (int ph = p.ph_lo; ph < p.ph_hi; ++ph) {
        const int l = ph / 12, kind = (ph == 24) ? 12 : ph % 12;
#if REP_MASK
        for (int rep = 0; rep < (((REP_MASK) >> kind) & 1 ? 2 : 1); ++rep) {
        if (rep) { __threadfence(); cg::this_grid().sync(); }
#endif
        if (PH_ON(0) && kind == 0) { prep_phase(p, l, (float*)shm); if (l == 0) norm_phase<1>(p, p.in[7], 0); else norm_phase2<0>(p, p.in[7] + l * D, 11); }
        else if (PH_ON(1) && (kind == 1 || kind == 10 || kind == 2 || kind == 11 || kind == 8 || kind == 4)) {
            EpiAll E; E.mode = (kind == 1 || kind == 10) ? 0 : (kind == 4 ? 2 : 1); E.Ob = (E.mode == 0) ? HID : (bf16_t*)(p.ws + WS_PROJ); E.Of = X; E.BA = (float*)(p.ws + WS_BA); E.scale = kind == 8 ? 1.f : 0.5f;
            E.PART = (float*)(p.ws + WS_PART) + (size_t)blockIdx.x * 65536;
#if REP_MASK
            if (((REP_MASK) >> kind) & 1) E.scale *= 0.5f;
#endif
            const bf16_t* A = (kind == 2 || kind == 11) ? HID : HN;
            size_t wo; int N, K;
            if (kind == 1) { wo = WS_WGU1; N = NGU; K = D; } else if (kind == 10) { wo = WS_WGU2; N = NGU; K = D; } else if (kind == 2) { wo = WS_WD1; N = D; K = DFF; }
            else if (kind == 11) { wo = WS_WD2; N = D; K = DFF; } else if (kind == 8) { wo = WS_WOUT; N = D; K = D; } else { wo = WS_WIN; N = NINP; K = D; }
#if REP_MASK
            if (rep) { E.mode = 3; run_gemm_sk(shm, A, (const bf16_t*)(p.ws + wo), N, K, E, 0, PROBE_FAKE); } else
#endif
            run_gemm_sk(shm, A, (const bf16_t*)(p.ws + wo), N, K, E, (E.mode == 1 && gridDim.x == 256) ? 1 : 0); }
        else if (PH_ON(3) && kind == 3) norm_phase2<0>(p, p.in[11] + l * D, 11);
        else if (PH_ON(3) && kind == 9) norm_phase2<0>(p, p.in[26] + l * D, 8);
        else if (PH_ON(5) && kind == 5) {
            for (int it = blockIdx.x; it < NSC * 8; it += gridDim.x) gdn_item(p, l, it >> 3, it & 7, shm);
            if (gridDim.x == 256 && blockIdx.x >= 144) {
                for (int k = 0; k < LRU_P5; ++k) { const int li = ((int)blockIdx.x - 144) + 112 * k; lru_item(p, l, li >> 4, li & 15, shm); } }
        }
        else if (PH_ON(6) && kind == 6) chain_phase(p, l, shm);
        else if (PH_ON(7) && kind == 7) mix_out_phase(p, l);
        else if (PH_ON(12) && kind == 12) norm_phase2<2>(p, p.in[30], 11);
#if REP_MASK
        }
#endif
#if N_LAUNCH_MODE == 1
        if (ph + 1 < p.ph_hi) { if (p.ph_hi > 1000) cg::this_grid().sync(); else xcd_barrier(xb); }
#else
        if (ph + 1 < p.ph_hi) cg::this_grid().sync();
#endif
    }
}

extern "C" void kernel_launch(void* const* d_in, const int* in_sizes, int n_in, void* d_out, int out_size, void* d_ws, size_t ws_size, hipStream_t stream) {
    static int grid = 0;
    if (grid == 0) {
        if (n_in != 31 || ws_size < WS_END) { fprintf(stderr, "kernel_launch: unexpected n_in %d or ws_size %zu (need %zu)\n", n_in, ws_size, (size_t)WS_END); grid = -1; return; }
        int dev = 0, cus = 0, per_cu = 0;
        hipGetDevice(&dev); hipDeviceGetAttribute(&cus, hipDeviceAttributeMultiprocessorCount, dev);
        if (hipFuncSetAttribute((const void*)mega, hipFuncAttributeMaxDynamicSharedMemorySize, LDS_BYTES) != hipSuccess) { fprintf(stderr, "kernel_launch: hipFuncSetAttribute failed\n"); grid = -1; return; }
        if (hipOccupancyMaxActiveBlocksPerMultiprocessor(&per_cu, (const void*)mega, 512, LDS_BYTES) != hipSuccess || per_cu < 1) { fprintf(stderr, "kernel_launch: occupancy query says %d\n", per_cu); per_cu = 1; }
        (void)hipGetLastError();
        grid = cus;
        if (grid < 128) { fprintf(stderr, "kernel_launch: only %d CUs\n", grid); grid = -1; return; }
    }
    if (grid < 0) return;
    Params p{};
#if TEST_MEMSET
    (void)hipMemsetAsync((unsigned char*)d_ws + WS_X, 0, WS_END - WS_X, stream);
#endif
    for (int i = 0; i < 31; ++i) p.in[i] = (const float*)d_in[i];
    p.out = (float*)d_out; p.ws = (unsigned char*)d_ws;
#if N_LAUNCH_MODE == 1
    p.ph_lo = 0; p.ph_hi = 25;
    (void)hipMemsetAsync((unsigned char*)d_ws + WS_BAR, 0, 16384, stream);
    void* args[] = {&p};
    hipError_t e = hipLaunchCooperativeKernel((const void*)mega, dim3(grid), dim3(512), args, LDS_BYTES, stream);
    if (e != hipSuccess) fprintf(stderr, "cooperative launch failed: %s (grid %d)\n", hipGetErrorString(e), grid);
#else
    for (int ph = 0; ph < 25; ++ph) { p.ph_lo = ph; p.ph_hi = ph + 1; hipLaunchKernelGGL(mega, dim3(grid), dim3(512), LDS_BYTES, stream, p); }
#endif
}
```

```cpp
#include <hip/hip_runtime.h>
#include <hip/hip_cooperative_groups.h>
#include <cstdio>
namespace cg = cooperative_groups;
namespace pg8 {
#define PG8_LAS __attribute__((address_space(3)))
typedef unsigned short bf16_t;
typedef short bf16x8 __attribute__((ext_vector_type(8)));
typedef float f32x4 __attribute__((ext_vector_type(4)));
typedef unsigned u32x4 __attribute__((ext_vector_type(4)));
constexpr int BM = 256, BK = 64, HALF = 128, HTB = HALF * BK * 2  , STAGE_BYTES = 8 * HTB, NXCD = 8, WGM = 8;
__host__ __device__ __forceinline__ int lds_byte(int r, int c) { const int st = (r >> 4) * 2 + (c >> 5), rr = r & 15, cc = c & 31, ob = rr * 64 + cc * 2; return st * 1024 + (ob ^ (((ob >> 9) & 1) << 5)); }
__host__ __device__ __forceinline__ void stage_rc(int b, int& R, int& C) { const int st = b / 1024, sb = b % 1024, swz = sb ^ (((sb >> 9) & 1) << 5); R = (st >> 1) * 16 + swz / 64; C = (st & 1) * 32 + (swz % 64) / 2; }
__host__ __device__ __forceinline__ int perm32(int rho) { const int n = rho >> 4, i = rho & 15; return 8 * (i >> 2) + 4 * n + (i & 3); }
struct Unit { int pm, pn, kt0, nkt, part; };
struct Gemm { const bf16_t* A; const bf16_t* Bt; int M, N, K, fake; };
struct StaticOrder {
    int nM, nN, nwg, G, c;
    __host__ __device__ void init(int M, int N, int G_, int c_) { nM = M / BM; nN = N / BM; nwg = nM * nN; G = G_; c = c_; }
    __host__ __device__ bool next(int i, Unit& u) const {
        const long L = (long)i * G + c; if (L >= nwg) return false;
        int wgid = (int)L; { const int q = nwg / NXCD, r = nwg % NXCD, xcd = wgid % NXCD, off = wgid / NXCD; wgid = (xcd < r ? xcd * (q + 1) : r * (q + 1) + (xcd - r) * q) + off; }
        const int nig = WGM * nN, gid = wgid / nig, fm = gid * WGM, gsz = (nM - fm) < WGM ? (nM - fm) : WGM;
        u.pm = fm + ((wgid % nig) % gsz); u.pn = (wgid % nig) / gsz; return true;
    }
    __device__ __forceinline__ void a_ready(const Unit&) const {}
    __device__ __forceinline__ void done(const Unit&) const {}
};
__device__ __forceinline__ unsigned cvt_pk_bf16(float lo, float hi) { unsigned r; asm volatile("v_cvt_pk_bf16_f32 %0, %1, %2" : "=v"(r) : "v"(lo), "v"(hi)); return r; }
template <class Epi, class Sched, bool STAMP = false>
__device__ __forceinline__ void gemm_phase(PG8_LAS unsigned char* lds, const Gemm g, const Sched& S, const Epi& E, unsigned long long* stamps) {
    int tid_ = threadIdx.x; asm volatile("" : "+v"(tid_)); const int tid = tid_, wid = __builtin_amdgcn_readfirstlane(tid >> 6), lane = tid & 63, wr = wid >> 2, wc = wid & 3, fr = lane & 15, fq = lane >> 4;
    const int K = g.K; int nt;
    int ts_lo = 0, ts_hi = 0, nts = 0; const unsigned long long rt_entry = STAMP ? (unsigned long long)wall_clock64() : 0ull;
#define PG8_STAMP() do { if (STAMP && wid == 0 && nts < 64) { const unsigned long long _c = (unsigned long long)clock64(); \
        ts_lo = (lane == nts) ? (int)(unsigned)_c : ts_lo; ts_hi = (lane == nts) ? (int)(unsigned)(_c >> 32) : ts_hi; ++nts; } } while (0)
    PG8_STAMP();
    unsigned voffA[2], voffB[2];
#pragma unroll
    for (int i = 0; i < 2; ++i) { int R, C; stage_rc(tid * 16 + i * 8192, R, C); const int Rb = E.perm() ? ((R & ~31) + perm32(R & 31)) : R;
        voffA[i] = (unsigned)(R * K + C) * 2u; voffB[i] = (unsigned)(Rb * K + C) * 2u; }
    const size_t kstep = (size_t)(BK * 2);
    const size_t hstep = (size_t)HALF * K * 2;
    const size_t tstep = 2 * hstep;
    const unsigned ldsw = (unsigned)wid * 1024u;
    const int aoff = lds_byte(wr * 64 + fr, fq * 8), boff = lds_byte(wc * 32 + fr, fq * 8);
#define PG8_SA(b, h) (((b) * 2 + (h)) * HTB)
#define PG8_SB(b, h) ((4 + (b) * 2 + (h)) * HTB)
#define PG8_STAGE(bufoff, gbase, voff) do { _Pragma("unroll") for (int _i = 0; _i < 2; ++_i) \
        __builtin_amdgcn_global_load_lds((const unsigned*)((const char*)(gbase) + (voff)[_i]), (PG8_LAS unsigned*)(lds + (bufoff) + ldsw + _i * 8192), 16, 0, 0); } while (0)
#define PG8_LDA(dst, b, h) do { _Pragma("unroll") for (int m = 0; m < 4; ++m) _Pragma("unroll") for (int k = 0; k < 2; ++k) dst[m][k] = *(const PG8_LAS bf16x8*)(lds + PG8_SA(b, h) + aoff + m * 2048 + k * 1024); } while (0)
#define PG8_LDB(dst, b, h) do { _Pragma("unroll") for (int n = 0; n < 2; ++n) _Pragma("unroll") for (int k = 0; k < 2; ++k) dst[n][k] = *(const PG8_LAS bf16x8*)(lds + PG8_SB(b, h) + boff + n * 2048 + k * 1024); } while (0)
#define PG8_MMA(ai, bj, At, Bt) do { __builtin_amdgcn_s_setprio(1); _Pragma("unroll") for (int m = 0; m < 4; ++m) _Pragma("unroll") for (int n = 0; n < 2; ++n) _Pragma("unroll") for (int k = 0; k < 2; ++k) \
        acc[ai][bj][m][n] = __builtin_amdgcn_mfma_f32_16x16x32_bf16(Bt[n][k], At[m][k], acc[ai][bj][m][n], 0, 0, 0); __builtin_amdgcn_s_setprio(0); } while (0)
#define PG8_WAIT_V(n) asm volatile("s_waitcnt vmcnt(" #n ")" ::: "memory")
#define PG8_WAIT_L(n) asm volatile("s_waitcnt lgkmcnt(" #n ")" ::: "memory")
#define PG8_BAR __builtin_amdgcn_s_barrier()
#define PG8_SCHED __builtin_amdgcn_sched_barrier(0)
    Unit cur, nxt; int ui = 0;
    if (!S.next(0, cur)) return;
    nt = cur.nkt;
    f32x4 acc[2][2][4][2];
#pragma unroll
    for (int a = 0; a < 2; ++a)
#pragma unroll
        for (int b = 0; b < 2; ++b)
#pragma unroll
            for (int m = 0; m < 4; ++m)
#pragma unroll
                for (int n = 0; n < 2; ++n) acc[a][b][m][n] = (f32x4){0.f, 0.f, 0.f, 0.f};
    bf16x8 At[4][2], B0[2][2], B1[2][2];
    const char* cA = (const char*)g.A + (g.fake ? (size_t)0 : (size_t)cur.pm * tstep) + (size_t)cur.kt0 * (size_t)(BK * 2); const char* cB = (const char*)g.Bt + (g.fake ? (size_t)0 : (size_t)cur.pn * tstep) + (size_t)cur.kt0 * (size_t)(BK * 2);
    S.a_ready(cur);
    PG8_STAGE(PG8_SB(0, 0), cB, voffB); PG8_STAGE(PG8_SA(0, 0), cA, voffA); PG8_STAGE(PG8_SB(0, 1), cB + hstep, voffB); PG8_STAGE(PG8_SA(0, 1), cA + hstep, voffA);
    if (wr == 1) PG8_BAR;
    PG8_WAIT_V(4); PG8_BAR;
    PG8_STAGE(PG8_SB(1, 0), cB + kstep, voffB); PG8_STAGE(PG8_SA(1, 0), cA + kstep, voffA); PG8_STAGE(PG8_SB(1, 1), cB + hstep + kstep, voffB);
    PG8_WAIT_V(6); PG8_BAR;
    PG8_STAMP();
    for (;;) {
        const bool has_next = S.next(ui + 1, nxt);
        const char* nA = has_next ? (const char*)g.A + (g.fake ? (size_t)0 : (size_t)nxt.pm * tstep) + (size_t)nxt.kt0 * kstep : cA; const char* nB = has_next ? (const char*)g.Bt + (g.fake ? (size_t)0 : (size_t)nxt.pn * tstep) + (size_t)nxt.kt0 * kstep : cB;
        for (int t = 0; t < nt; t += 2) {
            const bool last = (t == nt - 2);
            const char* a1 = cA + (size_t)(t + 1) * kstep;
            const char* a2 = last ? nA : cA + (size_t)(t + 2) * kstep; const char* b2 = last ? nB : cB + (size_t)(t + 2) * kstep;
            const char* a3 = a2 + kstep; const char* b3 = b2 + kstep;
            if (last && has_next) S.a_ready(nxt);
            PG8_LDB(B0, 0, 0); PG8_SCHED; PG8_LDA(At, 0, 0); PG8_STAGE(PG8_SA(1, 1), a1 + hstep, voffA);
            PG8_WAIT_L(8); PG8_BAR; PG8_WAIT_L(0); PG8_MMA(0, 0, At, B0); PG8_BAR; PG8_SCHED;
            PG8_LDB(B1, 0, 1); PG8_STAGE(PG8_SB(0, 0), b2, voffB);
            PG8_BAR; PG8_WAIT_L(0); PG8_MMA(0, 1, At, B1); PG8_BAR;
            PG8_LDA(At, 0, 1); PG8_STAGE(PG8_SA(0, 0), a2, voffA);
            PG8_BAR; PG8_WAIT_L(0); PG8_MMA(1, 0, At, B0); PG8_BAR; PG8_SCHED;
            PG8_STAGE(PG8_SB(0, 1), b2 + hstep, voffB);
            PG8_WAIT_V(6); PG8_BAR; PG8_MMA(1, 1, At, B1); PG8_BAR;
            PG8_LDB(B0, 1, 0); PG8_SCHED; PG8_LDA(At, 1, 0); PG8_STAGE(PG8_SA(0, 1), a2 + hstep, voffA);
            PG8_WAIT_L(8); PG8_BAR; PG8_WAIT_L(0); PG8_MMA(0, 0, At, B0); PG8_BAR; PG8_SCHED;
            PG8_LDB(B1, 1, 1); PG8_STAGE(PG8_SB(1, 0), b3, voffB);
            PG8_BAR; PG8_WAIT_L(0); PG8_MMA(0, 1, At, B1); PG8_BAR;
            PG8_LDA(At, 1, 1); PG8_STAGE(PG8_SA(1, 0), a3, voffA);
            PG8_BAR; PG8_WAIT_L(0); PG8_MMA(1, 0, At, B0); PG8_BAR; PG8_SCHED;
            PG8_STAGE(PG8_SB(1, 1), b3 + hstep, voffB);
            PG8_WAIT_V(6); PG8_BAR; PG8_MMA(1, 1, At, B1); PG8_BAR;
        }
        PG8_STAMP();
        if constexpr (!Epi::AFTER_DRAIN) { E(acc, cur, wr, wc, fr, fq); S.done(cur); }
        PG8_STAMP();
        if (!has_next) break;
#pragma unroll
        for (int a = 0; a < 2; ++a)
#pragma unroll
            for (int b = 0; b < 2; ++b)
#pragma unroll
                for (int m = 0; m < 4; ++m)
#pragma unroll
                    for (int n = 0; n < 2; ++n) acc[a][b][m][n] = (f32x4){0.f, 0.f, 0.f, 0.f};
        cur = nxt; cA = nA; cB = nB; ++ui; nt = cur.nkt;
    }
    PG8_WAIT_V(0);
    if (wr == 0) PG8_BAR;
    PG8_BAR;
    if constexpr (Epi::AFTER_DRAIN) { E.fused(acc, cur, wr, wc, fr, fq, lds, wid, lane); S.done(cur); }
    PG8_STAMP();
    if (STAMP && wid == 0) { stamps[lane] = lane < nts ? (((unsigned long long)(unsigned)ts_hi << 32) | (unsigned)ts_lo) : 0ull;
        if (lane == 62) stamps[62] = rt_entry; if (lane == 63) stamps[63] = (unsigned long long)wall_clock64(); }
#undef PG8_STAMP
#undef PG8_SA
#undef PG8_SB
#undef PG8_STAGE
#undef PG8_LDA
#undef PG8_LDB
#undef PG8_MMA
#undef PG8_WAIT_V
#undef PG8_WAIT_L
#undef PG8_BAR
#undef PG8_SCHED
}
}
using pg8::bf16_t; using pg8::bf16x8; using pg8::f32x4; using pg8::u32x4;
typedef unsigned u32x2 __attribute__((ext_vector_type(2)));

constexpr int D = 2048, TP = 8208, NSS = 16;
constexpr int MROWS = 16672, MP = 16896, SROW0 = 16416;
constexpr int DFF = 5632, NGU = 11264, NINP = 6400, PLD = 6144;
constexpr int NSC = 274;
constexpr float EPS = 1e-6f;
constexpr int LDS_BYTES = 147456;
#ifndef TEST_MEMSET
#define TEST_MEMSET 0
#endif
#ifndef LRU_KEEP
#define LRU_KEEP 0
#endif
#ifndef PROBE_FAKE
#define PROBE_FAKE 1
#endif
#ifndef REP_MASK
#define REP_MASK 0
#endif
#ifndef TEST_SKIP
#define TEST_SKIP 0
#endif
#ifndef PH_MASK
#define PH_MASK 0x7fff
#endif
#define PH_ON(k) (((PH_MASK) >> (k)) & 1)
#ifndef N_LAUNCH_MODE
#define N_LAUNCH_MODE 1
#endif

constexpr size_t SZ_WGU = (size_t)NGU * D * 2, SZ_WD = (size_t)D * DFF * 2, SZ_WIN = (size_t)NINP * D * 2, SZ_WOUT = (size_t)D * D * 2;
constexpr size_t WS_WGU1 = 0, WS_WD1 = WS_WGU1 + SZ_WGU, WS_WGU2 = WS_WD1 + SZ_WD, WS_WD2 = WS_WGU2 + SZ_WGU, WS_WIN = WS_WD2 + SZ_WD, WS_WOUT = WS_WIN + SZ_WIN,
    WS_WG = WS_WOUT + SZ_WOUT, WS_X = WS_WG + 262144, WS_HN = WS_X + (size_t)MP * D * 4, WS_PROJ = WS_HN + (size_t)MP * D * 2, WS_GCH = WS_PROJ + (size_t)MP * PLD * 2,
    WS_BA = WS_GCH + (size_t)NSC * 8 * 73728, WS_GE = WS_BA + (size_t)MP * 16 * 4, WS_ACH = WS_GE + 16384, WS_BCH = WS_ACH + (size_t)NSC * 1024 * 4,
    WS_CARRY = WS_BCH + (size_t)NSC * 1024 * 4, WS_PART = WS_CARRY + (size_t)NSC * 1024 * 4, WS_BAR = WS_PART + (size_t)256 * 65536 * 4, WS_END = WS_BAR + 16384;
constexpr size_t O_YP = 0, O_YS = 33554432, O_PCA = 34078720, O_PLRU = 34091008, O_PCB = 34095104, O_PDL = 34131968, O_SCA = 34656256, O_SLRU = 34754560,
    O_SCB = 34787328, O_SDL = 35082240;
constexpr size_t OS_HL = 0, OS_AC = (size_t)MROWS * 1024;

__device__ __forceinline__ int fresh_tid() { int t = threadIdx.x; asm volatile("" : "+v"(t)); return t; }
__device__ __forceinline__ void unit_of(int L, int nM, int nN, int& pm, int& pn) {
    const int nwg = nM * nN; int wgid = L; { const int q = nwg / 8, r = nwg % 8, xcd = wgid % 8, off = wgid / 8; wgid = (xcd < r ? xcd * (q + 1) : r * (q + 1) + (xcd - r) * q) + off; }
    const int nig = 8 * nN, gid = wgid / nig, fm = gid * 8, gsz = (nM - fm) < 8 ? (nM - fm) : 8;
    pm = fm + ((wgid % nig) % gsz); pn = (wgid % nig) / gsz;
}
struct Params { const float* in[31]; float* out; unsigned char* ws; int ph_lo, ph_hi; };

typedef __bf16 bf16v2 __attribute__((ext_vector_type(2)));
__device__ __forceinline__ unsigned pk2(float lo, float hi) { bf16v2 v; v[0] = (__bf16)lo; v[1] = (__bf16)hi; return __builtin_bit_cast(unsigned, v); }
__device__ __forceinline__ float bflo(unsigned u) { return __uint_as_float(u << 16); }
__device__ __forceinline__ float bfhi(unsigned u) { return __uint_as_float(u & 0xffff0000u); }
__device__ __forceinline__ float bf2f(bf16_t b) { return __uint_as_float(((unsigned)b) << 16); }
__device__ __forceinline__ float sigmoidf_(float x) { return __builtin_amdgcn_rcpf(1.f + __expf(-x)); }
__device__ __forceinline__ float siluf_(float x) { return x * __builtin_amdgcn_rcpf(1.f + __expf(-x)); }
__device__ __forceinline__ float softplusf_(float x) { return x > 20.f ? x : log1pf(__expf(x)); }
__device__ __forceinline__ float gelu_tanh(float x) { const float y = 0.7978845608028654f * (x + 0.044715f * x * x * x); const float t = 1.f - 2.f * __builtin_amdgcn_rcpf(1.f + __expf(2.f * y)); return 0.5f * x * (1.f + t); }
__device__ __forceinline__ void unpack8(const u32x4 v, float (&f)[8]) { f[0] = bflo(v.x); f[1] = bfhi(v.x); f[2] = bflo(v.y); f[3] = bfhi(v.y); f[4] = bflo(v.z); f[5] = bfhi(v.z); f[6] = bflo(v.w); f[7] = bfhi(v.w); }
__device__ __forceinline__ u32x4 pack8(const float (&f)[8]) { u32x4 o; o.x = pk2(f[0], f[1]); o.y = pk2(f[2], f[3]); o.z = pk2(f[4], f[5]); o.w = pk2(f[6], f[7]); return o; }
__device__ __forceinline__ f32x4 mfma16(bf16x8 a, bf16x8 b, f32x4 c) { return __builtin_amdgcn_mfma_f32_16x16x32_bf16(a, b, c, 0, 0, 0); }

struct EpiGU {
    static constexpr bool PERM = false, AFTER_DRAIN = false;
    bf16_t* H;
    __device__ __forceinline__ void operator()(const f32x4 (&acc)[2][2][4][2], const pg8::Unit& u, int wr, int wc, int fr, int fq) const {
        const int row0 = u.pm * 256 + wr * 64 + fr, hc0 = u.pn * 128 + wc * 16 + 4 * fq;
#pragma unroll
        for (int ai = 0; ai < 2; ++ai)
#pragma unroll
            for (int m = 0; m < 4; ++m) { u32x2 o[2];
#pragma unroll
                for (int bj = 0; bj < 2; ++bj) { const f32x4 g = acc[ai][bj][m][0], up = acc[ai][bj][m][1];
                    o[bj].x = pk2(siluf_(g[0]) * up[0], siluf_(g[1]) * up[1]); o[bj].y = pk2(siluf_(g[2]) * up[2], siluf_(g[3]) * up[3]); }
                const auto rx = __builtin_amdgcn_permlane16_swap(o[0].x, o[1].x, false, false); const auto ry = __builtin_amdgcn_permlane16_swap(o[0].y, o[1].y, false, false);
                u32x4 w; w.x = rx[0]; w.y = ry[0]; w.z = rx[1]; w.w = ry[1];
                *(u32x4*)(H + (size_t)(row0 + ai * 128 + m * 16) * DFF + u.pn * 128 + 64 * (fq & 1) + wc * 16 + 8 * (fq >> 1)) = w; }
    }
};
struct EpiRes {
    static constexpr bool PERM = false, AFTER_DRAIN = false;
    float* X; float scale; float* PART;
    __device__ __forceinline__ void operator()(const f32x4 (&acc)[2][2][4][2], const pg8::Unit& u, int wr, int wc, int fr, int fq) const {
        const bool tail = u.part != 0;
        const int rl0 = wr * 64 + fr, cl0 = wc * 32 + 4 * fq;
        float* base = tail ? PART + (size_t)rl0 * 256 + cl0 : X + (size_t)(u.pm * 256 + rl0) * D + u.pn * 256 + cl0;
        const size_t ld = tail ? 256 : D;
#pragma unroll
        for (int ai = 0; ai < 2; ++ai)
#pragma unroll
            for (int m = 0; m < 4; ++m) { float* rowp = base + (size_t)(ai * 128 + m * 16) * ld;
#pragma unroll
                for (int bj = 0; bj < 2; ++bj)
#pragma unroll
                    for (int n = 0; n < 2; ++n) { f32x4* q = (f32x4*)(rowp + bj * 128 + n * 16); f32x4 v = acc[ai][bj][m][n] * scale; if (!tail) v = v + *q; *q = v; } }
    }
};
struct EpiProj {
    static constexpr bool PERM = true, AFTER_DRAIN = false;
    bf16_t* P; float* BA;
    __device__ __forceinline__ void operator()(const f32x4 (&acc)[2][2][4][2], const pg8::Unit& u, int wr, int wc, int fr, int fq) const {
        const int row0 = u.pm * 256 + wr * 64 + fr;
        if (u.pn < 24) {
            const int col0 = u.pn * 256 + wc * 32 + 8 * fq;
#pragma unroll
            for (int ai = 0; ai < 2; ++ai)
#pragma unroll
                for (int m = 0; m < 4; ++m) { bf16_t* rowp = P + (size_t)(row0 + ai * 128 + m * 16) * PLD + col0;
#pragma unroll
                    for (int bj = 0; bj < 2; ++bj) { const f32x4 v0 = acc[ai][bj][m][0], v1 = acc[ai][bj][m][1];
                        u32x4 w; w.x = pk2(v0[0], v0[1]); w.y = pk2(v0[2], v0[3]); w.z = pk2(v1[0], v1[1]); w.w = pk2(v1[2], v1[3]);
                        *(u32x4*)(rowp + bj * 128) = w; } }
        } else if (wc == 0 && fq < 2) {
#pragma unroll
            for (int ai = 0; ai < 2; ++ai)
#pragma unroll
                for (int m = 0; m < 4; ++m) { float* q = BA + (size_t)(row0 + ai * 128 + m * 16) * 16 + 8 * fq;
                    *(f32x4*)q = acc[ai][0][m][0]; *(f32x4*)(q + 4) = acc[ai][0][m][1]; }
        }
    }
};

struct EpiAll {
    static constexpr bool AFTER_DRAIN = false;
    int mode; bf16_t* Ob; float* Of; float* BA; float scale; float* PART;
    __device__ __forceinline__ bool perm() const { return mode == 2; }
    __device__ __forceinline__ void operator()(const f32x4 (&acc)[2][2][4][2], const pg8::Unit& u, int wr, int wc, int fr, int fq) const {
        if (mode == 3) {
            f32x4 s = {0.f, 0.f, 0.f, 0.f};
#pragma unroll
            for (int ai = 0; ai < 2; ++ai)
#pragma unroll
                for (int bj = 0; bj < 2; ++bj)
#pragma unroll
                    for (int m = 0; m < 4; ++m)
#pragma unroll
                        for (int n = 0; n < 2; ++n) s = s + acc[ai][bj][m][n];
            if (s[0] + s[1] + s[2] + s[3] == 12345.678f) BA[0] = s[0];
            return; }
        if (mode == 0) { EpiGU e; e.H = Ob; e(acc, u, wr, wc, fr, fq); }
        else if (mode == 1) { EpiRes e; e.X = Of; e.scale = scale; e.PART = PART; e(acc, u, wr, wc, fr, fq); }
        else { EpiProj e; e.P = Ob; e.BA = BA; e(acc, u, wr, wc, fr, fq); }
    }
};

__device__ __forceinline__ void tr_tile(const float* W, int K, int N, int kb, int nb, bf16_t* dst, int mode, float* tile) {
    const int tid = fresh_tid(), k0 = kb * 64, n0 = nb * 64;
    { const int nn = tid & 63, kq = tid >> 6, n = n0 + nn;
#pragma unroll
        for (int r = 0; r < 8; ++r) { const int kk = r * 8 + kq; tile[kk * 65 + nn] = (n < N) ? W[(size_t)(k0 + kk) * N + n] : 0.f; } }
    __syncthreads();
    { const int nn = tid >> 3, kc = tid & 7, n = n0 + nn; int drow = n;
        if (mode == 1) drow = (n >> 4) * 32 + (n & 15); else if (mode == 2) drow = (n >> 4) * 32 + 16 + (n & 15);
        const float* s = tile + (kc * 8) * 65 + nn; u32x4 o; o.x = pk2(s[0], s[65]); o.y = pk2(s[130], s[195]); o.z = pk2(s[260], s[325]); o.w = pk2(s[390], s[455]);
        *(u32x4*)(dst + (size_t)drow * K + k0 + kc * 8) = o; }
    __syncthreads();
}
struct TrJob { const float* W; bf16_t* dst; int K, N, mode, kb, nb; };
__device__ __forceinline__ TrJob prep_job(const Params& p, int l, int it) {
    TrJob j;
    if (it < 4224) { const int m = it / 704, r = it % 704, f = m / 3, w = m % 3;
        j.W = p.in[(f ? 27 : 8) + w] + (size_t)l * 2048 * 5632;
        if (w < 2) { j.K = 2048; j.N = 5632; j.kb = r / 22; j.nb = r % 22; j.mode = w + 1; j.dst = (bf16_t*)(p.ws + (f ? WS_WGU2 : WS_WGU1)); }
        else { j.K = 5632; j.N = 2048; j.kb = r / 8; j.nb = r % 8; j.mode = 0; j.dst = (bf16_t*)(p.ws + (f ? WS_WD2 : WS_WD1)); }
    } else if (it < 5024) { const int r = it - 4224; j.W = p.in[12] + (size_t)l * 2048 * 6160; j.K = 2048; j.N = 6160; j.kb = r / 25; j.nb = r % 25; j.mode = 0; j.dst = (bf16_t*)(p.ws + WS_WIN);
    } else { const int r = it - 5024; j.W = p.in[25] + (size_t)l * 2048 * 2048; j.K = 2048; j.N = 2048; j.kb = r / 8; j.nb = r % 8; j.mode = 0; j.dst = (bf16_t*)(p.ws + WS_WOUT); }
    return j;
}
__device__ __forceinline__ void tr_load(const TrJob& j, f32x4 (&v)[8], int tid) {
    const int lane = tid & 63, wid = tid >> 6, n = j.nb * 256 + lane * 4;
#pragma unroll
    for (int ps = 0; ps < 8; ++ps) v[ps] = (n < j.N) ? *(const f32x4*)(j.W + (size_t)(j.kb * 64 + ps * 8 + wid) * j.N + n) : (f32x4){0.f, 0.f, 0.f, 0.f};
}
__device__ __forceinline__ void prep_phase(const Params& p, int l, float* tile) {
    constexpr int NJ = 5280;
    const int tid = fresh_tid(), lane = tid & 63, wid = tid >> 6;
    int it = blockIdx.x; f32x4 v[8]; TrJob job;
    if (it < NJ) { job = prep_job(p, l, it); tr_load(job, v, tid); }
    while (it < NJ) {
#pragma unroll
        for (int ps = 0; ps < 8; ++ps) *(f32x4*)(tile + (ps * 8 + wid) * 260 + lane * 4) = v[ps];
        __syncthreads();
        const TrJob cur = job; it += gridDim.x;
        if (it < NJ) { job = prep_job(p, l, it); tr_load(job, v, tid); }
#pragma unroll
        for (int r = 0; r < 4; ++r) { const int q = tid + 512 * r, nl = q & 255, kc = q >> 8, n = cur.nb * 256 + nl; int drow = n;
            if (cur.mode == 1) drow = (n >> 4) * 32 + (n & 15); else if (cur.mode == 2) drow = (n >> 4) * 32 + 16 + (n & 15);
            const float* s = tile + (kc * 8) * 260 + nl; u32x4 o; o.x = pk2(s[0], s[260]); o.y = pk2(s[520], s[780]); o.z = pk2(s[1040], s[1300]); o.w = pk2(s[1560], s[1820]);
            *(u32x4*)(cur.dst + (size_t)drow * cur.K + cur.kb * 64 + kc * 8) = o; }
        __syncthreads();
    }
    for (int r = blockIdx.x; r < 32; r += gridDim.x) { const int n = r >> 1, g = r & 1; tr_tile(p.in[g ? 17 : 15] + (size_t)l * 65536 + n * 4096, 64, 64, 0, 0, (bf16_t*)(p.ws + WS_WG) + r * 4096, 0, tile); }
}

template <int MODE>
__device__ __forceinline__ void norm_phase(const Params& p, const float* w, int ndp) {
    const int tid = fresh_tid(), lane = tid & 63, wid = tid >> 6;
    float* X = (float*)(p.ws + WS_X); bf16_t* HN = (bf16_t*)(p.ws + WS_HN);
    for (int row = blockIdx.x * 8 + wid; row < MP; row += gridDim.x * 8) {
        if (row >= MROWS) {
            if (MODE != 2) {
#pragma unroll
                for (int q = 0; q < 8; ++q) { const int idx = 4 * lane + 256 * q; *(u32x2*)(HN + (size_t)row * D + idx) = (u32x2){0u, 0u};
                    if (MODE == 1) *(f32x4*)(X + (size_t)row * D + idx) = (f32x4){0.f, 0.f, 0.f, 0.f}; } }
            continue; }
        const float* src = X + (size_t)row * D; float* dsto = nullptr;
        if (MODE != 0) {
            if (row < SROW0) { const int b = row / TP, t = row % TP;
                if (MODE == 1) src = t < 16 ? p.in[6] + (size_t)t * D : p.in[0] + ((size_t)b * 8192 + (t - 16)) * D;
                else dsto = t < 16 ? nullptr : p.out + O_YP + ((size_t)b * 8192 + (t - 16)) * D;
            } else { const int r = row - SROW0; if (MODE == 1) src = p.in[1] + (size_t)r * D; else dsto = p.out + O_YS + (size_t)r * D; }
            if (MODE == 2 && dsto == nullptr) continue;
        }
        f32x4 v[8]; float ss = 0.f;
#pragma unroll
        for (int q = 0; q < 8; ++q) v[q] = *(const f32x4*)(src + 4 * lane + 256 * q);
        if (MODE != 1 && ndp > 0 && gridDim.x == 256) {
            const int pm = row >> 8, rl = row & 255;
#pragma unroll 1
            for (int j = 0; j < 16; ++j) { int upm, upn; unit_of(512 + j, MP / 256, 8, upm, upn);
                if (upm == pm) {
                    f32x4 s = {0.f, 0.f, 0.f, 0.f};
                    for (int ks = 0; ks < ndp; ++ks) s = s + *(const f32x4*)((const float*)(p.ws + WS_PART) + (size_t)(j * ndp + ks) * 65536 + rl * 256 + 4 * lane);
#pragma unroll
                    for (int q = 0; q < 8; ++q) if (upn == q) { v[q] = v[q] + s; *(f32x4*)(X + (size_t)row * D + 4 * lane + 256 * q) = v[q]; }
                } }
        }
#pragma unroll
        for (int q = 0; q < 8; ++q) { ss += v[q][0] * v[q][0] + v[q][1] * v[q][1] + v[q][2] * v[q][2] + v[q][3] * v[q][3]; }
#pragma unroll
        for (int o = 1; o < 64; o <<= 1) ss += __shfl_xor(ss, o);
        const float rs = rsqrtf(ss * (1.f / 2048.f) + EPS);
#pragma unroll
        for (int q = 0; q < 8; ++q) { const int idx = 4 * lane + 256 * q; const f32x4 wv = *(const f32x4*)(w + idx); const f32x4 y = v[q] * rs * wv;
            if (MODE == 2) *(f32x4*)(dsto + idx) = y;
            else { u32x2 o; o.x = pk2(y[0], y[1]); o.y = pk2(y[2], y[3]); *(u32x2*)(HN + (size_t)row * D + idx) = o; if (MODE == 1) *(f32x4*)(X + (size_t)row * D + idx) = v[q]; } }
    }
}

template <int MODE>
__device__ __forceinline__ void norm_phase2(const Params& p, const float* w, int ndp) {
    const int tid = fresh_tid(), lane = tid & 63, wid = tid >> 6;
    float* X = (float*)(p.ws + WS_X); bf16_t* HN = (bf16_t*)(p.ws + WS_HN);
    const int stride = gridDim.x * 8;
    for (int row0 = blockIdx.x * 8 + wid; row0 < MP; row0 += 2 * stride) {
        f32x4 v[2][8]; float* dsto[2]; bool act[2];
#pragma unroll
        for (int t = 0; t < 2; ++t) {
            const int row = row0 + t * stride; act[t] = row < MROWS; dsto[t] = nullptr;
            if (MODE == 0 && row >= MROWS && row < MP) {
#pragma unroll
                for (int q = 0; q < 8; ++q) *(u32x2*)(HN + (size_t)row * D + 4 * lane + 256 * q) = (u32x2){0u, 0u}; }
            if (MODE == 2 && act[t]) {
                if (row < SROW0) { const int b = row / TP, tt = row % TP; dsto[t] = tt < 16 ? nullptr : p.out + O_YP + ((size_t)b * 8192 + (tt - 16)) * D; }
                else dsto[t] = p.out + O_YS + (size_t)(row - SROW0) * D;
                act[t] = dsto[t] != nullptr; }
            if (act[t]) {
#pragma unroll
                for (int q = 0; q < 8; ++q) v[t][q] = *(const f32x4*)(X + (size_t)row * D + 4 * lane + 256 * q); }
        }
#pragma unroll
        for (int t = 0; t < 2; ++t) {
            if (!act[t]) continue;
            const int row = row0 + t * stride;
            if (ndp > 0 && gridDim.x == 256) {
                const int pm = row >> 8, rl = row & 255;
#pragma unroll 1
                for (int j = 0; j < 16; ++j) { int upm, upn; unit_of(512 + j, MP / 256, 8, upm, upn);
                    if (upm == pm) {
                        f32x4 s = {0.f, 0.f, 0.f, 0.f};
                        for (int ks = 0; ks < ndp; ++ks) s = s + *(const f32x4*)((const float*)(p.ws + WS_PART) + (size_t)(j * ndp + ks) * 65536 + rl * 256 + 4 * lane);
#pragma unroll
                        for (int q = 0; q < 8; ++q) if (upn == q) { v[t][q] = v[t][q] + s; *(f32x4*)(X + (size_t)row * D + 4 * lane + 256 * q) = v[t][q]; }
                    } }
            }
            float ss = 0.f;
#pragma unroll
            for (int q = 0; q < 8; ++q) ss += v[t][q][0] * v[t][q][0] + v[t][q][1] * v[t][q][1] + v[t][q][2] * v[t][q][2] + v[t][q][3] * v[t][q][3];
#pragma unroll
            for (int o = 1; o < 64; o <<= 1) ss += __shfl_xor(ss, o);
            const float rs = rsqrtf(ss * (1.f / 2048.f) + EPS);
#pragma unroll
            for (int q = 0; q < 8; ++q) { const int idx = 4 * lane + 256 * q; const f32x4 wv = *(const f32x4*)(w + idx); const f32x4 y = v[t][q] * rs * wv;
                if (MODE == 2) *(f32x4*)(dsto[t] + idx) = y;
                else { u32x2 o; o.x = pk2(y[0], y[1]); o.y = pk2(y[2], y[3]); *(u32x2*)(HN + (size_t)row * D + idx) = o; } }
        }
    }
}

struct ChunkGeo { int row0, tok0, valid_lo, samp; };
__device__ __forceinline__ ChunkGeo chunk_geo(int sc) {
    ChunkGeo g;
    if (sc < 258) { const int b = sc / 129, c = sc % 129; g.tok0 = 64 * c - 48; g.row0 = b * TP + g.tok0; g.valid_lo = c == 0 ? 48 : 0; g.samp = -1; }
    else { const int s = sc - 258; g.tok0 = -48; g.row0 = SROW0 + 16 * s - 48; g.valid_lo = 48; g.samp = s; }
    return g;
}

__device__ __forceinline__ void gdn_item(const Params& p, int l, int sc, int h, unsigned char* shm) {
    const int tid = fresh_tid(), L = tid & 63, w = tid >> 6;
    bf16_t* qs = (bf16_t*)shm; bf16_t* ks = (bf16_t*)(shm + 17408); float* sol = (float*)(shm + 34816); float* Lm = (float*)(shm + 100352); float* qkm = (float*)(shm + 116736);
    float* gcs = (float*)(shm + 134144); float* betas = gcs + 64; float* egcs = gcs + 128;
    const ChunkGeo G = chunk_geo(sc);
    const bf16_t* PROJ = (const bf16_t*)(p.ws + WS_PROJ); const float* BA = (const float*)(p.ws + WS_BA);
    const int item = sc * 8 + h; unsigned char* ib = p.ws + WS_GCH + (size_t)item * 73728;
    if (w == 0) {
        const int i = L; float beta = 0.f, g = 0.f;
        if (i >= G.valid_lo) { const float* ba = BA + (size_t)(G.row0 + i) * 16; beta = sigmoidf_(ba[h]); g = -__expf(p.in[22][l * 8 + h]) * softplusf_(ba[8 + h] + p.in[23][l * 8 + h]); }
#pragma unroll
        for (int o = 1; o < 64; o <<= 1) { const float v = __shfl_up(g, o); if (L >= o) g += v; }
        gcs[i] = g; betas[i] = beta; egcs[i] = __expf(g);
        if (L == 63) ((float*)(p.ws + WS_GE))[item] = __expf(g);
    }
    __syncthreads();
#pragma unroll 3
    for (int r = 0; r < 6; ++r) {
        const int e = tid + 512 * r, pos = e / 48, cgi = e % 48, typ = cgi >> 4, c8 = (cgi & 15) * 8, col = typ * 1024 + h * 128 + c8;
        const bool valid = pos >= G.valid_lo;
        float acc[8];
#pragma unroll
        for (int k = 0; k < 8; ++k) acc[k] = 0.f;
        if (valid) {
#pragma unroll
            for (int j = 0; j < 4; ++j) {
                const int m = G.tok0 + pos - 3 + j; float xv[8]; bool have = true;
                if (m >= 0) { const u32x4 raw = *(const u32x4*)(PROJ + (size_t)(G.row0 + pos - 3 + j) * PLD + 2048 + col); unpack8(raw, xv); }
                else if (G.samp >= 0) { const float* sp = p.in[4] + ((size_t)(l * 16 + G.samp) * 3 + (3 + m)) * 3072 + col; const f32x4 a = *(const f32x4*)sp, b = *(const f32x4*)(sp + 4);
                    xv[0] = a[0]; xv[1] = a[1]; xv[2] = a[2]; xv[3] = a[3]; xv[4] = b[0]; xv[5] = b[1]; xv[6] = b[2]; xv[7] = b[3]; }
                else have = false;
                if (have) { const float* wp = p.in[21] + (size_t)(l * 4 + j) * 3072 + col; const f32x4 wa = *(const f32x4*)wp, wb = *(const f32x4*)(wp + 4);
                    acc[0] += xv[0] * wa[0]; acc[1] += xv[1] * wa[1]; acc[2] += xv[2] * wa[2]; acc[3] += xv[3] * wa[3];
                    acc[4] += xv[4] * wb[0]; acc[5] += xv[5] * wb[1]; acc[6] += xv[6] * wb[2]; acc[7] += xv[7] * wb[3]; }
            }
        }
        float ss = 0.f;
#pragma unroll
        for (int k = 0; k < 8; ++k) { acc[k] = siluf_(acc[k]); ss += acc[k] * acc[k]; }
        ss += __shfl_xor(ss, 1); ss += __shfl_xor(ss, 2); ss += __shfl_xor(ss, 4); ss += __shfl_xor(ss, 8);
        if (typ < 2) { const float scl = rsqrtf(ss + EPS) * (typ == 0 ? 0.08838834764831845f : 1.f);
#pragma unroll
            for (int k = 0; k < 8; ++k) acc[k] *= scl;
            *(u32x4*)((typ == 0 ? qs : ks) + pos * 136 + c8) = pack8(acc);
            if (typ == 1) { const float f = betas[pos] * egcs[pos];
#pragma unroll
                for (int k = 0; k < 8; ++k) sol[pos * 256 + 128 + c8 + k] = f * acc[k]; }
        } else { const float f = betas[pos];
#pragma unroll
            for (int k = 0; k < 8; ++k) sol[pos * 256 + c8 + k] = f * acc[k]; }
    }
    __syncthreads();
    {
        const int mat = w >> 2, mt = w & 3, lr = L & 15, lq = L >> 4;
        const bf16_t* Asrc = mat ? qs : ks; bf16x8 a[4];
#pragma unroll
        for (int s = 0; s < 4; ++s) a[s] = *(const bf16x8*)(Asrc + (16 * mt + lr) * 136 + 32 * s + lq * 8);
#pragma unroll
        for (int nt = 0; nt < 4; ++nt) {
            f32x4 c = {0.f, 0.f, 0.f, 0.f};
#pragma unroll
            for (int s = 0; s < 4; ++s) { const bf16x8 b = *(const bf16x8*)(ks + (16 * nt + lr) * 136 + 32 * s + lq * 8); c = mfma16(a[s], b, c); }
            const int j = 16 * nt + lr; const float gj = gcs[j];
#pragma unroll
            for (int r = 0; r < 4; ++r) { const int i = 16 * mt + lq * 4 + r; const float dec = __expf(fminf(gcs[i] - gj, 0.f));
                if (mat == 0) Lm[i * 64 + j] = (i > j) ? betas[i] * dec * c[r] : 0.f;
                else qkm[i * 68 + j] = (i >= j) ? dec * c[r] : 0.f; }
        }
    }
    __syncthreads();
    {
        const int c = tid & 255; const bool mainw = tid < 256; const int t2 = tid - 256; const float gl = gcs[63];
#define GD_LOAD(ACC, B_) _Pragma("unroll") for (int r = 0; r < 16; ++r) ACC[r] = sol[(16 * (B_) + r) * 256 + c]
#define GD_STORE(ACC, B_) _Pragma("unroll") for (int r = 0; r < 16; ++r) sol[(16 * (B_) + r) * 256 + c] = ACC[r]
#define GD_PAIR(ACC, B_, JB_) do { float xj[16]; _Pragma("unroll") for (int k = 0; k < 16; ++k) xj[k] = sol[(16 * (JB_) + k) * 256 + c]; \
            _Pragma("unroll") for (int r = 0; r < 16; ++r) { const float* lr = Lm + (16 * (B_) + r) * 64 + 16 * (JB_); \
                _Pragma("unroll") for (int k4 = 0; k4 < 4; ++k4) { const f32x4 lv = *(const f32x4*)(lr + 4 * k4); \
                    ACC[r] -= lv[0] * xj[4 * k4]; ACC[r] -= lv[1] * xj[4 * k4 + 1]; ACC[r] -= lv[2] * xj[4 * k4 + 2]; ACC[r] -= lv[3] * xj[4 * k4 + 3]; } } } while (0)
#define GD_DIAG(ACC, B_) do { _Pragma("unroll") for (int r = 1; r < 16; ++r) { const float* lr = Lm + (16 * (B_) + r) * 64 + 16 * (B_); \
                _Pragma("unroll") for (int k4 = 0; k4 < (r + 3) / 4; ++k4) { const f32x4 lv = *(const f32x4*)(lr + 4 * k4); \
                    if (4 * k4 < r) ACC[r] -= lv[0] * ACC[4 * k4]; if (4 * k4 + 1 < r) ACC[r] -= lv[1] * ACC[4 * k4 + 1]; \
                    if (4 * k4 + 2 < r) ACC[r] -= lv[2] * ACC[4 * k4 + 2]; if (4 * k4 + 3 < r) ACC[r] -= lv[3] * ACC[4 * k4 + 3]; } } } while (0)
        float acc[16];
#pragma unroll 1
        for (int st = 0; st < 4; ++st) {
            if (mainw) { GD_LOAD(acc, st); if (st > 0) GD_PAIR(acc, st, st - 1); GD_DIAG(acc, st); GD_STORE(acc, st); }
            else if (st == 0) {
#pragma unroll
        for (int r = 0; r < 4; ++r) {
            const int q = t2 + 256 * r, Lq = q & 63, f = q >> 6, mt = f >> 2, s = f & 3, i = 16 * mt + (Lq & 15), k0 = 32 * s + (Lq >> 4) * 8;
            float v[8]; unpack8(*(const u32x4*)(qs + i * 136 + k0), v); const float e = egcs[i];
#pragma unroll
            for (int k = 0; k < 8; ++k) v[k] *= e;
            *(u32x4*)(ib + 16384 + (size_t)q * 16) = pack8(v); }
#pragma unroll
        for (int r = 0; r < 2; ++r) {
            const int q = t2 + 256 * r, Lq = q & 63, f = q >> 6, mt = f >> 1, s = f & 1, i = 16 * mt + (Lq & 15), j0 = 32 * s + (Lq >> 4) * 8;
            float v[8]; const f32x4 a = *(const f32x4*)(qkm + i * 68 + j0), b = *(const f32x4*)(qkm + i * 68 + j0 + 4);
            v[0] = a[0]; v[1] = a[1]; v[2] = a[2]; v[3] = a[3]; v[4] = b[0]; v[5] = b[1]; v[6] = b[2]; v[7] = b[3];
            *(u32x4*)(ib + 49152 + (size_t)q * 16) = pack8(v); }
            } else if (st < 3) {
#pragma unroll 1
                for (int Bp = st + 1; Bp < 4; ++Bp) { GD_LOAD(acc, Bp); GD_PAIR(acc, Bp, st - 1); GD_STORE(acc, Bp); }
            } else {
#pragma unroll
        for (int r = 0; r < 4; ++r) {
            const int q = t2 + 256 * r, Lq = q & 63, f = q >> 6, mt = f >> 1, s = f & 1, dk = 16 * mt + (Lq & 15), j0 = 32 * s + (Lq >> 4) * 8;
            float v[8];
#pragma unroll
            for (int k = 0; k < 8; ++k) v[k] = bf2f(ks[(j0 + k) * 136 + dk]) * __expf(fminf(gl - gcs[j0 + k], 0.f));
            *(u32x4*)(ib + 32768 + (size_t)q * 16) = pack8(v); }
            }
            if (st < 3) __syncthreads();
        }
#undef GD_LOAD
#undef GD_STORE
#undef GD_PAIR
#undef GD_DIAG
    }
    __syncthreads();
#pragma unroll
    for (int r = 0; r < 2; ++r) {
        const int q = tid + 512 * r, Lq = q & 63, f = q >> 6, mt = f >> 2, s = f & 3, i = 16 * mt + (Lq & 15), k0 = 32 * s + (Lq >> 4) * 8;
        float v[8]; const f32x4 a = *(const f32x4*)(sol + i * 256 + 128 + k0), b = *(const f32x4*)(sol + i * 256 + 128 + k0 + 4);
        v[0] = a[0]; v[1] = a[1]; v[2] = a[2]; v[3] = a[3]; v[4] = b[0]; v[5] = b[1]; v[6] = b[2]; v[7] = b[3];
        *(u32x4*)(ib + (size_t)q * 16) = pack8(v); }
#pragma unroll
    for (int r = 0; r < 4; ++r) {
        const int q = tid + 512 * r, Lq = q & 63, f = q >> 6, mt = f >> 3, ntile = f & 7, i0 = 16 * mt + (Lq >> 4) * 4, cc = 16 * ntile + (Lq & 15);
        u32x2 o; o.x = pk2(sol[i0 * 256 + cc], sol[(i0 + 1) * 256 + cc]); o.y = pk2(sol[(i0 + 2) * 256 + cc], sol[(i0 + 3) * 256 + cc]);
        *(u32x2*)(ib + 57344 + (size_t)q * 8) = o; }
    __syncthreads();
}

__device__ __forceinline__ void lru_item(const Params& p, int l, int sc, int n, unsigned char* shm) {
    const int tid = fresh_tid(), L = tid & 63, w = tid >> 6;
    bf16_t* xs = (bf16_t*)shm; float* xf = (float*)(shm + 9216); float* gr = (float*)(shm + 25856);
    const ChunkGeo G = chunk_geo(sc);
    const bf16_t* PROJ = (const bf16_t*)(p.ws + WS_PROJ);
    const int g_ = w >> 2, nt_ = w & 3, lr_ = L & 15, lq_ = L >> 4;
    bf16x8 bfr[2];
    { const bf16_t* WG = (const bf16_t*)(p.ws + WS_WG) + (size_t)(n * 2 + g_) * 4096;
#pragma unroll
        for (int s = 0; s < 2; ++s) bfr[s] = *(const bf16x8*)(WG + (16 * nt_ + lr_) * 64 + 32 * s + lq_ * 8); }
    const float bias_ = p.in[g_ ? 18 : 16][l * 1024 + n * 64 + 16 * nt_ + lr_];
    const float lam_ = p.in[19][l * 1024 + n * 64 + (tid & 63)];
    {
        const int pos = tid >> 3, cgi = tid & 7, ch0 = n * 64 + cgi * 8; float acc[8];
        { const float* bp = p.in[14] + l * 1024 + ch0; const f32x4 a = *(const f32x4*)bp, b = *(const f32x4*)(bp + 4);
            acc[0] = a[0]; acc[1] = a[1]; acc[2] = a[2]; acc[3] = a[3]; acc[4] = b[0]; acc[5] = b[1]; acc[6] = b[2]; acc[7] = b[3]; }
        if (pos >= G.valid_lo) {
#pragma unroll
            for (int j = 0; j < 4; ++j) {
                const int m = G.tok0 + pos - 3 + j; float xv[8]; bool have = true;
                if (m >= 0) { unpack8(*(const u32x4*)(PROJ + (size_t)(G.row0 + pos - 3 + j) * PLD + ch0), xv); }
                else if (G.samp >= 0) { const float* sp = p.in[2] + ((size_t)(l * 16 + G.samp) * 3 + (3 + m)) * 1024 + ch0; const f32x4 a = *(const f32x4*)sp, b = *(const f32x4*)(sp + 4);
                    xv[0] = a[0]; xv[1] = a[1]; xv[2] = a[2]; xv[3] = a[3]; xv[4] = b[0]; xv[5] = b[1]; xv[6] = b[2]; xv[7] = b[3]; }
                else have = false;
                if (have) { const float* wp = p.in[13] + (size_t)(l * 4 + j) * 1024 + ch0; const f32x4 wa = *(const f32x4*)wp, wb = *(const f32x4*)(wp + 4);
                    acc[0] += xv[0] * wa[0]; acc[1] += xv[1] * wa[1]; acc[2] += xv[2] * wa[2]; acc[3] += xv[3] * wa[3];
                    acc[4] += xv[4] * wb[0]; acc[5] += xv[5] * wb[1]; acc[6] += xv[6] * wb[2]; acc[7] += xv[7] * wb[3]; }
            }
        }
        *(u32x4*)(xs + pos * 72 + cgi * 8) = pack8(acc);
#pragma unroll
        for (int k = 0; k < 8; ++k) xf[pos * 65 + cgi * 8 + k] = acc[k];
    }
    __syncthreads();
    {
        const int g = g_, nt = nt_, lr = lr_, lq = lq_;
#pragma unroll
        for (int mt = 0; mt < 4; ++mt) {
            f32x4 c = {0.f, 0.f, 0.f, 0.f};
#pragma unroll
            for (int s = 0; s < 2; ++s) { const bf16x8 a = *(const bf16x8*)(xs + (16 * mt + lr) * 72 + 32 * s + lq * 8); c = mfma16(a, bfr[s], c); }
#pragma unroll
            for (int r = 0; r < 4; ++r) gr[g * 4160 + (16 * mt + lq * 4 + r) * 65 + 16 * nt + lr] = sigmoidf_(c[r] + bias_);
        }
    }
    __syncthreads();
    {
        const int ch = tid & 63; const float sp = softplusf_(-lam_);
#pragma unroll
        for (int k = 0; k < 8; ++k) { const int tok = (tid >> 6) + 8 * k, o = tok * 65 + ch;
            const float r = gr[o], ig = gr[4160 + o], x = xf[o]; const float la = -8.f * r * sp; float a = __expf(la); float bb = sqrtf(fmaxf(-expm1f(2.f * la), 0.f)) * ig * x;
            if (tok < G.valid_lo) { a = 1.f; bb = 0.f; }
            gr[o] = a; gr[4160 + o] = bb; }
    }
    __syncthreads();
    {
        const int ch = L; float A = 1.f, hh = 0.f, hs[8], As[8];
#pragma unroll
        for (int k = 0; k < 8; ++k) { const int tok = 8 * w + k; const float a = gr[tok * 65 + ch], b2 = gr[4160 + tok * 65 + ch]; hh = a * hh + b2; A *= a; hs[k] = hh; As[k] = A; }
        xf[w * 64 + ch] = A; xf[512 + w * 64 + ch] = hh;
        __syncthreads();
        float cA = 1.f, cH = 0.f;
#pragma unroll
        for (int j = 0; j < 7; ++j) { if (j < w) { const float sa = xf[j * 64 + ch], sh = xf[512 + j * 64 + ch]; cH = sa * cH + sh; cA *= sa; } }
        float* HL = p.out + OS_HL; bf16_t* AC = (bf16_t*)(p.out + OS_AC);
#pragma unroll
        for (int k = 0; k < 8; ++k) { const int tok = 8 * w + k; const float ht = hs[k] + As[k] * cH, At = As[k] * cA;
            if (tok >= G.valid_lo) { const size_t o = (size_t)(G.row0 + tok) * 1024 + n * 64 + ch; HL[o] = ht; AC[o] = (bf16_t)(pk2(At, 0.f) & 0xffffu); }
            if (w == 7 && k == 7) { ((float*)(p.ws + WS_ACH))[sc * 1024 + n * 64 + ch] = At; ((float*)(p.ws + WS_BCH))[sc * 1024 + n * 64 + ch] = ht; } }
    }
    __syncthreads();
}

struct Frags { bf16x8 a1[4]; bf16x8 a2[2]; bf16x8 ke[2]; u32x2 u[2]; float ge; };
__device__ __forceinline__ void chain_load(Frags& f, const unsigned char* ib, const float* GE, int item, int role, int mt, int w, int d, int L) {
    const unsigned char* a1b = ib + (role ? 16384 : 0);
#pragma unroll
    for (int s = 0; s < 4; ++s) f.a1[s] = *(const bf16x8*)(a1b + (size_t)((mt * 4 + s) * 64 + L) * 16);
    if (role) {
#pragma unroll
        for (int s = 0; s < 2; ++s) f.a2[s] = *(const bf16x8*)(ib + 49152 + (size_t)((mt * 2 + s) * 64 + L) * 16);
    } else {
#pragma unroll
        for (int nt = 0; nt < 2; ++nt) f.u[nt] = *(const u32x2*)(ib + 57344 + (size_t)((mt * 8 + 2 * d + nt) * 64 + L) * 8);
    }
#pragma unroll
    for (int s = 0; s < 2; ++s) f.ke[s] = *(const bf16x8*)(ib + 32768 + (size_t)((w * 2 + s) * 64 + L) * 16);
    f.ge = GE[item];
}
__device__ __forceinline__ void chain_step(const Frags& f, f32x4 (&S)[2], unsigned char* St, unsigned char* wt, int role, int mt, int w, int L, float* Orow, int valid_lo) {
    const int lr = L & 15, lq = L >> 4;
    f32x4 acc[2]; acc[0] = (f32x4){0.f, 0.f, 0.f, 0.f}; acc[1] = acc[0];
#pragma unroll
    for (int s = 0; s < 4; ++s)
#pragma unroll
        for (int nt = 0; nt < 2; ++nt) { const bf16x8 b = *(const bf16x8*)(St + (16 * nt + lr) * 272 + (32 * s + lq * 8) * 2); acc[nt] = mfma16(f.a1[s], b, acc[nt]); }
    if (!role) {
#pragma unroll
        for (int nt = 0; nt < 2; ++nt) { u32x2 o; o.x = pk2(bflo(f.u[nt].x) - acc[nt][0], bfhi(f.u[nt].x) - acc[nt][1]); o.y = pk2(bflo(f.u[nt].y) - acc[nt][2], bfhi(f.u[nt].y) - acc[nt][3]);
            *(u32x2*)(wt + (16 * nt + lr) * 144 + (16 * mt + lq * 4) * 2) = o; }
    }
    __syncthreads();
    bf16x8 bw[2][2];
#pragma unroll
    for (int nt = 0; nt < 2; ++nt)
#pragma unroll
        for (int s = 0; s < 2; ++s) bw[nt][s] = *(const bf16x8*)(wt + (16 * nt + lr) * 144 + (32 * s + lq * 8) * 2);
    if (role) {
#pragma unroll
        for (int nt = 0; nt < 2; ++nt) {
#pragma unroll
            for (int s = 0; s < 2; ++s) acc[nt] = mfma16(f.a2[s], bw[nt][s], acc[nt]);
#pragma unroll
            for (int r = 0; r < 4; ++r) { const int i = 16 * mt + lq * 4 + r; if (i >= valid_lo) Orow[(ptrdiff_t)i * 1024 + 16 * nt + lr] = acc[nt][r]; } }
    }
#pragma unroll
    for (int nt = 0; nt < 2; ++nt) { S[nt] = S[nt] * f.ge;
#pragma unroll
        for (int s = 0; s < 2; ++s) S[nt] = mfma16(f.ke[s], bw[nt][s], S[nt]);
        u32x2 o; o.x = pk2(S[nt][0], S[nt][1]); o.y = pk2(S[nt][2], S[nt][3]);
        *(u32x2*)(St + (16 * nt + lr) * 272 + (16 * w + lq * 4) * 2) = o; }
    __syncthreads();
}
__device__ __forceinline__ void gdn_chain(const Params& p, int l, int stream, int h, int d, unsigned char* shm) {
    const int tid = fresh_tid(), L = tid & 63, w = tid >> 6, role = w >> 2, mt = w & 3, lr = L & 15, lq = L >> 4;
    const bool samp = stream >= 2; const int s = stream - 2;
    const int sc0 = samp ? 258 + s : stream * 129, nsteps = samp ? 1 : 129;
    unsigned char* St = shm; unsigned char* wt = shm + 8704;
    const float* GE = (const float*)(p.ws + WS_GE);
    float* O = (float*)(p.ws + WS_HN);
    f32x4 S[2];
#pragma unroll
    for (int nt = 0; nt < 2; ++nt)
#pragma unroll
        for (int r = 0; r < 4; ++r) S[nt][r] = samp ? p.in[5][((size_t)((l * 16 + s) * 8 + h) * 128 + 16 * w + lq * 4 + r) * 128 + 32 * d + 16 * nt + lr] : 0.f;
#pragma unroll
    for (int nt = 0; nt < 2; ++nt) { u32x2 o; o.x = pk2(S[nt][0], S[nt][1]); o.y = pk2(S[nt][2], S[nt][3]); *(u32x2*)(St + (16 * nt + lr) * 272 + (16 * w + lq * 4) * 2) = o; }
    Frags fa, fb;
    const unsigned char* gch = p.ws + WS_GCH;
    chain_load(fa, gch + (size_t)(sc0 * 8 + h) * 73728, GE, sc0 * 8 + h, role, mt, w, d, L);
    __syncthreads();
    const ptrdiff_t rbase = samp ? (ptrdiff_t)(SROW0 + 16 * s - 48) : (ptrdiff_t)(stream * TP - 48);
    for (int c = 0; c < nsteps; c += 2) {
        if (c + 1 < nsteps) { const int it = (sc0 + c + 1) * 8 + h; chain_load(fb, gch + (size_t)it * 73728, GE, it, role, mt, w, d, L); }
        chain_step(fa, S, St, wt, role, mt, w, L, O + (rbase + 64 * c) * 1024 + h * 128 + 32 * d, (c == 0) ? 48 : 0);
        if (c + 1 < nsteps) {
            if (c + 2 < nsteps) { const int it = (sc0 + c + 2) * 8 + h; chain_load(fa, gch + (size_t)it * 73728, GE, it, role, mt, w, d, L); }
            chain_step(fb, S, St, wt, role, mt, w, L, O + (rbase + 64 * (c + 1)) * 1024 + h * 128 + 32 * d, 0);
        }
    }
    float* dst = p.out + (samp ? O_SDL + (size_t)((l * 16 + s) * 8 + h) * 16384 : O_PDL + (size_t)((l * 2 + stream) * 8 + h) * 16384);
#pragma unroll
    for (int nt = 0; nt < 2; ++nt)
#pragma unroll
        for (int r = 0; r < 4; ++r) dst[(size_t)(16 * w + lq * 4 + r) * 128 + 32 * d + 16 * nt + lr] = S[nt][r];
}
__device__ __forceinline__ void chain_phase(const Params& p, int l, unsigned char* shm) {
    const int bid = blockIdx.x;
    if (bid < 64) { const int pair = (bid & 7) * 2 + ((bid >> 3) >> 2), d = (bid >> 3) & 3; gdn_chain(p, l, pair >> 3, pair & 7, d, shm);
#if REP_MASK & 0x8000
        __syncthreads(); gdn_chain(p, l, pair >> 3, pair & 7, d, shm);
#endif
        return; }
#if REP_MASK & 0x10000
    for (int rr = 0; rr < 2; ++rr) {
#else
    {
#endif
    const int r = bid - 64, nr = gridDim.x - 64;
    const float* ACH = (const float*)(p.ws + WS_ACH); const float* BCH = (const float*)(p.ws + WS_BCH); float* CARRY = (float*)(p.ws + WS_CARRY);
    for (int g = r * 512 + fresh_tid(); g < 16384; g += nr * 512) { const int s = g >> 10, ch = g & 1023; CARRY[(size_t)(258 + s) * 1024 + ch] = p.in[3][(size_t)(l * 16 + s) * 1024 + ch]; }
    for (int q = r; q < 512; q += nr) { const int pair = q >> 2, d = q & 3; gdn_chain(p, l, 2 + (pair >> 3), pair & 7, d, shm); }
    __syncthreads();
    for (int li = LRU_KEEP + r; li < NSC * 16; li += nr) lru_item(p, l, li >> 4, li & 15, shm);
    unsigned* cnt = (unsigned*)(p.ws + WS_BAR) + 3600 + 64 * l;
    __syncthreads();
    if (threadIdx.x == 0) { __threadfence(); __hip_atomic_fetch_add(cnt, 1u, __ATOMIC_RELAXED, __HIP_MEMORY_SCOPE_AGENT); }
    if (r < 4) {
        if (threadIdx.x == 0) { unsigned sp = 0; while (__hip_atomic_load(cnt, __ATOMIC_RELAXED, __HIP_MEMORY_SCOPE_AGENT) < (unsigned)nr && ++sp < (1u << 22)) __builtin_amdgcn_s_sleep(2); __threadfence(); }
        __syncthreads();
        const int g = r * 512 + fresh_tid(), b2 = g >> 10, ch = g & 1023; float carry = 0.f;
#pragma unroll 1
        for (int c0 = 0; c0 < 129; c0 += 16) {
            float av[16], bv[16];
#pragma unroll
            for (int k = 0; k < 16; ++k) { const int c = (c0 + k < 129) ? c0 + k : 128; const size_t o = (size_t)(b2 * 129 + c) * 1024 + ch; av[k] = ACH[o]; bv[k] = BCH[o]; }
#pragma unroll
            for (int k = 0; k < 16; ++k) if (c0 + k < 129) { CARRY[(size_t)(b2 * 129 + c0 + k) * 1024 + ch] = carry; carry = av[k] * carry + bv[k]; }
        }
    }
    }
}

__device__ __forceinline__ void mix_out_phase(const Params& p, int l) {
    const int tid = fresh_tid(), lane = tid & 63, wid = tid >> 6;
    bf16_t* HN = (bf16_t*)(p.ws + WS_HN); const bf16_t* PROJ = (const bf16_t*)(p.ws + WS_PROJ);
    const float* HL = p.out + OS_HL; const bf16_t* AC = (const bf16_t*)(p.out + OS_AC); const float* CARRY = (const float*)(p.ws + WS_CARRY);
    for (int row = blockIdx.x * 8 + wid; row < MROWS; row += gridDim.x * 8) {
        int sc, t, T, stream; bool samp = row >= SROW0;
        if (!samp) { stream = row / TP; t = row % TP; T = TP; sc = stream * 129 + (t + 48) / 64; }
        else { const int r = row - SROW0; stream = r >> 4; t = r & 15; T = 16; sc = 258 + stream; }
        const float* Orow = (const float*)(HN + (size_t)row * D);
        f32x4 o4[4], h4[4]; float ssA = 0.f, ssB[4];
#pragma unroll
        for (int q = 0; q < 4; ++q) { const int idx = 4 * lane + 256 * q; o4[q] = *(const f32x4*)(Orow + idx);
            const f32x4 hl = *(const f32x4*)(HL + (size_t)row * 1024 + idx); const u32x2 ac = *(const u32x2*)(AC + (size_t)row * 1024 + idx); const f32x4 ci = *(const f32x4*)(CARRY + (size_t)sc * 1024 + idx);
            h4[q][0] = hl[0] + bflo(ac.x) * ci[0]; h4[q][1] = hl[1] + bfhi(ac.x) * ci[1]; h4[q][2] = hl[2] + bflo(ac.y) * ci[2]; h4[q][3] = hl[3] + bfhi(ac.y) * ci[3];
#if TEST_SKIP == 1 || TEST_SKIP == 3
            h4[q] = (f32x4){0.f, 0.f, 0.f, 0.f};
#elif TEST_SKIP == 2
            o4[q] = (f32x4){0.f, 0.f, 0.f, 0.f};
#endif
            ssA += h4[q][0] * h4[q][0] + h4[q][1] * h4[q][1] + h4[q][2] * h4[q][2] + h4[q][3] * h4[q][3];
            ssB[q] = o4[q][0] * o4[q][0] + o4[q][1] * o4[q][1] + o4[q][2] * o4[q][2] + o4[q][3] * o4[q][3]; }
#pragma unroll
        for (int o = 1; o < 64; o <<= 1) ssA += __shfl_xor(ssA, o);
#pragma unroll
        for (int q = 0; q < 4; ++q) {
#pragma unroll
            for (int o = 1; o < 32; o <<= 1) ssB[q] += __shfl_xor(ssB[q], o); }
        const float rsA = rsqrtf(ssA * (1.f / 1024.f) + EPS);
        u32x2 ga[4], zz[4];
#pragma unroll
        for (int q = 0; q < 4; ++q) { const int idx = 4 * lane + 256 * q; ga[q] = *(const u32x2*)(PROJ + (size_t)row * PLD + 1024 + idx); zz[q] = *(const u32x2*)(PROJ + (size_t)row * PLD + 5120 + idx); }
        asm volatile("s_waitcnt vmcnt(0)" ::: "memory");
#pragma unroll
        for (int q = 0; q < 4; ++q) { const int idx = 4 * lane + 256 * q;
            const f32x4 na = *(const f32x4*)(p.in[20] + l * 1024 + idx); const f32x4 nb = *(const f32x4*)(p.in[24] + l * 128 + (idx & 127));
            const float rsB = rsqrtf(ssB[q] * (1.f / 128.f) + EPS);
            const float g0 = gelu_tanh(bflo(ga[q].x)), g1 = gelu_tanh(bfhi(ga[q].x)), g2 = gelu_tanh(bflo(ga[q].y)), g3 = gelu_tanh(bfhi(ga[q].y));
            u32x2 ya; ya.x = pk2(h4[q][0] * rsA * na[0] * g0, h4[q][1] * rsA * na[1] * g1); ya.y = pk2(h4[q][2] * rsA * na[2] * g2, h4[q][3] * rsA * na[3] * g3);
            const float z0 = siluf_(bflo(zz[q].x)), z1 = siluf_(bfhi(zz[q].x)), z2 = siluf_(bflo(zz[q].y)), z3 = siluf_(bfhi(zz[q].y));
            u32x2 yb; yb.x = pk2(o4[q][0] * rsB * nb[0] * z0, o4[q][1] * rsB * nb[1] * z1); yb.y = pk2(o4[q][2] * rsB * nb[2] * z2, o4[q][3] * rsB * nb[3] * z3);
#if TEST_SKIP == 3
            yb.x = pk2(o4[q][0], o4[q][1]); yb.y = pk2(o4[q][2], o4[q][3]);
#endif
            *(u32x2*)(HN + (size_t)row * D + idx) = ya; *(u32x2*)(HN + (size_t)row * D + 1024 + idx) = yb; }
        if (t >= T - 3) {
            const int j = t - (T - 3);
            float* lru = p.out + (samp ? O_SLRU + (size_t)(l * 16 + stream) * 1024 : O_PLRU + (size_t)(l * 2 + stream) * 1024);
            float* ca = p.out + (samp ? O_SCA + ((size_t)(l * 16 + stream) * 3 + j) * 1024 : O_PCA + ((size_t)(l * 2 + stream) * 3 + j) * 1024);
            float* cb = p.out + (samp ? O_SCB + ((size_t)(l * 16 + stream) * 3 + j) * 3072 : O_PCB + ((size_t)(l * 2 + stream) * 3 + j) * 3072);
#pragma unroll
            for (int q = 0; q < 4; ++q) { const int idx = 4 * lane + 256 * q; if (t == T - 1) *(f32x4*)(lru + idx) = h4[q];
                const u32x2 v = *(const u32x2*)(PROJ + (size_t)row * PLD + idx); *(f32x4*)(ca + idx) = (f32x4){bflo(v.x), bfhi(v.x), bflo(v.y), bfhi(v.y)}; }
#pragma unroll
            for (int q = 0; q < 12; ++q) { const int idx = 4 * lane + 256 * q; const u32x2 v = *(const u32x2*)(PROJ + (size_t)row * PLD + 2048 + idx);
                *(f32x4*)(cb + idx) = (f32x4){bflo(v.x), bfhi(v.x), bflo(v.y), bfhi(v.y)}; }
        }
    }
}

#define XB_TMO      128
#define XB_XCNT(j)  (256  + 64 * (j))
#define XB_XSUB(j)  (1280 + 64 * (j))
#define XB_XGEN(j)  (2304 + 64 * (j))
#define XB_TOP      3328
#define XB_TOPGEN   3392
#define XCD_BAR_WORDS 3456
#define XB_SPIN_CAP (1u << 18)
#define XB_LAS __attribute__((address_space(3)))

__device__ __forceinline__ unsigned xb_ld(unsigned* p)              { return __hip_atomic_load(p, __ATOMIC_RELAXED, __HIP_MEMORY_SCOPE_AGENT); }
__device__ __forceinline__ unsigned xb_add(unsigned* p, unsigned v) { return __hip_atomic_fetch_add(p, v, __ATOMIC_RELAXED, __HIP_MEMORY_SCOPE_AGENT); }
__device__ __forceinline__ unsigned xb_xcc_id() { return (unsigned)__builtin_amdgcn_s_getreg((3 << 11) | 20) & 0xFu; }
#define XB_SPIN(cond, bar) do { unsigned _sp = 0; while (cond) { __builtin_amdgcn_s_sleep(1); \
    if ((++_sp & 255u) == 0u) { if (xb_ld(&(bar)[XB_TMO])) break; if (_sp > XB_SPIN_CAP) { atomicAdd(&(bar)[XB_TMO], 1u); break; } } } } while (0)

struct XcdBarrier {
    unsigned* bar; unsigned x;
    volatile XB_LAS unsigned* st;
};

__device__ __forceinline__ XcdBarrier xcd_barrier_post(unsigned* bar, volatile XB_LAS unsigned* st) {
    XcdBarrier b; b.bar = bar; b.x = xb_xcc_id(); b.st = st;
    if (threadIdx.x == 0) (void)xb_add(&bar[XB_XCNT(b.x)], 1u);
    return b;
}
__device__ __forceinline__ void xcd_barrier_complete(unsigned* bar, unsigned x, unsigned& nloc, unsigned& nx) {
    const unsigned G = gridDim.x * gridDim.y * gridDim.z;
    unsigned sum, cnt, mine, sp = 0u;
    for (;;) {
        sum = 0u; cnt = 0u; mine = 0u;
#pragma unroll
        for (unsigned j = 0; j < 16; ++j) { const unsigned c = xb_ld(&bar[XB_XCNT(j)]); sum += c; cnt += (c > 0u) ? 1u : 0u; mine = (j == x) ? c : mine; }
        if (sum == G) break;
        __builtin_amdgcn_s_sleep(1);
        if ((++sp & 255u) == 0u) { if (xb_ld(&bar[XB_TMO])) break; if (sp > XB_SPIN_CAP) { atomicAdd(&bar[XB_TMO], 1u); break; } }
    }
    nloc = mine > 0u ? mine : 1u; nx = cnt > 0u ? cnt : 1u;
}

__device__ __forceinline__ void xcd_barrier(const XcdBarrier& b) {
    asm volatile("s_waitcnt vmcnt(0)" ::: "memory");
    __syncthreads();
    if (threadIdx.x == 0) {
        unsigned* bar = b.bar;
        __builtin_amdgcn_s_waitcnt(0);
        unsigned nloc = b.st[0], nx = b.st[1];
        if (nloc == 0u) { xcd_barrier_complete(bar, b.x, nloc, nx); b.st[0] = nloc; b.st[1] = nx; }
        const unsigned old = xb_add(&bar[XB_XSUB(b.x)], 1u);
        const unsigned gen = old / nloc;
        if (old + 1u == (gen + 1u) * nloc) {
            __builtin_amdgcn_fence(__ATOMIC_RELEASE, "agent");
            asm volatile("s_waitcnt vmcnt(0)" ::: "memory");
            const unsigned og = xb_add(&bar[XB_TOP], 1u);
            const unsigned tg = og / nx;
            if (og + 1u == (tg + 1u) * nx) xb_add(&bar[XB_TOPGEN], 1u);
            else XB_SPIN(xb_ld(&bar[XB_TOPGEN]) == tg, bar);
            __builtin_amdgcn_fence(__ATOMIC_ACQUIRE, "agent");
            xb_add(&bar[XB_XGEN(b.x)], 1u);
            asm volatile("s_waitcnt vmcnt(0)" ::: "memory");
        } else {
            XB_SPIN(xb_ld(&bar[XB_XGEN(b.x)]) == gen, bar);
            __builtin_amdgcn_fence(__ATOMIC_ACQUIRE, "agent");
            asm volatile("s_waitcnt vmcnt(0)" ::: "memory");
        }
    }
    __syncthreads();
}

struct SchedAll {
    pg8::StaticOrder so; int mode, nkt_full, nM, nN, nsplit, G, c;
    __device__ __forceinline__ void init(int M, int N, int K, int G_, int c_, int mode_) {
        mode = mode_; nkt_full = K / 64; nM = M / 256; nN = N / 256; G = G_; c = c_; so.init(M, N, G_, c_);
        nsplit = (K == DFF) ? 11 : 8;
    }
    __device__ __forceinline__ bool next(int i, pg8::Unit& u) const {
        const int nwg = nM * nN, nfull = nwg / G;
        if (!mode || i < nfull) { if (!so.next(i, u)) return false; u.kt0 = 0; u.nkt = nkt_full; u.part = 0; return true; }
        if (i > nfull) return false;
        const int left = nwg - nfull * G;
        if (c >= left * nsplit) return false;
        const int j = c / nsplit, ks = c - j * nsplit;
        unit_of(nfull * G + j, nM, nN, u.pm, u.pn); u.nkt = nkt_full / nsplit; u.kt0 = ks * u.nkt; u.part = 1; return true;
    }
    __device__ __forceinline__ void a_ready(const pg8::Unit&) const {}
    __device__ __forceinline__ void done(const pg8::Unit&) const {}
};
template <class Epi> __device__ __forceinline__ void run_gemm_sk(unsigned char* shm, const bf16_t* A, const bf16_t* Bt, int N, int K, const Epi& E, int mode, int fake = 0) {
    pg8::Gemm g; g.A = A; g.Bt = Bt; g.M = MP; g.N = N; g.K = K; g.fake = fake;
    SchedAll S; S.init(MP, N, K, (int)gridDim.x, (int)blockIdx.x, mode);
    pg8::gemm_phase<Epi, SchedAll, false>((PG8_LAS unsigned char*)shm, g, S, E, nullptr);
}
template <class Epi> __device__ __forceinline__ void run_gemm(unsigned char* shm, const bf16_t* A, const bf16_t* Bt, int N, int K, const Epi& E) {
    pg8::Gemm g; g.A = A; g.Bt = Bt; g.M = MP; g.N = N; g.K = K; g.fake = 0;
    pg8::StaticOrder S; S.init(MP, N, (int)gridDim.x, (int)blockIdx.x);
    pg8::gemm_phase<Epi, pg8::StaticOrder, false>((PG8_LAS unsigned char*)shm, g, S, E, nullptr);
}

__global__ void __launch_bounds__(512, 2) mega(Params p) {
    extern __shared__ __attribute__((aligned(16))) unsigned char shm[];
    bf16_t* HN = (bf16_t*)(p.ws + WS_HN); bf16_t* HID = (bf16_t*)(p.ws + WS_PROJ); float* X = (float*)(p.ws + WS_X);
#if N_LAUNCH_MODE == 1
    volatile XB_LAS unsigned* xbw = (volatile XB_LAS unsigned*)(shm + LDS_BYTES - 16);
    if (threadIdx.x == 0) { xbw[0] = 0u; xbw[1] = 0u; }
    __syncthreads();
    const XcdBarrier xb = xcd_barrier_post((unsigned*)(p.ws + WS_BAR), xbw);
#endif
    for (int ph = p.ph_lo; ph < p.ph_hi; ++ph) {
        const int l = ph / 12, kind = (ph == 24) ? 12 : ph % 12;
#if REP_MASK
        for (int rep = 0; rep < (((REP_MASK) >> kind) & 1 ? 2 : 1); ++rep) {
        if (rep) { __threadfence(); cg::this_grid().sync(); }
#endif
        if (PH_ON(0) && kind == 0) { prep_phase(p, l, (float*)shm); if (l == 0) norm_phase<1>(p, p.in[7], 0); else norm_phase2<0>(p, p.in[7] + l * D, 11); }
        else if (PH_ON(1) && (kind == 1 || kind == 10 || kind == 2 || kind == 11 || kind == 8 || kind == 4)) {
            EpiAll E; E.mode = (kind == 1 || kind == 10) ? 0 : (kind == 4 ? 2 : 1); E.Ob = (E.mode == 0) ? HID : (bf16_t*)(p.ws + WS_PROJ); E.Of = X; E.BA = (float*)(p.ws + WS_BA); E.scale = kind == 8 ? 1.f : 0.5f;
            E.PART = (float*)(p.ws + WS_PART) + (size_t)blockIdx.x * 65536;
#if REP_MASK
            if (((REP_MASK) >> kind) & 1) E.scale *= 0.5f;
#endif
            const bf16_t* A = (kind == 2 || kind == 11) ? HID : HN;
            size_t wo; int N, K;
            if (kind == 1) { wo = WS_WGU1; N = NGU; K = D; } else if (kind == 10) { wo = WS_WGU2; N = NGU; K = D; } else if (kind == 2) { wo = WS_WD1; N = D; K = DFF; }
            else if (kind == 11) { wo = WS_WD2; N = D; K = DFF; } else if (kind == 8) { wo = WS_WOUT; N = D; K = D; } else { wo = WS_WIN; N = NINP; K = D; }
#if REP_MASK
            if (rep) { E.mode = 3; run_gemm_sk(shm, A, (const bf16_t*)(p.ws + wo), N, K, E, 0, PROBE_FAKE); } else
#endif
            run_gemm_sk(shm, A, (const bf16_t*)(p.ws + wo), N, K, E, (E.mode == 1 && gridDim.x == 256) ? 1 : 0); }
        else if (PH_ON(3) && kind == 3) norm_phase2<0>(p, p.in[11] + l * D, 11);
        else if (PH_ON(3) && kind == 9) norm_phase2<0>(p, p.in[26] + l * D, 8);
        else if (PH_ON(5) && kind == 5) {
            for (int it = blockIdx.x; it < NSC * 8 + LRU_KEEP; it += gridDim.x) {
                if (it < NSC * 8) { if (PH_ON(13)) { gdn_item(p, l, it >> 3, it & 7, shm);
#if REP_MASK & 0x2000
                    gdn_item(p, l, it >> 3, it & 7, shm);
#endif
                } } else if (PH_ON(14)) { const int r = it - NSC * 8; lru_item(p, l, r >> 4, r & 15, shm);
#if REP_MASK & 0x4000
                    lru_item(p, l, r >> 4, r & 15, shm);
#endif
                } }
        }
        else if (PH_ON(6) && kind == 6) chain_phase(p, l, shm);
        else if (PH_ON(7) && kind == 7) mix_out_phase(p, l);
        else if (PH_ON(12) && kind == 12) norm_phase2<2>(p, p.in[30], 11);
#if REP_MASK
        }
#endif
#if N_LAUNCH_MODE == 1
        if (ph + 1 < p.ph_hi) { if (p.ph_hi > 1000) cg::this_grid().sync(); else xcd_barrier(xb); }
#else
        if (ph + 1 < p.ph_hi) cg::this_grid().sync();
#endif
    }
}

extern "C" void kernel_launch(void* const* d_in, const int* in_sizes, int n_in, void* d_out, int out_size, void* d_ws, size_t ws_size, hipStream_t stream) {
    static int grid = 0;
    if (grid == 0) {
        if (n_in != 31 || ws_size < WS_END) { fprintf(stderr, "kernel_launch: unexpected n_in %d or ws_size %zu (need %zu)\n", n_in, ws_size, (size_t)WS_END); grid = -1; return; }
        int dev = 0, cus = 0, per_cu = 0;
        hipGetDevice(&dev); hipDeviceGetAttribute(&cus, hipDeviceAttributeMultiprocessorCount, dev);
        if (hipFuncSetAttribute((const void*)mega, hipFuncAttributeMaxDynamicSharedMemorySize, LDS_BYTES) != hipSuccess) { fprintf(stderr, "kernel_launch: hipFuncSetAttribute failed\n"); grid = -1; return; }
        if (hipOccupancyMaxActiveBlocksPerMultiprocessor(&per_cu, (const void*)mega, 512, LDS_BYTES) != hipSuccess || per_cu < 1) { fprintf(stderr, "kernel_launch: occupancy query says %d\n", per_cu); per_cu = 1; }
        (void)hipGetLastError();
        grid = cus;
        if (grid < 128) { fprintf(stderr, "kernel_launch: only %d CUs\n", grid); grid = -1; return; }
    }
    if (grid < 0) return;
    Params p{};
#if TEST_MEMSET
    (void)hipMemsetAsync((unsigned char*)d_ws + WS_X, 0, WS_END - WS_X, stream);
#endif
    for (int i = 0; i < 31; ++i) p.in[i] = (const float*)d_in[i];
    p.out = (float*)d_out; p.ws = (unsigned char*)d_ws;
#if N_LAUNCH_MODE == 1
    p.ph_lo = 0; p.ph_hi = 25;
    (void)hipMemsetAsync((unsigned char*)d_ws + WS_BAR, 0, 16384, stream);
    void* args[] = {&p};
    hipError_t e = hipLaunchCooperativeKernel((const void*)mega, dim3(grid), dim3(512), args, LDS_BYTES, stream);
    if (e != hipSuccess) fprintf(stderr, "cooperative launch failed: %s (grid %d)\n", hipGetErrorString(e), grid);
#else
    for (int ph = 0; ph < 25; ++ph) { p.ph_lo = ph; p.ph_hi = ph + 1; hipLaunchKernelGGL(mega, dim3(grid), dim3(512), LDS_BYTES, stream, p); }
#endif
}
```

```cpp
#include <hip/hip_runtime.h>
#include <hip/hip_cooperative_groups.h>
#include <cstdio>
namespace cg = cooperative_groups;
namespace pg8 {
#define PG8_LAS __attribute__((address_space(3)))
typedef unsigned short bf16_t;
typedef short bf16x8 __attribute__((ext_vector_type(8)));
typedef float f32x4 __attribute__((ext_vector_type(4)));
typedef unsigned u32x4 __attribute__((ext_vector_type(4)));
constexpr int BM = 256, BK = 64, HALF = 128, HTB = HALF * BK * 2  , STAGE_BYTES = 8 * HTB, NXCD = 8, WGM = 8;
__host__ __device__ __forceinline__ int lds_byte(int r, int c) { const int st = (r >> 4) * 2 + (c >> 5), rr = r & 15, cc = c & 31, ob = rr * 64 + cc * 2; return st * 1024 + (ob ^ (((ob >> 9) & 1) << 5)); }
__host__ __device__ __forceinline__ void stage_rc(int b, int& R, int& C) { const int st = b / 1024, sb = b % 1024, swz = sb ^ (((sb >> 9) & 1) << 5); R = (st >> 1) * 16 + swz / 64; C = (st & 1) * 32 + (swz % 64) / 2; }
__host__ __device__ __forceinline__ int perm32(int rho) { const int n = rho >> 4, i = rho & 15; return 8 * (i >> 2) + 4 * n + (i & 3); }
struct Unit { int pm, pn, kt0, nkt, part; };
struct Gemm { const bf16_t* A; const bf16_t* Bt; int M, N, K, fake; };
struct StaticOrder {
    int nM, nN, nwg, G, c;
    __host__ __device__ void init(int M, int N, int G_, int c_) { nM = M / BM; nN = N / BM; nwg = nM * nN; G = G_; c = c_; }
    __host__ __device__ bool next(int i, Unit& u) const {
        const long L = (long)i * G + c; if (L >= nwg) return false;
        int wgid = (int)L; { const int q = nwg / NXCD, r = nwg % NXCD, xcd = wgid % NXCD, off = wgid / NXCD; wgid = (xcd < r ? xcd * (q + 1) : r * (q + 1) + (xcd - r) * q) + off; }
        const int nig = WGM * nN, gid = wgid / nig, fm = gid * WGM, gsz = (nM - fm) < WGM ? (nM - fm) : WGM;
        u.pm = fm + ((wgid % nig) % gsz); u.pn = (wgid % nig) / gsz; return true;
    }
    __device__ __forceinline__ void a_ready(const Unit&) const {}
    __device__ __forceinline__ void done(const Unit&) const {}
};
__device__ __forceinline__ unsigned cvt_pk_bf16(float lo, float hi) { unsigned r; asm volatile("v_cvt_pk_bf16_f32 %0, %1, %2" : "=v"(r) : "v"(lo), "v"(hi)); return r; }
template <class Epi, class Sched, bool STAMP = false>
__device__ __forceinline__ void gemm_phase(PG8_LAS unsigned char* lds, const Gemm g, const Sched& S, const Epi& E, unsigned long long* stamps) {
    int tid_ = threadIdx.x; asm volatile("" : "+v"(tid_)); const int tid = tid_, wid = __builtin_amdgcn_readfirstlane(tid >> 6), lane = tid & 63, wr = wid >> 2, wc = wid & 3, fr = lane & 15, fq = lane >> 4;
    const int K = g.K; int nt;
    int ts_lo = 0, ts_hi = 0, nts = 0; const unsigned long long rt_entry = STAMP ? (unsigned long long)wall_clock64() : 0ull;
#define PG8_STAMP() do { if (STAMP && wid == 0 && nts < 64) { const unsigned long long _c = (unsigned long long)clock64(); \
        ts_lo = (lane == nts) ? (int)(unsigned)_c : ts_lo; ts_hi = (lane == nts) ? (int)(unsigned)(_c >> 32) : ts_hi; ++nts; } } while (0)
    PG8_STAMP();
    unsigned voffA[2], voffB[2];
#pragma unroll
    for (int i = 0; i < 2; ++i) { int R, C; stage_rc(tid * 16 + i * 8192, R, C); const int Rb = E.perm() ? ((R & ~31) + perm32(R & 31)) : R;
        voffA[i] = (unsigned)(R * K + C) * 2u; voffB[i] = (unsigned)(Rb * K + C) * 2u; }
    const size_t kstep = (size_t)(BK * 2);
    const size_t hstep = (size_t)HALF * K * 2;
    const size_t tstep = 2 * hstep;
    const unsigned ldsw = (unsigned)wid * 1024u;
    const int aoff = lds_byte(wr * 64 + fr, fq * 8), boff = lds_byte(wc * 32 + fr, fq * 8);
#define PG8_SA(b, h) (((b) * 2 + (h)) * HTB)
#define PG8_SB(b, h) ((4 + (b) * 2 + (h)) * HTB)
#define PG8_STAGE(bufoff, gbase, voff) do { _Pragma("unroll") for (int _i = 0; _i < 2; ++_i) \
        __builtin_amdgcn_global_load_lds((const unsigned*)((const char*)(gbase) + (voff)[_i]), (PG8_LAS unsigned*)(lds + (bufoff) + ldsw + _i * 8192), 16, 0, 0); } while (0)
#define PG8_LDA(dst, b, h) do { _Pragma("unroll") for (int m = 0; m < 4; ++m) _Pragma("unroll") for (int k = 0; k < 2; ++k) dst[m][k] = *(const PG8_LAS bf16x8*)(lds + PG8_SA(b, h) + aoff + m * 2048 + k * 1024); } while (0)
#define PG8_LDB(dst, b, h) do { _Pragma("unroll") for (int n = 0; n < 2; ++n) _Pragma("unroll") for (int k = 0; k < 2; ++k) dst[n][k] = *(const PG8_LAS bf16x8*)(lds + PG8_SB(b, h) + boff + n * 2048 + k * 1024); } while (0)
#define PG8_MMA(ai, bj, At, Bt) do { __builtin_amdgcn_s_setprio(1); _Pragma("unroll") for (int m = 0; m < 4; ++m) _Pragma("unroll") for (int n = 0; n < 2; ++n) _Pragma("unroll") for (int k = 0; k < 2; ++k) \
        acc[ai][bj][m][n] = __builtin_amdgcn_mfma_f32_16x16x32_bf16(Bt[n][k], At[m][k], acc[ai][bj][m][n], 0, 0, 0); __builtin_amdgcn_s_setprio(0); } while (0)
#define PG8_WAIT_V(n) asm volatile("s_waitcnt vmcnt(" #n ")" ::: "memory")
#define PG8_WAIT_L(n) asm volatile("s_waitcnt lgkmcnt(" #n ")" ::: "memory")
#define PG8_BAR __builtin_amdgcn_s_barrier()
#define PG8_SCHED __builtin_amdgcn_sched_barrier(0)
    Unit cur, nxt; int ui = 0;
    if (!S.next(0, cur)) return;
    nt = cur.nkt;
    f32x4 acc[2][2][4][2];
#pragma unroll
    for (int a = 0; a < 2; ++a)
#pragma unroll
        for (int b = 0; b < 2; ++b)
#pragma unroll
            for (int m = 0; m < 4; ++m)
#pragma unroll
                for (int n = 0; n < 2; ++n) acc[a][b][m][n] = (f32x4){0.f, 0.f, 0.f, 0.f};
    bf16x8 At[4][2], B0[2][2], B1[2][2];
    const char* cA = (const char*)g.A + (g.fake ? (size_t)0 : (size_t)cur.pm * tstep) + (size_t)cur.kt0 * (size_t)(BK * 2); const char* cB = (const char*)g.Bt + (g.fake ? (size_t)0 : (size_t)cur.pn * tstep) + (size_t)cur.kt0 * (size_t)(BK * 2);
    S.a_ready(cur);
    PG8_STAGE(PG8_SB(0, 0), cB, voffB); PG8_STAGE(PG8_SA(0, 0), cA, voffA); PG8_STAGE(PG8_SB(0, 1), cB + hstep, voffB); PG8_STAGE(PG8_SA(0, 1), cA + hstep, voffA);
    if (wr == 1) PG8_BAR;
    PG8_WAIT_V(4); PG8_BAR;
    PG8_STAGE(PG8_SB(1, 0), cB + kstep, voffB); PG8_STAGE(PG8_SA(1, 0), cA + kstep, voffA); PG8_STAGE(PG8_SB(1, 1), cB + hstep + kstep, voffB);
    PG8_WAIT_V(6); PG8_BAR;
    PG8_STAMP();
    for (;;) {
        const bool has_next = S.next(ui + 1, nxt);
        const char* nA = has_next ? (const char*)g.A + (g.fake ? (size_t)0 : (size_t)nxt.pm * tstep) + (size_t)nxt.kt0 * kstep : cA; const char* nB = has_next ? (const char*)g.Bt + (g.fake ? (size_t)0 : (size_t)nxt.pn * tstep) + (size_t)nxt.kt0 * kstep : cB;
        for (int t = 0; t < nt; t += 2) {
            const bool last = (t == nt - 2);
            const char* a1 = cA + (size_t)(t + 1) * kstep;
            const char* a2 = last ? nA : cA + (size_t)(t + 2) * kstep; const char* b2 = last ? nB : cB + (size_t)(t + 2) * kstep;
            const char* a3 = a2 + kstep; const char* b3 = b2 + kstep;
            if (last && has_next) S.a_ready(nxt);
            PG8_LDB(B0, 0, 0); PG8_SCHED; PG8_LDA(At, 0, 0); PG8_STAGE(PG8_SA(1, 1), a1 + hstep, voffA);
            PG8_WAIT_L(8); PG8_BAR; PG8_WAIT_L(0); PG8_MMA(0, 0, At, B0); PG8_BAR; PG8_SCHED;
            PG8_LDB(B1, 0, 1); PG8_STAGE(PG8_SB(0, 0), b2, voffB);
            PG8_BAR; PG8_WAIT_L(0); PG8_MMA(0, 1, At, B1); PG8_BAR;
            PG8_LDA(At, 0, 1); PG8_STAGE(PG8_SA(0, 0), a2, voffA);
            PG8_BAR; PG8_WAIT_L(0); PG8_MMA(1, 0, At, B0); PG8_BAR; PG8_SCHED;
            PG8_STAGE(PG8_SB(0, 1), b2 + hstep, voffB);
            PG8_WAIT_V(6); PG8_BAR; PG8_MMA(1, 1, At, B1); PG8_BAR;
            PG8_LDB(B0, 1, 0); PG8_SCHED; PG8_LDA(At, 1, 0); PG8_STAGE(PG8_SA(0, 1), a2 + hstep, voffA);
            PG8_WAIT_L(8); PG8_BAR; PG8_WAIT_L(0); PG8_MMA(0, 0, At, B0); PG8_BAR; PG8_SCHED;
            PG8_LDB(B1, 1, 1); PG8_STAGE(PG8_SB(1, 0), b3, voffB);
            PG8_BAR; PG8_WAIT_L(0); PG8_MMA(0, 1, At, B1); PG8_BAR;
            PG8_LDA(At, 1, 1); PG8_STAGE(PG8_SA(1, 0), a3, voffA);
            PG8_BAR; PG8_WAIT_L(0); PG8_MMA(1, 0, At, B0); PG8_BAR; PG8_SCHED;
            PG8_STAGE(PG8_SB(1, 1), b3 + hstep, voffB);
            PG8_WAIT_V(6); PG8_BAR; PG8_MMA(1, 1, At, B1); PG8_BAR;
        }
        PG8_STAMP();
        if constexpr (!Epi::AFTER_DRAIN) { E(acc, cur, wr, wc, fr, fq); S.done(cur); }
        PG8_STAMP();
        if (!has_next) break;
#pragma unroll
        for (int a = 0; a < 2; ++a)
#pragma unroll
            for (int b = 0; b < 2; ++b)
#pragma unroll
                for (int m = 0; m < 4; ++m)
#pragma unroll
                    for (int n = 0; n < 2; ++n) acc[a][b][m][n] = (f32x4){0.f, 0.f, 0.f, 0.f};
        cur = nxt; cA = nA; cB = nB; ++ui; nt = cur.nkt;
    }
    PG8_WAIT_V(0);
    if (wr == 0) PG8_BAR;
    PG8_BAR;
    if constexpr (Epi::AFTER_DRAIN) { E.fused(acc, cur, wr, wc, fr, fq, lds, wid, lane); S.done(cur); }
    PG8_STAMP();
    if (STAMP && wid == 0) { stamps[lane] = lane < nts ? (((unsigned long long)(unsigned)ts_hi << 32) | (unsigned)ts_lo) : 0ull;
        if (lane == 62) stamps[62] = rt_entry; if (lane == 63) stamps[63] = (unsigned long long)wall_clock64(); }
#undef PG8_STAMP
#undef PG8_SA
#undef PG8_SB
#undef PG8_STAGE
#undef PG8_LDA
#undef PG8_LDB
#undef PG8_MMA
#undef PG8_WAIT_V
#undef PG8_WAIT_L
#undef PG8_BAR
#undef PG8_SCHED
}
}
using pg8::bf16_t; using pg8::bf16x8; using pg8::f32x4; using pg8::u32x4;
typedef unsigned u32x2 __attribute__((ext_vector_type(2)));

constexpr int D = 2048, TP = 8208, NSS = 16;
constexpr int MROWS = 16672, MP = 16896, SROW0 = 16416;
constexpr int DFF = 5632, NGU = 11264, NINP = 6400, PLD = 6144;
constexpr int NSC = 274;
constexpr float EPS = 1e-6f;
constexpr int LDS_BYTES = 147456;
#ifndef TEST_MEMSET
#define TEST_MEMSET 0
#endif
#ifndef LRU_KEEP
#define LRU_KEEP 0
#endif
#ifndef PROBE_FAKE
#define PROBE_FAKE 1
#endif
#ifndef REP_MASK
#define REP_MASK 0
#endif
#ifndef TEST_SKIP
#define TEST_SKIP 0
#endif
#ifndef PH_MASK
#define PH_MASK 0x7fff
#endif
#define PH_ON(k) (((PH_MASK) >> (k)) & 1)
#ifndef N_LAUNCH_MODE
#define N_LAUNCH_MODE 1
#endif

constexpr size_t SZ_WGU = (size_t)NGU * D * 2, SZ_WD = (size_t)D * DFF * 2, SZ_WIN = (size_t)NINP * D * 2, SZ_WOUT = (size_t)D * D * 2;
constexpr size_t WS_WGU1 = 0, WS_WD1 = WS_WGU1 + SZ_WGU, WS_WGU2 = WS_WD1 + SZ_WD, WS_WD2 = WS_WGU2 + SZ_WGU, WS_WIN = WS_WD2 + SZ_WD, WS_WOUT = WS_WIN + SZ_WIN,
    WS_WG = WS_WOUT + SZ_WOUT, WS_X = WS_WG + 262144, WS_HN = WS_X + (size_t)MP * D * 4, WS_PROJ = WS_HN + (size_t)MP * D * 2, WS_GCH = WS_PROJ + (size_t)MP * PLD * 2,
    WS_BA = WS_GCH + (size_t)NSC * 8 * 73728, WS_GE = WS_BA + (size_t)MP * 16 * 4, WS_ACH = WS_GE + 16384, WS_BCH = WS_ACH + (size_t)NSC * 1024 * 4,
    WS_CARRY = WS_BCH + (size_t)NSC * 1024 * 4, WS_PART = WS_CARRY + (size_t)NSC * 1024 * 4, WS_BAR = WS_PART + (size_t)256 * 65536 * 4, WS_END = WS_BAR + 16384;
constexpr size_t O_YP = 0, O_YS = 33554432, O_PCA = 34078720, O_PLRU = 34091008, O_PCB = 34095104, O_PDL = 34131968, O_SCA = 34656256, O_SLRU = 34754560,
    O_SCB = 34787328, O_SDL = 35082240;
constexpr size_t OS_HL = 0, OS_AC = (size_t)MROWS * 1024;

__device__ __forceinline__ int fresh_tid() { int t = threadIdx.x; asm volatile("" : "+v"(t)); return t; }
__device__ __forceinline__ void unit_of(int L, int nM, int nN, int& pm, int& pn) {
    const int nwg = nM * nN; int wgid = L; { const int q = nwg / 8, r = nwg % 8, xcd = wgid % 8, off = wgid / 8; wgid = (xcd < r ? xcd * (q + 1) : r * (q + 1) + (xcd - r) * q) + off; }
    const int nig = 8 * nN, gid = wgid / nig, fm = gid * 8, gsz = (nM - fm) < 8 ? (nM - fm) : 8;
    pm = fm + ((wgid % nig) % gsz); pn = (wgid % nig) / gsz;
}
struct Params { const float* in[31]; float* out; unsigned char* ws; int ph_lo, ph_hi; };

typedef __bf16 bf16v2 __attribute__((ext_vector_type(2)));
__device__ __forceinline__ unsigned pk2(float lo, float hi) { bf16v2 v; v[0] = (__bf16)lo; v[1] = (__bf16)hi; return __builtin_bit_cast(unsigned, v); }
__device__ __forceinline__ float bflo(unsigned u) { return __uint_as_float(u << 16); }
__device__ __forceinline__ float bfhi(unsigned u) { return __uint_as_float(u & 0xffff0000u); }
__device__ __forceinline__ float bf2f(bf16_t b) { return __uint_as_float(((unsigned)b) << 16); }
__device__ __forceinline__ float sigmoidf_(float x) { return __builtin_amdgcn_rcpf(1.f + __expf(-x)); }
__device__ __forceinline__ float siluf_(float x) { return x * __builtin_amdgcn_rcpf(1.f + __expf(-x)); }
__device__ __forceinline__ float softplusf_(float x) { return x > 20.f ? x : log1pf(__expf(x)); }
__device__ __forceinline__ float gelu_tanh(float x) { const float y = 0.7978845608028654f * (x + 0.044715f * x * x * x); const float t = 1.f - 2.f * __builtin_amdgcn_rcpf(1.f + __expf(2.f * y)); return 0.5f * x * (1.f + t); }
__device__ __forceinline__ void unpack8(const u32x4 v, float (&f)[8]) { f[0] = bflo(v.x); f[1] = bfhi(v.x); f[2] = bflo(v.y); f[3] = bfhi(v.y); f[4] = bflo(v.z); f[5] = bfhi(v.z); f[6] = bflo(v.w); f[7] = bfhi(v.w); }
__device__ __forceinline__ u32x4 pack8(const float (&f)[8]) { u32x4 o; o.x = pk2(f[0], f[1]); o.y = pk2(f[2], f[3]); o.z = pk2(f[4], f[5]); o.w = pk2(f[6], f[7]); return o; }
__device__ __forceinline__ f32x4 mfma16(bf16x8 a, bf16x8 b, f32x4 c) { return __builtin_amdgcn_mfma_f32_16x16x32_bf16(a, b, c, 0, 0, 0); }

struct EpiGU {
    static constexpr bool PERM = false, AFTER_DRAIN = false;
    bf16_t* H;
    __device__ __forceinline__ void operator()(const f32x4 (&acc)[2][2][4][2], const pg8::Unit& u, int wr, int wc, int fr, int fq) const {
        const int row0 = u.pm * 256 + wr * 64 + fr, hc0 = u.pn * 128 + wc * 16 + 4 * fq;
#pragma unroll
        for (int ai = 0; ai < 2; ++ai)
#pragma unroll
            for (int m = 0; m < 4; ++m) { u32x2 o[2];
#pragma unroll
                for (int bj = 0; bj < 2; ++bj) { const f32x4 g = acc[ai][bj][m][0], up = acc[ai][bj][m][1];
                    o[bj].x = pk2(siluf_(g[0]) * up[0], siluf_(g[1]) * up[1]); o[bj].y = pk2(siluf_(g[2]) * up[2], siluf_(g[3]) * up[3]); }
                const auto rx = __builtin_amdgcn_permlane16_swap(o[0].x, o[1].x, false, false); const auto ry = __builtin_amdgcn_permlane16_swap(o[0].y, o[1].y, false, false);
                u32x4 w; w.x = rx[0]; w.y = ry[0]; w.z = rx[1]; w.w = ry[1];
                *(u32x4*)(H + (size_t)(row0 + ai * 128 + m * 16) * DFF + u.pn * 128 + 64 * (fq & 1) + wc * 16 + 8 * (fq >> 1)) = w; }
    }
};
struct EpiRes {
    static constexpr bool PERM = false, AFTER_DRAIN = false;
    float* X; float scale; float* PART;
    __device__ __forceinline__ void operator()(const f32x4 (&acc)[2][2][4][2], const pg8::Unit& u, int wr, int wc, int fr, int fq) const {
        const bool tail = u.part != 0;
        const int rl0 = wr * 64 + fr, cl0 = wc * 32 + 4 * fq;
        float* base = tail ? PART + (size_t)rl0 * 256 + cl0 : X + (size_t)(u.pm * 256 + rl0) * D + u.pn * 256 + cl0;
        const size_t ld = tail ? 256 : D;
#pragma unroll
        for (int ai = 0; ai < 2; ++ai)
#pragma unroll
            for (int m = 0; m < 4; ++m) { float* rowp = base + (size_t)(ai * 128 + m * 16) * ld;
#pragma unroll
                for (int bj = 0; bj < 2; ++bj)
#pragma unroll
                    for (int n = 0; n < 2; ++n) { f32x4* q = (f32x4*)(rowp + bj * 128 + n * 16); f32x4 v = acc[ai][bj][m][n] * scale; if (!tail) v = v + *q; *q = v; } }
    }
};
struct EpiProj {
    static constexpr bool PERM = true, AFTER_DRAIN = false;
    bf16_t* P; float* BA;
    __device__ __forceinline__ void operator()(const f32x4 (&acc)[2][2][4][2], const pg8::Unit& u, int wr, int wc, int fr, int fq) const {
        const int row0 = u.pm * 256 + wr * 64 + fr;
        if (u.pn < 24) {
            const int col0 = u.pn * 256 + wc * 32 + 8 * fq;
#pragma unroll
            for (int ai = 0; ai < 2; ++ai)
#pragma unroll
                for (int m = 0; m < 4; ++m) { bf16_t* rowp = P + (size_t)(row0 + ai * 128 + m * 16) * PLD + col0;
#pragma unroll
                    for (int bj = 0; bj < 2; ++bj) { const f32x4 v0 = acc[ai][bj][m][0], v1 = acc[ai][bj][m][1];
                        u32x4 w; w.x = pk2(v0[0], v0[1]); w.y = pk2(v0[2], v0[3]); w.z = pk2(v1[0], v1[1]); w.w = pk2(v1[2], v1[3]);
                        *(u32x4*)(rowp + bj * 128) = w; } }
        } else if (wc == 0 && fq < 2) {
#pragma unroll
            for (int ai = 0; ai < 2; ++ai)
#pragma unroll
                for (int m = 0; m < 4; ++m) { float* q = BA + (size_t)(row0 + ai * 128 + m * 16) * 16 + 8 * fq;
                    *(f32x4*)q = acc[ai][0][m][0]; *(f32x4*)(q + 4) = acc[ai][0][m][1]; }
        }
    }
};

struct EpiAll {
    static constexpr bool AFTER_DRAIN = false;
    int mode; bf16_t* Ob; float* Of; float* BA; float scale; float* PART;
    __device__ __forceinline__ bool perm() const { return mode == 2; }
    __device__ __forceinline__ void operator()(const f32x4 (&acc)[2][2][4][2], const pg8::Unit& u, int wr, int wc, int fr, int fq) const {
        if (mode == 3) {
            f32x4 s = {0.f, 0.f, 0.f, 0.f};
#pragma unroll
            for (int ai = 0; ai < 2; ++ai)
#pragma unroll
                for (int bj = 0; bj < 2; ++bj)
#pragma unroll
                    for (int m = 0; m < 4; ++m)
#pragma unroll
                        for (int n = 0; n < 2; ++n) s = s + acc[ai][bj][m][n];
            if (s[0] + s[1] + s[2] + s[3] == 12345.678f) BA[0] = s[0];
            return; }
        if (mode == 0) { EpiGU e; e.H = Ob; e(acc, u, wr, wc, fr, fq); }
        else if (mode == 1) { EpiRes e; e.X = Of; e.scale = scale; e.PART = PART; e(acc, u, wr, wc, fr, fq); }
        else { EpiProj e; e.P = Ob; e.BA = BA; e(acc, u, wr, wc, fr, fq); }
    }
};

__device__ __forceinline__ void tr_tile(const float* W, int K, int N, int kb, int nb, bf16_t* dst, int mode, float* tile) {
    const int tid = fresh_tid(), k0 = kb * 64, n0 = nb * 64;
    { const int nn = tid & 63, kq = tid >> 6, n = n0 + nn;
#pragma unroll
        for (int r = 0; r < 8; ++r) { const int kk = r * 8 + kq; tile[kk * 65 + nn] = (n < N) ? W[(size_t)(k0 + kk) * N + n] : 0.f; } }
    __syncthreads();
    { const int nn = tid >> 3, kc = tid & 7, n = n0 + nn; int drow = n;
        if (mode == 1) drow = (n >> 4) * 32 + (n & 15); else if (mode == 2) drow = (n >> 4) * 32 + 16 + (n & 15);
        const float* s = tile + (kc * 8) * 65 + nn; u32x4 o; o.x = pk2(s[0], s[65]); o.y = pk2(s[130], s[195]); o.z = pk2(s[260], s[325]); o.w = pk2(s[390], s[455]);
        *(u32x4*)(dst + (size_t)drow * K + k0 + kc * 8) = o; }
    __syncthreads();
}
struct TrJob { const float* W; bf16_t* dst; int K, N, mode, kb, nb; };
__device__ __forceinline__ TrJob prep_job(const Params& p, int l, int it) {
    TrJob j;
    if (it < 4224) { const int m = it / 704, r = it % 704, f = m / 3, w = m % 3;
        j.W = p.in[(f ? 27 : 8) + w] + (size_t)l * 2048 * 5632;
        if (w < 2) { j.K = 2048; j.N = 5632; j.kb = r / 22; j.nb = r % 22; j.mode = w + 1; j.dst = (bf16_t*)(p.ws + (f ? WS_WGU2 : WS_WGU1)); }
        else { j.K = 5632; j.N = 2048; j.kb = r / 8; j.nb = r % 8; j.mode = 0; j.dst = (bf16_t*)(p.ws + (f ? WS_WD2 : WS_WD1)); }
    } else if (it < 5024) { const int r = it - 4224; j.W = p.in[12] + (size_t)l * 2048 * 6160; j.K = 2048; j.N = 6160; j.kb = r / 25; j.nb = r % 25; j.mode = 0; j.dst = (bf16_t*)(p.ws + WS_WIN);
    } else { const int r = it - 5024; j.W = p.in[25] + (size_t)l * 2048 * 2048; j.K = 2048; j.N = 2048; j.kb = r / 8; j.nb = r % 8; j.mode = 0; j.dst = (bf16_t*)(p.ws + WS_WOUT); }
    return j;
}
__device__ __forceinline__ void tr_load(const TrJob& j, f32x4 (&v)[8], int tid) {
    const int lane = tid & 63, wid = tid >> 6, n = j.nb * 256 + lane * 4;
#pragma unroll
    for (int ps = 0; ps < 8; ++ps) v[ps] = (n < j.N) ? *(const f32x4*)(j.W + (size_t)(j.kb * 64 + ps * 8 + wid) * j.N + n) : (f32x4){0.f, 0.f, 0.f, 0.f};
}
__device__ __forceinline__ void prep_phase(const Params& p, int l, float* tile) {
    constexpr int NJ = 5280;
    const int tid = fresh_tid(), lane = tid & 63, wid = tid >> 6;
    int it = blockIdx.x; f32x4 v[8]; TrJob job;
    if (it < NJ) { job = prep_job(p, l, it); tr_load(job, v, tid); }
    while (it < NJ) {
#pragma unroll
        for (int ps = 0; ps < 8; ++ps) *(f32x4*)(tile + (ps * 8 + wid) * 260 + lane * 4) = v[ps];
        __syncthreads();
        const TrJob cur = job; it += gridDim.x;
        if (it < NJ) { job = prep_job(p, l, it); tr_load(job, v, tid); }
#pragma unroll
        for (int r = 0; r < 4; ++r) { const int q = tid + 512 * r, nl = q & 255, kc = q >> 8, n = cur.nb * 256 + nl; int drow = n;
            if (cur.mode == 1) drow = (n >> 4) * 32 + (n & 15); else if (cur.mode == 2) drow = (n >> 4) * 32 + 16 + (n & 15);
            const float* s = tile + (kc * 8) * 260 + nl; u32x4 o; o.x = pk2(s[0], s[260]); o.y = pk2(s[520], s[780]); o.z = pk2(s[1040], s[1300]); o.w = pk2(s[1560], s[1820]);
            *(u32x4*)(cur.dst + (size_t)drow * cur.K + cur.kb * 64 + kc * 8) = o; }
        __syncthreads();
    }
    for (int r = blockIdx.x; r < 32; r += gridDim.x) { const int n = r >> 1, g = r & 1; tr_tile(p.in[g ? 17 : 15] + (size_t)l * 65536 + n * 4096, 64, 64, 0, 0, (bf16_t*)(p.ws + WS_WG) + r * 4096, 0, tile); }
}

template <int MODE>
__device__ __forceinline__ void norm_phase(const Params& p, const float* w, int ndp) {
    const int tid = fresh_tid(), lane = tid & 63, wid = tid >> 6;
    float* X = (float*)(p.ws + WS_X); bf16_t* HN = (bf16_t*)(p.ws + WS_HN);
    for (int row = blockIdx.x * 8 + wid; row < MP; row += gridDim.x * 8) {
        if (row >= MROWS) {
            if (MODE != 2) {
#pragma unroll
                for (int q = 0; q < 8; ++q) { const int idx = 4 * lane + 256 * q; *(u32x2*)(HN + (size_t)row * D + idx) = (u32x2){0u, 0u};
                    if (MODE == 1) *(f32x4*)(X + (size_t)row * D + idx) = (f32x4){0.f, 0.f, 0.f, 0.f}; } }
            continue; }
        const float* src = X + (size_t)row * D; float* dsto = nullptr;
        if (MODE != 0) {
            if (row < SROW0) { const int b = row / TP, t = row % TP;
                if (MODE == 1) src = t < 16 ? p.in[6] + (size_t)t * D : p.in[0] + ((size_t)b * 8192 + (t - 16)) * D;
                else dsto = t < 16 ? nullptr : p.out + O_YP + ((size_t)b * 8192 + (t - 16)) * D;
            } else { const int r = row - SROW0; if (MODE == 1) src = p.in[1] + (size_t)r * D; else dsto = p.out + O_YS + (size_t)r * D; }
            if (MODE == 2 && dsto == nullptr) continue;
        }
        f32x4 v[8]; float ss = 0.f;
#pragma unroll
        for (int q = 0; q < 8; ++q) v[q] = *(const f32x4*)(src + 4 * lane + 256 * q);
        if (MODE != 1 && ndp > 0 && gridDim.x == 256) {
            const int pm = row >> 8, rl = row & 255;
#pragma unroll 1
            for (int j = 0; j < 16; ++j) { int upm, upn; unit_of(512 + j, MP / 256, 8, upm, upn);
                if (upm == pm) {
                    f32x4 s = {0.f, 0.f, 0.f, 0.f};
                    for (int ks = 0; ks < ndp; ++ks) s = s + *(const f32x4*)((const float*)(p.ws + WS_PART) + (size_t)(j * ndp + ks) * 65536 + rl * 256 + 4 * lane);
#pragma unroll
                    for (int q = 0; q < 8; ++q) if (upn == q) { v[q] = v[q] + s; *(f32x4*)(X + (size_t)row * D + 4 * lane + 256 * q) = v[q]; }
                } }
        }
#pragma unroll
        for (int q = 0; q < 8; ++q) { ss += v[q][0] * v[q][0] + v[q][1] * v[q][1] + v[q][2] * v[q][2] + v[q][3] * v[q][3]; }
#pragma unroll
        for (int o = 1; o < 64; o <<= 1) ss += __shfl_xor(ss, o);
        const float rs = rsqrtf(ss * (1.f / 2048.f) + EPS);
#pragma unroll
        for (int q = 0; q < 8; ++q) { const int idx = 4 * lane + 256 * q; const f32x4 wv = *(const f32x4*)(w + idx); const f32x4 y = v[q] * rs * wv;
            if (MODE == 2) *(f32x4*)(dsto + idx) = y;
            else { u32x2 o; o.x = pk2(y[0], y[1]); o.y = pk2(y[2], y[3]); *(u32x2*)(HN + (size_t)row * D + idx) = o; if (MODE == 1) *(f32x4*)(X + (size_t)row * D + idx) = v[q]; } }
    }
}

template <int MODE>
__device__ __forceinline__ void norm_phase2(const Params& p, const float* w, int ndp) {
    const int tid = fresh_tid(), lane = tid & 63, wid = tid >> 6;
    float* X = (float*)(p.ws + WS_X); bf16_t* HN = (bf16_t*)(p.ws + WS_HN);
    const int stride = gridDim.x * 8;
    for (int row0 = blockIdx.x * 8 + wid; row0 < MP; row0 += 2 * stride) {
        f32x4 v[2][8]; float* dsto[2]; bool act[2];
#pragma unroll
        for (int t = 0; t < 2; ++t) {
            const int row = row0 + t * stride; act[t] = row < MROWS; dsto[t] = nullptr;
            if (MODE == 0 && row >= MROWS && row < MP) {
#pragma unroll
                for (int q = 0; q < 8; ++q) *(u32x2*)(HN + (size_t)row * D + 4 * lane + 256 * q) = (u32x2){0u, 0u}; }
            if (MODE == 2 && act[t]) {
                if (row < SROW0) { const int b = row / TP, tt = row % TP; dsto[t] = tt < 16 ? nullptr : p.out + O_YP + ((size_t)b * 8192 + (tt - 16)) * D; }
                else dsto[t] = p.out + O_YS + (size_t)(row - SROW0) * D;
                act[t] = dsto[t] != nullptr; }
            if (act[t]) {
#pragma unroll
                for (int q = 0; q < 8; ++q) v[t][q] = *(const f32x4*)(X + (size_t)row * D + 4 * lane + 256 * q); }
        }
#pragma unroll
        for (int t = 0; t < 2; ++t) {
            if (!act[t]) continue;
            const int row = row0 + t * stride;
            if (ndp > 0 && gridDim.x == 256) {
                const int pm = row >> 8, rl = row & 255;
#pragma unroll 1
                for (int j = 0; j < 16; ++j) { int upm, upn; unit_of(512 + j, MP / 256, 8, upm, upn);
                    if (upm == pm) {
                        f32x4 s = {0.f, 0.f, 0.f, 0.f};
                        for (int ks = 0; ks < ndp; ++ks) s = s + *(const f32x4*)((const float*)(p.ws + WS_PART) + (size_t)(j * ndp + ks) * 65536 + rl * 256 + 4 * lane);
#pragma unroll
                        for (int q = 0; q < 8; ++q) if (upn == q) { v[t][q] = v[t][q] + s; *(f32x4*)(X + (size_t)row * D + 4 * lane + 256 * q) = v[t][q]; }
                    } }
            }
            float ss = 0.f;
#pragma unroll
            for (int q = 0; q < 8; ++q) ss += v[t][q][0] * v[t][q][0] + v[t][q][1] * v[t][q][1] + v[t][q][2] * v[t][q][2] + v[t][q][3] * v[t][q][3];
#pragma unroll
            for (int o = 1; o < 64; o <<= 1) ss += __shfl_xor(ss, o);
            const float rs = rsqrtf(ss * (1.f / 2048.f) + EPS);
#pragma unroll
            for (int q = 0; q < 8; ++q) { const int idx = 4 * lane + 256 * q; const f32x4 wv = *(const f32x4*)(w + idx); const f32x4 y = v[t][q] * rs * wv;
                if (MODE == 2) *(f32x4*)(dsto[t] + idx) = y;
                else { u32x2 o; o.x = pk2(y[0], y[1]); o.y = pk2(y[2], y[3]); *(u32x2*)(HN + (size_t)row * D + idx) = o; } }
        }
    }
}

struct ChunkGeo { int row0, tok0, valid_lo, samp; };
__device__ __forceinline__ ChunkGeo chunk_geo(int sc) {
    ChunkGeo g;
    if (sc < 258) { const int b = sc / 129, c = sc % 129; g.tok0 = 64 * c - 48; g.row0 = b * TP + g.tok0; g.valid_lo = c == 0 ? 48 : 0; g.samp = -1; }
    else { const int s = sc - 258; g.tok0 = -48; g.row0 = SROW0 + 16 * s - 48; g.valid_lo = 48; g.samp = s; }
    return g;
}

__device__ __forceinline__ void gdn_item(const Params& p, int l, int sc, int h, unsigned char* shm) {
    const int tid = fresh_tid(), L = tid & 63, w = tid >> 6;
    bf16_t* qs = (bf16_t*)shm; bf16_t* ks = (bf16_t*)(shm + 17408); float* sol = (float*)(shm + 34816); float* Lm = (float*)(shm + 100352); float* qkm = (float*)(shm + 116736);
    float* gcs = (float*)(shm + 134144); float* betas = gcs + 64; float* egcs = gcs + 128;
    const ChunkGeo G = chunk_geo(sc);
    const bf16_t* PROJ = (const bf16_t*)(p.ws + WS_PROJ); const float* BA = (const float*)(p.ws + WS_BA);
    const int item = sc * 8 + h; unsigned char* ib = p.ws + WS_GCH + (size_t)item * 73728;
    if (w == 0) {
        const int i = L; float beta = 0.f, g = 0.f;
        if (i >= G.valid_lo) { const float* ba = BA + (size_t)(G.row0 + i) * 16; beta = sigmoidf_(ba[h]); g = -__expf(p.in[22][l * 8 + h]) * softplusf_(ba[8 + h] + p.in[23][l * 8 + h]); }
#pragma unroll
        for (int o = 1; o < 64; o <<= 1) { const float v = __shfl_up(g, o); if (L >= o) g += v; }
        gcs[i] = g; betas[i] = beta; egcs[i] = __expf(g);
        if (L == 63) ((float*)(p.ws + WS_GE))[item] = __expf(g);
    }
    float pend[6][8];
#pragma unroll
    for (int r = 0; r < 6; ++r) {
        const int e = tid + 512 * r, pos = e / 48, cgi = e % 48, typ = cgi >> 4, c8 = (cgi & 15) * 8, col = typ * 1024 + h * 128 + c8;
        const bool valid = pos >= G.valid_lo;
        float acc[8];
#pragma unroll
        for (int k = 0; k < 8; ++k) acc[k] = 0.f;
        if (valid) {
#pragma unroll
            for (int j = 0; j < 4; ++j) {
                const int m = G.tok0 + pos - 3 + j; float xv[8]; bool have = true;
                if (m >= 0) { const u32x4 raw = *(const u32x4*)(PROJ + (size_t)(G.row0 + pos - 3 + j) * PLD + 2048 + col); unpack8(raw, xv); }
                else if (G.samp >= 0) { const float* sp = p.in[4] + ((size_t)(l * 16 + G.samp) * 3 + (3 + m)) * 3072 + col; const f32x4 a = *(const f32x4*)sp, b = *(const f32x4*)(sp + 4);
                    xv[0] = a[0]; xv[1] = a[1]; xv[2] = a[2]; xv[3] = a[3]; xv[4] = b[0]; xv[5] = b[1]; xv[6] = b[2]; xv[7] = b[3]; }
                else have = false;
                if (have) { const float* wp = p.in[21] + (size_t)(l * 4 + j) * 3072 + col; const f32x4 wa = *(const f32x4*)wp, wb = *(const f32x4*)(wp + 4);
                    acc[0] += xv[0] * wa[0]; acc[1] += xv[1] * wa[1]; acc[2] += xv[2] * wa[2]; acc[3] += xv[3] * wa[3];
                    acc[4] += xv[4] * wb[0]; acc[5] += xv[5] * wb[1]; acc[6] += xv[6] * wb[2]; acc[7] += xv[7] * wb[3]; }
            }
        }
        float ss = 0.f;
#pragma unroll
        for (int k = 0; k < 8; ++k) { acc[k] = siluf_(acc[k]); ss += acc[k] * acc[k]; }
        ss += __shfl_xor(ss, 1); ss += __shfl_xor(ss, 2); ss += __shfl_xor(ss, 4); ss += __shfl_xor(ss, 8);
        if (typ < 2) { const float scl = rsqrtf(ss + EPS) * (typ == 0 ? 0.08838834764831845f : 1.f);
#pragma unroll
            for (int k = 0; k < 8; ++k) acc[k] *= scl;
            *(u32x4*)((typ == 0 ? qs : ks) + pos * 136 + c8) = pack8(acc);
        }
#pragma unroll
        for (int k = 0; k < 8; ++k) pend[r][k] = acc[k];
    }
    __syncthreads();
#pragma unroll
    for (int r = 0; r < 6; ++r) {
        const int e = tid + 512 * r, pos = e / 48, cgi = e % 48, typ = cgi >> 4, c8 = (cgi & 15) * 8;
        if (typ >= 1) { const float f = typ == 1 ? betas[pos] * egcs[pos] : betas[pos]; float* d = sol + pos * 256 + (typ == 1 ? 128 : 0) + c8;
            *(f32x4*)d = (f32x4){f * pend[r][0], f * pend[r][1], f * pend[r][2], f * pend[r][3]}; *(f32x4*)(d + 4) = (f32x4){f * pend[r][4], f * pend[r][5], f * pend[r][6], f * pend[r][7]}; }
    }
    {
        const int mat = w >> 2, mt = w & 3, lr = L & 15, lq = L >> 4;
        const bf16_t* Asrc = mat ? qs : ks; bf16x8 a[4];
#pragma unroll
        for (int s = 0; s < 4; ++s) a[s] = *(const bf16x8*)(Asrc + (16 * mt + lr) * 136 + 32 * s + lq * 8);
#pragma unroll
        for (int nt = 0; nt < 4; ++nt) {
            f32x4 c = {0.f, 0.f, 0.f, 0.f};
#pragma unroll
            for (int s = 0; s < 4; ++s) { const bf16x8 b = *(const bf16x8*)(ks + (16 * nt + lr) * 136 + 32 * s + lq * 8); c = mfma16(a[s], b, c); }
            const int j = 16 * nt + lr; const float gj = gcs[j];
#pragma unroll
            for (int r = 0; r < 4; ++r) { const int i = 16 * mt + lq * 4 + r; const float dec = __expf(fminf(gcs[i] - gj, 0.f));
                if (mat == 0) Lm[i * 64 + j] = (i > j) ? betas[i] * dec * c[r] : 0.f;
                else qkm[i * 68 + j] = (i >= j) ? dec * c[r] : 0.f; }
        }
    }
    __syncthreads();
    {
        const int c = tid & 255; const bool mainw = tid < 256; const int t2 = tid - 256; const float gl = gcs[63];
#define GD_LOAD(ACC, B_) _Pragma("unroll") for (int r = 0; r < 16; ++r) ACC[r] = sol[(16 * (B_) + r) * 256 + c]
#define GD_STORE(ACC, B_) _Pragma("unroll") for (int r = 0; r < 16; ++r) sol[(16 * (B_) + r) * 256 + c] = ACC[r]
#define GD_PAIR(ACC, B_, JB_) do { float xj[16]; _Pragma("unroll") for (int k = 0; k < 16; ++k) xj[k] = sol[(16 * (JB_) + k) * 256 + c]; \
            _Pragma("unroll") for (int r = 0; r < 16; ++r) { const float* lr = Lm + (16 * (B_) + r) * 64 + 16 * (JB_); \
                _Pragma("unroll") for (int k4 = 0; k4 < 4; ++k4) { const f32x4 lv = *(const f32x4*)(lr + 4 * k4); \
                    ACC[r] -= lv[0] * xj[4 * k4]; ACC[r] -= lv[1] * xj[4 * k4 + 1]; ACC[r] -= lv[2] * xj[4 * k4 + 2]; ACC[r] -= lv[3] * xj[4 * k4 + 3]; } } } while (0)
#define GD_DIAG(ACC, B_) do { _Pragma("unroll") for (int r = 1; r < 16; ++r) { const float* lr = Lm + (16 * (B_) + r) * 64 + 16 * (B_); \
                _Pragma("unroll") for (int k4 = 0; k4 < (r + 3) / 4; ++k4) { const f32x4 lv = *(const f32x4*)(lr + 4 * k4); \
                    if (4 * k4 < r) ACC[r] -= lv[0] * ACC[4 * k4]; if (4 * k4 + 1 < r) ACC[r] -= lv[1] * ACC[4 * k4 + 1]; \
                    if (4 * k4 + 2 < r) ACC[r] -= lv[2] * ACC[4 * k4 + 2]; if (4 * k4 + 3 < r) ACC[r] -= lv[3] * ACC[4 * k4 + 3]; } } } while (0)
        float acc[16];
#pragma unroll 1
        for (int st = 0; st < 4; ++st) {
            if (mainw) { GD_LOAD(acc, st); if (st > 0) GD_PAIR(acc, st, st - 1); GD_DIAG(acc, st); GD_STORE(acc, st); }
            else if (st == 0) {
#pragma unroll
        for (int r = 0; r < 4; ++r) {
            const int q = t2 + 256 * r, Lq = q & 63, f = q >> 6, mt = f >> 2, s = f & 3, i = 16 * mt + (Lq & 15), k0 = 32 * s + (Lq >> 4) * 8;
            float v[8]; unpack8(*(const u32x4*)(qs + i * 136 + k0), v); const float e = egcs[i];
#pragma unroll
            for (int k = 0; k < 8; ++k) v[k] *= e;
            *(u32x4*)(ib + 16384 + (size_t)q * 16) = pack8(v); }
#pragma unroll
        for (int r = 0; r < 2; ++r) {
            const int q = t2 + 256 * r, Lq = q & 63, f = q >> 6, mt = f >> 1, s = f & 1, i = 16 * mt + (Lq & 15), j0 = 32 * s + (Lq >> 4) * 8;
            float v[8]; const f32x4 a = *(const f32x4*)(qkm + i * 68 + j0), b = *(const f32x4*)(qkm + i * 68 + j0 + 4);
            v[0] = a[0]; v[1] = a[1]; v[2] = a[2]; v[3] = a[3]; v[4] = b[0]; v[5] = b[1]; v[6] = b[2]; v[7] = b[3];
            *(u32x4*)(ib + 49152 + (size_t)q * 16) = pack8(v); }
            } else if (st < 3) {
#pragma unroll 1
                for (int Bp = st + 1; Bp < 4; ++Bp) { GD_LOAD(acc, Bp); GD_PAIR(acc, Bp, st - 1); GD_STORE(acc, Bp); }
            } else {
#pragma unroll
        for (int r = 0; r < 4; ++r) {
            const int q = t2 + 256 * r, Lq = q & 63, f = q >> 6, mt = f >> 1, s = f & 1, dk = 16 * mt + (Lq & 15), j0 = 32 * s + (Lq >> 4) * 8;
            float v[8];
#pragma unroll
            for (int k = 0; k < 8; ++k) v[k] = bf2f(ks[(j0 + k) * 136 + dk]) * __expf(fminf(gl - gcs[j0 + k], 0.f));
            *(u32x4*)(ib + 32768 + (size_t)q * 16) = pack8(v); }
            }
            if (st < 3) __syncthreads();
        }
#undef GD_LOAD
#undef GD_STORE
#undef GD_PAIR
#undef GD_DIAG
    }
    __syncthreads();
#pragma unroll
    for (int r = 0; r < 2; ++r) {
        const int q = tid + 512 * r, Lq = q & 63, f = q >> 6, mt = f >> 2, s = f & 3, i = 16 * mt + (Lq & 15), k0 = 32 * s + (Lq >> 4) * 8;
        float v[8]; const f32x4 a = *(const f32x4*)(sol + i * 256 + 128 + k0), b = *(const f32x4*)(sol + i * 256 + 128 + k0 + 4);
        v[0] = a[0]; v[1] = a[1]; v[2] = a[2]; v[3] = a[3]; v[4] = b[0]; v[5] = b[1]; v[6] = b[2]; v[7] = b[3];
        *(u32x4*)(ib + (size_t)q * 16) = pack8(v); }
#pragma unroll
    for (int r = 0; r < 4; ++r) {
        const int q = tid + 512 * r, Lq = q & 63, f = q >> 6, mt = f >> 3, ntile = f & 7, i0 = 16 * mt + (Lq >> 4) * 4, cc = 16 * ntile + (Lq & 15);
        u32x2 o; o.x = pk2(sol[i0 * 256 + cc], sol[(i0 + 1) * 256 + cc]); o.y = pk2(sol[(i0 + 2) * 256 + cc], sol[(i0 + 3) * 256 + cc]);
        *(u32x2*)(ib + 57344 + (size_t)q * 8) = o; }
    __syncthreads();
}

__device__ __forceinline__ void lru_item(const Params& p, int l, int sc, int n, unsigned char* shm) {
    const int tid = fresh_tid(), L = tid & 63, w = tid >> 6;
    bf16_t* xs = (bf16_t*)shm; float* xf = (float*)(shm + 9216); float* gr = (float*)(shm + 25856);
    const ChunkGeo G = chunk_geo(sc);
    const bf16_t* PROJ = (const bf16_t*)(p.ws + WS_PROJ);
    const int g_ = w >> 2, nt_ = w & 3, lr_ = L & 15, lq_ = L >> 4;
    bf16x8 bfr[2];
    { const bf16_t* WG = (const bf16_t*)(p.ws + WS_WG) + (size_t)(n * 2 + g_) * 4096;
#pragma unroll
        for (int s = 0; s < 2; ++s) bfr[s] = *(const bf16x8*)(WG + (16 * nt_ + lr_) * 64 + 32 * s + lq_ * 8); }
    const float bias_ = p.in[g_ ? 18 : 16][l * 1024 + n * 64 + 16 * nt_ + lr_];
    const float lam_ = p.in[19][l * 1024 + n * 64 + (tid & 63)];
    {
        const int pos = tid >> 3, cgi = tid & 7, ch0 = n * 64 + cgi * 8; float acc[8];
        { const float* bp = p.in[14] + l * 1024 + ch0; const f32x4 a = *(const f32x4*)bp, b = *(const f32x4*)(bp + 4);
            acc[0] = a[0]; acc[1] = a[1]; acc[2] = a[2]; acc[3] = a[3]; acc[4] = b[0]; acc[5] = b[1]; acc[6] = b[2]; acc[7] = b[3]; }
        if (pos >= G.valid_lo) {
#pragma unroll
            for (int j = 0; j < 4; ++j) {
                const int m = G.tok0 + pos - 3 + j; float xv[8]; bool have = true;
                if (m >= 0) { unpack8(*(const u32x4*)(PROJ + (size_t)(G.row0 + pos - 3 + j) * PLD + ch0), xv); }
                else if (G.samp >= 0) { const float* sp = p.in[2] + ((size_t)(l * 16 + G.samp) * 3 + (3 + m)) * 1024 + ch0; const f32x4 a = *(const f32x4*)sp, b = *(const f32x4*)(sp + 4);
                    xv[0] = a[0]; xv[1] = a[1]; xv[2] = a[2]; xv[3] = a[3]; xv[4] = b[0]; xv[5] = b[1]; xv[6] = b[2]; xv[7] = b[3]; }
                else have = false;
                if (have) { const float* wp = p.in[13] + (size_t)(l * 4 + j) * 1024 + ch0; const f32x4 wa = *(const f32x4*)wp, wb = *(const f32x4*)(wp + 4);
                    acc[0] += xv[0] * wa[0]; acc[1] += xv[1] * wa[1]; acc[2] += xv[2] * wa[2]; acc[3] += xv[3] * wa[3];
                    acc[4] += xv[4] * wb[0]; acc[5] += xv[5] * wb[1]; acc[6] += xv[6] * wb[2]; acc[7] += xv[7] * wb[3]; }
            }
        }
        *(u32x4*)(xs + pos * 72 + cgi * 8) = pack8(acc);
#pragma unroll
        for (int k = 0; k < 8; ++k) xf[pos * 65 + cgi * 8 + k] = acc[k];
    }
    __syncthreads();
    {
        const int g = g_, nt = nt_, lr = lr_, lq = lq_;
#pragma unroll
        for (int mt = 0; mt < 4; ++mt) {
            f32x4 c = {0.f, 0.f, 0.f, 0.f};
#pragma unroll
            for (int s = 0; s < 2; ++s) { const bf16x8 a = *(const bf16x8*)(xs + (16 * mt + lr) * 72 + 32 * s + lq * 8); c = mfma16(a, bfr[s], c); }
#pragma unroll
            for (int r = 0; r < 4; ++r) gr[g * 4160 + (16 * mt + lq * 4 + r) * 65 + 16 * nt + lr] = sigmoidf_(c[r] + bias_);
        }
    }
    __syncthreads();
    {
        const int ch = tid & 63; const float sp = softplusf_(-lam_);
#pragma unroll
        for (int k = 0; k < 8; ++k) { const int tok = (tid >> 6) + 8 * k, o = tok * 65 + ch;
            const float r = gr[o], ig = gr[4160 + o], x = xf[o]; const float la = -8.f * r * sp; float a = __expf(la); float bb = sqrtf(fmaxf(-expm1f(2.f * la), 0.f)) * ig * x;
            if (tok < G.valid_lo) { a = 1.f; bb = 0.f; }
            gr[o] = a; gr[4160 + o] = bb; }
    }
    __syncthreads();
    {
        const int ch = L; float A = 1.f, hh = 0.f, hs[8], As[8];
#pragma unroll
        for (int k = 0; k < 8; ++k) { const int tok = 8 * w + k; const float a = gr[tok * 65 + ch], b2 = gr[4160 + tok * 65 + ch]; hh = a * hh + b2; A *= a; hs[k] = hh; As[k] = A; }
        xf[w * 64 + ch] = A; xf[512 + w * 64 + ch] = hh;
        __syncthreads();
        float cA = 1.f, cH = 0.f;
#pragma unroll
        for (int j = 0; j < 7; ++j) { if (j < w) { const float sa = xf[j * 64 + ch], sh = xf[512 + j * 64 + ch]; cH = sa * cH + sh; cA *= sa; } }
        float* HL = p.out + OS_HL; bf16_t* AC = (bf16_t*)(p.out + OS_AC);
#pragma unroll
        for (int k = 0; k < 8; ++k) { const int tok = 8 * w + k; const float ht = hs[k] + As[k] * cH, At = As[k] * cA;
            if (tok >= G.valid_lo) { const size_t o = (size_t)(G.row0 + tok) * 1024 + n * 64 + ch; HL[o] = ht; AC[o] = (bf16_t)(pk2(At, 0.f) & 0xffffu); }
            if (w == 7 && k == 7) { ((float*)(p.ws + WS_ACH))[sc * 1024 + n * 64 + ch] = At; ((float*)(p.ws + WS_BCH))[sc * 1024 + n * 64 + ch] = ht; } }
    }
    __syncthreads();
}

struct Frags { bf16x8 a1[4]; bf16x8 a2[2]; bf16x8 ke[2]; u32x2 u[2]; float ge; };
__device__ __forceinline__ void chain_load(Frags& f, const unsigned char* ib, const float* GE, int item, int role, int mt, int w, int d, int L) {
    const unsigned char* a1b = ib + (role ? 16384 : 0);
#pragma unroll
    for (int s = 0; s < 4; ++s) f.a1[s] = *(const bf16x8*)(a1b + (size_t)((mt * 4 + s) * 64 + L) * 16);
    if (role) {
#pragma unroll
        for (int s = 0; s < 2; ++s) f.a2[s] = *(const bf16x8*)(ib + 49152 + (size_t)((mt * 2 + s) * 64 + L) * 16);
    } else {
#pragma unroll
        for (int nt = 0; nt < 2; ++nt) f.u[nt] = *(const u32x2*)(ib + 57344 + (size_t)((mt * 8 + 2 * d + nt) * 64 + L) * 8);
    }
#pragma unroll
    for (int s = 0; s < 2; ++s) f.ke[s] = *(const bf16x8*)(ib + 32768 + (size_t)((w * 2 + s) * 64 + L) * 16);
    f.ge = GE[item];
}
__device__ __forceinline__ void chain_step(const Frags& f, f32x4 (&S)[2], unsigned char* St, unsigned char* wt, int role, int mt, int w, int L, float* Orow, int valid_lo) {
    const int lr = L & 15, lq = L >> 4;
    f32x4 acc[2]; acc[0] = (f32x4){0.f, 0.f, 0.f, 0.f}; acc[1] = acc[0];
#pragma unroll
    for (int s = 0; s < 4; ++s)
#pragma unroll
        for (int nt = 0; nt < 2; ++nt) { const bf16x8 b = *(const bf16x8*)(St + (16 * nt + lr) * 272 + (32 * s + lq * 8) * 2); acc[nt] = mfma16(f.a1[s], b, acc[nt]); }
    if (!role) {
#pragma unroll
        for (int nt = 0; nt < 2; ++nt) { u32x2 o; o.x = pk2(bflo(f.u[nt].x) - acc[nt][0], bfhi(f.u[nt].x) - acc[nt][1]); o.y = pk2(bflo(f.u[nt].y) - acc[nt][2], bfhi(f.u[nt].y) - acc[nt][3]);
            *(u32x2*)(wt + (16 * nt + lr) * 144 + (16 * mt + lq * 4) * 2) = o; }
    }
    __syncthreads();
    bf16x8 bw[2][2];
#pragma unroll
    for (int nt = 0; nt < 2; ++nt)
#pragma unroll
        for (int s = 0; s < 2; ++s) bw[nt][s] = *(const bf16x8*)(wt + (16 * nt + lr) * 144 + (32 * s + lq * 8) * 2);
    if (role) {
#pragma unroll
        for (int nt = 0; nt < 2; ++nt) {
#pragma unroll
            for (int s = 0; s < 2; ++s) acc[nt] = mfma16(f.a2[s], bw[nt][s], acc[nt]);
#pragma unroll
            for (int r = 0; r < 4; ++r) { const int i = 16 * mt + lq * 4 + r; if (i >= valid_lo) Orow[(ptrdiff_t)i * 1024 + 16 * nt + lr] = acc[nt][r]; } }
    }
#pragma unroll
    for (int nt = 0; nt < 2; ++nt) { S[nt] = S[nt] * f.ge;
#pragma unroll
        for (int s = 0; s < 2; ++s) S[nt] = mfma16(f.ke[s], bw[nt][s], S[nt]);
        u32x2 o; o.x = pk2(S[nt][0], S[nt][1]); o.y = pk2(S[nt][2], S[nt][3]);
        *(u32x2*)(St + (16 * nt + lr) * 272 + (16 * w + lq * 4) * 2) = o; }
    __syncthreads();
}
__device__ __forceinline__ void gdn_chain(const Params& p, int l, int stream, int h, int d, unsigned char* shm) {
    const int tid = fresh_tid(), L = tid & 63, w = tid >> 6, role = w >> 2, mt = w & 3, lr = L & 15, lq = L >> 4;
    const bool samp = stream >= 2; const int s = stream - 2;
    const int sc0 = samp ? 258 + s : stream * 129, nsteps = samp ? 1 : 129;
    unsigned char* St = shm; unsigned char* wt = shm + 8704;
    const float* GE = (const float*)(p.ws + WS_GE);
    float* O = (float*)(p.ws + WS_HN);
    f32x4 S[2];
#pragma unroll
    for (int nt = 0; nt < 2; ++nt)
#pragma unroll
        for (int r = 0; r < 4; ++r) S[nt][r] = samp ? p.in[5][((size_t)((l * 16 + s) * 8 + h) * 128 + 16 * w + lq * 4 + r) * 128 + 32 * d + 16 * nt + lr] : 0.f;
#pragma unroll
    for (int nt = 0; nt < 2; ++nt) { u32x2 o; o.x = pk2(S[nt][0], S[nt][1]); o.y = pk2(S[nt][2], S[nt][3]); *(u32x2*)(St + (16 * nt + lr) * 272 + (16 * w + lq * 4) * 2) = o; }
    Frags fa, fb;
    const unsigned char* gch = p.ws + WS_GCH;
    chain_load(fa, gch + (size_t)(sc0 * 8 + h) * 73728, GE, sc0 * 8 + h, role, mt, w, d, L);
    __syncthreads();
    const ptrdiff_t rbase = samp ? (ptrdiff_t)(SROW0 + 16 * s - 48) : (ptrdiff_t)(stream * TP - 48);
    for (int c = 0; c < nsteps; c += 2) {
        if (c + 1 < nsteps) { const int it = (sc0 + c + 1) * 8 + h; chain_load(fb, gch + (size_t)it * 73728, GE, it, role, mt, w, d, L); }
        chain_step(fa, S, St, wt, role, mt, w, L, O + (rbase + 64 * c) * 1024 + h * 128 + 32 * d, (c == 0) ? 48 : 0);
        if (c + 1 < nsteps) {
            if (c + 2 < nsteps) { const int it = (sc0 + c + 2) * 8 + h; chain_load(fa, gch + (size_t)it * 73728, GE, it, role, mt, w, d, L); }
            chain_step(fb, S, St, wt, role, mt, w, L, O + (rbase + 64 * (c + 1)) * 1024 + h * 128 + 32 * d, 0);
        }
    }
    float* dst = p.out + (samp ? O_SDL + (size_t)((l * 16 + s) * 8 + h) * 16384 : O_PDL + (size_t)((l * 2 + stream) * 8 + h) * 16384);
#pragma unroll
    for (int nt = 0; nt < 2; ++nt)
#pragma unroll
        for (int r = 0; r < 4; ++r) dst[(size_t)(16 * w + lq * 4 + r) * 128 + 32 * d + 16 * nt + lr] = S[nt][r];
}
__device__ __forceinline__ void chain_phase(const Params& p, int l, unsigned char* shm) {
    const int bid = blockIdx.x;
    if (bid < 64) { const int pair = (bid & 7) * 2 + ((bid >> 3) >> 2), d = (bid >> 3) & 3; gdn_chain(p, l, pair >> 3, pair & 7, d, shm);
#if REP_MASK & 0x8000
        __syncthreads(); gdn_chain(p, l, pair >> 3, pair & 7, d, shm);
#endif
        return; }
#if REP_MASK & 0x10000
    for (int rr = 0; rr < 2; ++rr) {
#else
    {
#endif
    const int r = bid - 64, nr = gridDim.x - 64;
    const float* ACH = (const float*)(p.ws + WS_ACH); const float* BCH = (const float*)(p.ws + WS_BCH); float* CARRY = (float*)(p.ws + WS_CARRY);
    for (int g = r * 512 + fresh_tid(); g < 16384; g += nr * 512) { const int s = g >> 10, ch = g & 1023; CARRY[(size_t)(258 + s) * 1024 + ch] = p.in[3][(size_t)(l * 16 + s) * 1024 + ch]; }
    for (int q = r; q < 512; q += nr) { const int pair = q >> 2, d = q & 3; gdn_chain(p, l, 2 + (pair >> 3), pair & 7, d, shm); }
    __syncthreads();
    for (int li = LRU_KEEP + r; li < NSC * 16; li += nr) lru_item(p, l, li >> 4, li & 15, shm);
    unsigned* cnt = (unsigned*)(p.ws + WS_BAR) + 3600 + 64 * l;
    __syncthreads();
    if (threadIdx.x == 0) { __threadfence(); __hip_atomic_fetch_add(cnt, 1u, __ATOMIC_RELAXED, __HIP_MEMORY_SCOPE_AGENT); }
    if (r < 4) {
        if (threadIdx.x == 0) { unsigned sp = 0; while (__hip_atomic_load(cnt, __ATOMIC_RELAXED, __HIP_MEMORY_SCOPE_AGENT) < (unsigned)nr && ++sp < (1u << 22)) __builtin_amdgcn_s_sleep(2); __threadfence(); }
        __syncthreads();
        const int g = r * 512 + fresh_tid(), b2 = g >> 10, ch = g & 1023; float carry = 0.f;
#pragma unroll 1
        for (int c0 = 0; c0 < 129; c0 += 16) {
            float av[16], bv[16];
#pragma unroll
            for (int k = 0; k < 16; ++k) { const int c = (c0 + k < 129) ? c0 + k : 128; const size_t o = (size_t)(b2 * 129 + c) * 1024 + ch; av[k] = ACH[o]; bv[k] = BCH[o]; }
#pragma unroll
            for (int k = 0; k < 16; ++k) if (c0 + k < 129) { CARRY[(size_t)(b2 * 129 + c0 + k) * 1024 + ch] = carry; carry = av[k] * carry + bv[k]; }
        }
    }
    }
}

__device__ __forceinline__ void mix_out_phase(const Params& p, int l) {
    const int tid = fresh_tid(), lane = tid & 63, wid = tid >> 6;
    bf16_t* HN = (bf16_t*)(p.ws + WS_HN); const bf16_t* PROJ = (const bf16_t*)(p.ws + WS_PROJ);
    const float* HL = p.out + OS_HL; const bf16_t* AC = (const bf16_t*)(p.out + OS_AC); const float* CARRY = (const float*)(p.ws + WS_CARRY);
    for (int row = blockIdx.x * 8 + wid; row < MROWS; row += gridDim.x * 8) {
        int sc, t, T, stream; bool samp = row >= SROW0;
        if (!samp) { stream = row / TP; t = row % TP; T = TP; sc = stream * 129 + (t + 48) / 64; }
        else { const int r = row - SROW0; stream = r >> 4; t = r & 15; T = 16; sc = 258 + stream; }
        const float* Orow = (const float*)(HN + (size_t)row * D);
        f32x4 o4[4], h4[4]; float ssA = 0.f, ssB[4];
#pragma unroll
        for (int q = 0; q < 4; ++q) { const int idx = 4 * lane + 256 * q; o4[q] = *(const f32x4*)(Orow + idx);
            const f32x4 hl = *(const f32x4*)(HL + (size_t)row * 1024 + idx); const u32x2 ac = *(const u32x2*)(AC + (size_t)row * 1024 + idx); const f32x4 ci = *(const f32x4*)(CARRY + (size_t)sc * 1024 + idx);
            h4[q][0] = hl[0] + bflo(ac.x) * ci[0]; h4[q][1] = hl[1] + bfhi(ac.x) * ci[1]; h4[q][2] = hl[2] + bflo(ac.y) * ci[2]; h4[q][3] = hl[3] + bfhi(ac.y) * ci[3];
#if TEST_SKIP == 1 || TEST_SKIP == 3
            h4[q] = (f32x4){0.f, 0.f, 0.f, 0.f};
#elif TEST_SKIP == 2
            o4[q] = (f32x4){0.f, 0.f, 0.f, 0.f};
#endif
            ssA += h4[q][0] * h4[q][0] + h4[q][1] * h4[q][1] + h4[q][2] * h4[q][2] + h4[q][3] * h4[q][3];
            ssB[q] = o4[q][0] * o4[q][0] + o4[q][1] * o4[q][1] + o4[q][2] * o4[q][2] + o4[q][3] * o4[q][3]; }
#pragma unroll
        for (int o = 1; o < 64; o <<= 1) ssA += __shfl_xor(ssA, o);
#pragma unroll
        for (int q = 0; q < 4; ++q) {
#pragma unroll
            for (int o = 1; o < 32; o <<= 1) ssB[q] += __shfl_xor(ssB[q], o); }
        const float rsA = rsqrtf(ssA * (1.f / 1024.f) + EPS);
        u32x2 ga[4], zz[4];
#pragma unroll
        for (int q = 0; q < 4; ++q) { const int idx = 4 * lane + 256 * q; ga[q] = *(const u32x2*)(PROJ + (size_t)row * PLD + 1024 + idx); zz[q] = *(const u32x2*)(PROJ + (size_t)row * PLD + 5120 + idx); }
        asm volatile("s_waitcnt vmcnt(0)" ::: "memory");
#pragma unroll
        for (int q = 0; q < 4; ++q) { const int idx = 4 * lane + 256 * q;
            const f32x4 na = *(const f32x4*)(p.in[20] + l * 1024 + idx); const f32x4 nb = *(const f32x4*)(p.in[24] + l * 128 + (idx & 127));
            const float rsB = rsqrtf(ssB[q] * (1.f / 128.f) + EPS);
            const float g0 = gelu_tanh(bflo(ga[q].x)), g1 = gelu_tanh(bfhi(ga[q].x)), g2 = gelu_tanh(bflo(ga[q].y)), g3 = gelu_tanh(bfhi(ga[q].y));
            u32x2 ya; ya.x = pk2(h4[q][0] * rsA * na[0] * g0, h4[q][1] * rsA * na[1] * g1); ya.y = pk2(h4[q][2] * rsA * na[2] * g2, h4[q][3] * rsA * na[3] * g3);
            const float z0 = siluf_(bflo(zz[q].x)), z1 = siluf_(bfhi(zz[q].x)), z2 = siluf_(bflo(zz[q].y)), z3 = siluf_(bfhi(zz[q].y));
            u32x2 yb; yb.x = pk2(o4[q][0] * rsB * nb[0] * z0, o4[q][1] * rsB * nb[1] * z1); yb.y = pk2(o4[q][2] * rsB * nb[2] * z2, o4[q][3] * rsB * nb[3] * z3);
#if TEST_SKIP == 3
            yb.x = pk2(o4[q][0], o4[q][1]); yb.y = pk2(o4[q][2], o4[q][3]);
#endif
            *(u32x2*)(HN + (size_t)row * D + idx) = ya; *(u32x2*)(HN + (size_t)row * D + 1024 + idx) = yb; }
        if (t >= T - 3) {
            const int j = t - (T - 3);
            float* lru = p.out + (samp ? O_SLRU + (size_t)(l * 16 + stream) * 1024 : O_PLRU + (size_t)(l * 2 + stream) * 1024);
            float* ca = p.out + (samp ? O_SCA + ((size_t)(l * 16 + stream) * 3 + j) * 1024 : O_PCA + ((size_t)(l * 2 + stream) * 3 + j) * 1024);
            float* cb = p.out + (samp ? O_SCB + ((size_t)(l * 16 + stream) * 3 + j) * 3072 : O_PCB + ((size_t)(l * 2 + stream) * 3 + j) * 3072);
#pragma unroll
            for (int q = 0; q < 4; ++q) { const int idx = 4 * lane + 256 * q; if (t == T - 1) *(f32x4*)(lru + idx) = h4[q];
                const u32x2 v = *(const u32x2*)(PROJ + (size_t)row * PLD + idx); *(f32x4*)(ca + idx) = (f32x4){bflo(v.x), bfhi(v.x), bflo(v.y), bfhi(v.y)}; }
#pragma unroll
            for (int q = 0; q < 12; ++q) { const int idx = 4 * lane + 256 * q; const u32x2 v = *(const u32x2*)(PROJ + (size_t)row * PLD + 2048 + idx);
                *(f32x4*)(cb + idx) = (f32x4){bflo(v.x), bfhi(v.x), bflo(v.y), bfhi(v.y)}; }
        }
    }
}

#define XB_TMO      128
#define XB_XCNT(j)  (256  + 64 * (j))
#define XB_XSUB(j)  (1280 + 64 * (j))
#define XB_XGEN(j)  (2304 + 64 * (j))
#define XB_TOP      3328
#define XB_TOPGEN   3392
#define XCD_BAR_WORDS 3456
#define XB_SPIN_CAP (1u << 18)
#define XB_LAS __attribute__((address_space(3)))

__device__ __forceinline__ unsigned xb_ld(unsigned* p)              { return __hip_atomic_load(p, __ATOMIC_RELAXED, __HIP_MEMORY_SCOPE_AGENT); }
__device__ __forceinline__ unsigned xb_add(unsigned* p, unsigned v) { return __hip_atomic_fetch_add(p, v, __ATOMIC_RELAXED, __HIP_MEMORY_SCOPE_AGENT); }
__device__ __forceinline__ unsigned xb_xcc_id() { return (unsigned)__builtin_amdgcn_s_getreg((3 << 11) | 20) & 0xFu; }
#define XB_SPIN(cond, bar) do { unsigned _sp = 0; while (cond) { __builtin_amdgcn_s_sleep(1); \
    if ((++_sp & 255u) == 0u) { if (xb_ld(&(bar)[XB_TMO])) break; if (_sp > XB_SPIN_CAP) { atomicAdd(&(bar)[XB_TMO], 1u); break; } } } } while (0)

struct XcdBarrier {
    unsigned* bar; unsigned x;
    volatile XB_LAS unsigned* st;
};

__device__ __forceinline__ XcdBarrier xcd_barrier_post(unsigned* bar, volatile XB_LAS unsigned* st) {
    XcdBarrier b; b.bar = bar; b.x = xb_xcc_id(); b.st = st;
    if (threadIdx.x == 0) (void)xb_add(&bar[XB_XCNT(b.x)], 1u);
    return b;
}
__device__ __forceinline__ void xcd_barrier_complete(unsigned* bar, unsigned x, unsigned& nloc, unsigned& nx) {
    const unsigned G = gridDim.x * gridDim.y * gridDim.z;
    unsigned sum, cnt, mine, sp = 0u;
    for (;;) {
        sum = 0u; cnt = 0u; mine = 0u;
#pragma unroll
        for (unsigned j = 0; j < 16; ++j) { const unsigned c = xb_ld(&bar[XB_XCNT(j)]); sum += c; cnt += (c > 0u) ? 1u : 0u; mine = (j == x) ? c : mine; }
        if (sum == G) break;
        __builtin_amdgcn_s_sleep(1);
        if ((++sp & 255u) == 0u) { if (xb_ld(&bar[XB_TMO])) break; if (sp > XB_SPIN_CAP) { atomicAdd(&bar[XB_TMO], 1u); break; } }
    }
    nloc = mine > 0u ? mine : 1u; nx = cnt > 0u ? cnt : 1u;
}

__device__ __forceinline__ void xcd_barrier(const XcdBarrier& b) {
    asm volatile("s_waitcnt vmcnt(0)" ::: "memory");
    __syncthreads();
    if (threadIdx.x == 0) {
        unsigned* bar = b.bar;
        __builtin_amdgcn_s_waitcnt(0);
        unsigned nloc = b.st[0], nx = b.st[1];
        if (nloc == 0u) { xcd_barrier_complete(bar, b.x, nloc, nx); b.st[0] = nloc; b.st[1] = nx; }
        const unsigned old = xb_add(&bar[XB_XSUB(b.x)], 1u);
        const unsigned gen = old / nloc;
        if (old + 1u == (gen + 1u) * nloc) {
            __builtin_amdgcn_fence(__ATOMIC_RELEASE, "agent");
            asm volatile("s_waitcnt vmcnt(0)" ::: "memory");
            const unsigned og = xb_add(&bar[XB_TOP], 1u);
            const unsigned tg = og / nx;
            if (og + 1u == (tg + 1u) * nx) xb_add(&bar[XB_TOPGEN], 1u);
            else XB_SPIN(xb_ld(&bar[XB_TOPGEN]) == tg, bar);
            __builtin_amdgcn_fence(__ATOMIC_ACQUIRE, "agent");
            xb_add(&bar[XB_XGEN(b.x)], 1u);
            asm volatile("s_waitcnt vmcnt(0)" ::: "memory");
        } else {
            XB_SPIN(xb_ld(&bar[XB_XGEN(b.x)]) == gen, bar);
            __builtin_amdgcn_fence(__ATOMIC_ACQUIRE, "agent");
            asm volatile("s_waitcnt vmcnt(0)" ::: "memory");
        }
    }
    __syncthreads();
}

struct SchedAll {
    pg8::StaticOrder so; int mode, nkt_full, nM, nN, nsplit, G, c;
    __device__ __forceinline__ void init(int M, int N, int K, int G_, int c_, int mode_) {
        mode = mode_; nkt_full = K / 64; nM = M / 256; nN = N / 256; G = G_; c = c_; so.init(M, N, G_, c_);
        nsplit = (K == DFF) ? 11 : 8;
    }
    __device__ __forceinline__ bool next(int i, pg8::Unit& u) const {
        const int nwg = nM * nN, nfull = nwg / G;
        if (!mode || i < nfull) { if (!so.next(i, u)) return false; u.kt0 = 0; u.nkt = nkt_full; u.part = 0; return true; }
        if (i > nfull) return false;
        const int left = nwg - nfull * G;
        if (c >= left * nsplit) return false;
        const int j = c / nsplit, ks = c - j * nsplit;
        unit_of(nfull * G + j, nM, nN, u.pm, u.pn); u.nkt = nkt_full / nsplit; u.kt0 = ks * u.nkt; u.part = 1; return true;
    }
    __device__ __forceinline__ void a_ready(const pg8::Unit&) const {}
    __device__ __forceinline__ void done(const pg8::Unit&) const {}
};
template <class Epi> __device__ __forceinline__ void run_gemm_sk(unsigned char* shm, const bf16_t* A, const bf16_t* Bt, int N, int K, const Epi& E, int mode, int fake = 0) {
    pg8::Gemm g; g.A = A; g.Bt = Bt; g.M = MP; g.N = N; g.K = K; g.fake = fake;
    SchedAll S; S.init(MP, N, K, (int)gridDim.x, (int)blockIdx.x, mode);
    pg8::gemm_phase<Epi, SchedAll, false>((PG8_LAS unsigned char*)shm, g, S, E, nullptr);
}
template <class Epi> __device__ __forceinline__ void run_gemm(unsigned char* shm, const bf16_t* A, const bf16_t* Bt, int N, int K, const Epi& E) {
    pg8::Gemm g; g.A = A; g.Bt = Bt; g.M = MP; g.N = N; g.K = K; g.fake = 0;
    pg8::StaticOrder S; S.init(MP, N, (int)gridDim.x, (int)blockIdx.x);
    pg8::gemm_phase<Epi, pg8::StaticOrder, false>((PG8_LAS unsigned char*)shm, g, S, E, nullptr);
}

__global__ void __launch_bounds__(512, 2) mega(Params p) {
    extern __shared__ __attribute__((aligned(16))) unsigned char shm[];
    bf16_t* HN = (bf16_t*)(p.ws + WS_HN); bf16_t* HID = (bf16_t*)(p.ws + WS_PROJ); float* X = (float*)(p.ws + WS_X);
#if N_LAUNCH_MODE == 1
    volatile XB_LAS unsigned* xbw = (volatile XB_LAS unsigned*)(shm + LDS_BYTES - 16);
    if (threadIdx.x == 0) { xbw[0] = 0u; xbw[1] = 0u; }
    __syncthreads();
    const XcdBarrier xb = xcd_barrier_post((unsigned*)(p.ws + WS_BAR), xbw);
#endif
    for (int ph = p.ph_lo; ph < p.ph_hi; ++ph) {
        const int l = ph / 12, kind = (ph == 24) ? 12 : ph % 12;
#if REP_MASK
        for (int rep = 0; rep < (((REP_MASK) >> kind) & 1 ? 2 : 1); ++rep) {
        if (rep) { __threadfence(); cg::this_grid().sync(); }
#endif
        if (PH_ON(0) && kind == 0) { prep_phase(p, l, (float*)shm); if (l == 0) norm_phase<1>(p, p.in[7], 0); else norm_phase2<0>(p, p.in[7] + l * D, 11); }
        else if (PH_ON(1) && (kind == 1 || kind == 10 || kind == 2 || kind == 11 || kind == 8 || kind == 4)) {
            EpiAll E; E.mode = (kind == 1 || kind == 10) ? 0 : (kind == 4 ? 2 : 1); E.Ob = (E.mode == 0) ? HID : (bf16_t*)(p.ws + WS_PROJ); E.Of = X; E.BA = (float*)(p.ws + WS_BA); E.scale = kind == 8 ? 1.f : 0.5f;
            E.PART = (float*)(p.ws + WS_PART) + (size_t)blockIdx.x * 65536;
#if REP_MASK
            if (((REP_MASK) >> kind) & 1) E.scale *= 0.5f;
#endif
            const bf16_t* A = (kind == 2 || kind == 11) ? HID : HN;
            size_t wo; int N, K;
            if (kind == 1) { wo = WS_WGU1; N = NGU; K = D; } else if (kind == 10) { wo = WS_WGU2; N = NGU; K = D; } else if (kind == 2) { wo = WS_WD1; N = D; K = DFF; }
            else if (kind == 11) { wo = WS_WD2; N = D; K = DFF; } else if (kind == 8) { wo = WS_WOUT; N = D; K = D; } else { wo = WS_WIN; N = NINP; K = D; }
#if REP_MASK
            if (rep) { E.mode = 3; run_gemm_sk(shm, A, (const bf16_t*)(p.ws + wo), N, K, E, 0, PROBE_FAKE); } else
#endif
            run_gemm_sk(shm, A, (const bf16_t*)(p.ws + wo), N, K, E, (E.mode == 1 && gridDim.x == 256) ? 1 : 0); }
        else if (PH_ON(3) && kind == 3) norm_phase2<0>(p, p.in[11] + l * D, 11);
        else if (PH_ON(3) && kind == 9) norm_phase2<0>(p, p.in[26] + l * D, 8);
        else if (PH_ON(5) && kind == 5) {
            for (int it = blockIdx.x; it < NSC * 8 + LRU_KEEP; it += gridDim.x) {
                if (it < NSC * 8) { if (PH_ON(13)) { gdn_item(p, l, it >> 3, it & 7, shm);
#if REP_MASK & 0x2000
                    gdn_item(p, l, it >> 3, it & 7, shm);
#endif
                } } else if (PH_ON(14)) { const int r = it - NSC * 8; lru_item(p, l, r >> 4, r & 15, shm);
#if REP_MASK & 0x4000
                    lru_item(p, l, r >> 4, r & 15, shm);
#endif
                } }
        }
        else if (PH_ON(6) && kind == 6) chain_phase(p, l, shm);
        else if (PH_ON(7) && kind == 7) mix_out_phase(p, l);
        else if (PH_ON(12) && kind == 12) norm_phase2<2>(p, p.in[30], 11);
#if REP_MASK
        }
#endif
#if N_LAUNCH_MODE == 1
        if (ph + 1 < p.ph_hi) { if (p.ph_hi > 1000) cg::this_grid().sync(); else xcd_barrier(xb); }
#else
        if (ph + 1 < p.ph_hi) cg::this_grid().sync();
#endif
    }
}

extern "C" void kernel_launch(void* const* d_in, const int* in_sizes, int n_in, void* d_out, int out_size, void* d_ws, size_t ws_size, hipStream_t stream) {
    static int grid = 0;
    if (grid == 0) {
        if (n_in != 31 || ws_size < WS_END) { fprintf(stderr, "kernel_launch: unexpected n_in %d or ws_size %zu (need %zu)\n", n_in, ws_size, (size_t)WS_END); grid = -1; return; }
        int dev = 0, cus = 0, per_cu = 0;
        hipGetDevice(&dev); hipDeviceGetAttribute(&cus, hipDeviceAttributeMultiprocessorCount, dev);
        if (hipFuncSetAttribute((const void*)mega, hipFuncAttributeMaxDynamicSharedMemorySize, LDS_BYTES) != hipSuccess) { fprintf(stderr, "kernel_launch: hipFuncSetAttribute failed\n"); grid = -1; return; }
        if (hipOccupancyMaxActiveBlocksPerMultiprocessor(&per_cu, (const void*)mega, 512, LDS_BYTES) != hipSuccess || per_cu < 1) { fprintf(stderr, "kernel_launch: occupancy query says %d\n", per_cu); per_cu = 1; }
        (void)hipGetLastError();
        grid = cus;
        if (grid < 128) { fprintf(stderr, "kernel_launch: only %d CUs\n", grid); grid = -1; return; }
    }
    if (grid < 0) return;
    Params p{};
#if TEST_MEMSET
    (void)hipMemsetAsync((unsigned char*)d_ws + WS_X, 0, WS_END - WS_X, stream);
#endif
    for (int i = 0; i < 31; ++i) p.in[i] = (const float*)d_in[i];
    p.out = (float*)d_out; p.ws = (unsigned char*)d_ws;
#if N_LAUNCH_MODE == 1
    p.ph_lo = 0; p.ph_hi = 25;
    (void)hipMemsetAsync((unsigned char*)d_ws + WS_BAR, 0, 16384, stream);
    void* args[] = {&p};
    hipError_t e = hipLaunchCooperativeKernel((const void*)mega, dim3(grid), dim3(512), args, LDS_BYTES, stream);
    if (e != hipSuccess) fprintf(stderr, "cooperative launch failed: %s (grid %d)\n", hipGetErrorString(e), grid);
#else
    for (int ph = 0; ph < 25; ++ph) { p.ph_lo = ph; p.ph_hi = ph + 1; hipLaunchKernelGGL(mega, dim3(grid), dim3(512), LDS_BYTES, stream, p); }
#endif
}
```

```cpp
#include <hip/hip_runtime.h>
#include <hip/hip_cooperative_groups.h>
#include <cstdio>
namespace cg = cooperative_groups;
namespace pg8 {
#define PG8_LAS __attribute__((address_space(3)))
typedef unsigned short bf16_t;
typedef short bf16x8 __attribute__((ext_vector_type(8)));
typedef float f32x4 __attribute__((ext_vector_type(4)));
typedef unsigned u32x4 __attribute__((ext_vector_type(4)));
constexpr int BM = 256, BK = 64, HALF = 128, HTB = HALF * BK * 2  , STAGE_BYTES = 8 * HTB, NXCD = 8, WGM = 8;
__host__ __device__ __forceinline__ int lds_byte(int r, int c) { const int st = (r >> 4) * 2 + (c >> 5), rr = r & 15, cc = c & 31, ob = rr * 64 + cc * 2; return st * 1024 + (ob ^ (((ob >> 9) & 1) << 5)); }
__host__ __device__ __forceinline__ void stage_rc(int b, int& R, int& C) { const int st = b / 1024, sb = b % 1024, swz = sb ^ (((sb >> 9) & 1) << 5); R = (st >> 1) * 16 + swz / 64; C = (st & 1) * 32 + (swz % 64) / 2; }
__host__ __device__ __forceinline__ int perm32(int rho) { const int n = rho >> 4, i = rho & 15; return 8 * (i >> 2) + 4 * n + (i & 3); }
struct Unit { int pm, pn, kt0, nkt, part; };
struct Gemm { const bf16_t* A; const bf16_t* Bt; int M, N, K, fake; };
struct StaticOrder {
    int nM, nN, nwg, G, c;
    __host__ __device__ void init(int M, int N, int G_, int c_) { nM = M / BM; nN = N / BM; nwg = nM * nN; G = G_; c = c_; }
    __host__ __device__ bool next(int i, Unit& u) const {
        const long L = (long)i * G + c; if (L >= nwg) return false;
        int wgid = (int)L; { const int q = nwg / NXCD, r = nwg % NXCD, xcd = wgid % NXCD, off = wgid / NXCD; wgid = (xcd < r ? xcd * (q + 1) : r * (q + 1) + (xcd - r) * q) + off; }
        const int nig = WGM * nN, gid = wgid / nig, fm = gid * WGM, gsz = (nM - fm) < WGM ? (nM - fm) : WGM;
        u.pm = fm + ((wgid % nig) % gsz); u.pn = (wgid % nig) / gsz; return true;
    }
    __device__ __forceinline__ void a_ready(const Unit&) const {}
    __device__ __forceinline__ void done(const Unit&) const {}
};
__device__ __forceinline__ unsigned cvt_pk_bf16(float lo, float hi) { unsigned r; asm volatile("v_cvt_pk_bf16_f32 %0, %1, %2" : "=v"(r) : "v"(lo), "v"(hi)); return r; }
template <class Epi, class Sched, bool STAMP = false>
__device__ __forceinline__ void gemm_phase(PG8_LAS unsigned char* lds, const Gemm g, const Sched& S, const Epi& E, unsigned long long* stamps) {
    int tid_ = threadIdx.x; asm volatile("" : "+v"(tid_)); const int tid = tid_, wid = __builtin_amdgcn_readfirstlane(tid >> 6), lane = tid & 63, wr = wid >> 2, wc = wid & 3, fr = lane & 15, fq = lane >> 4;
    const int K = g.K; int nt;
    int ts_lo = 0, ts_hi = 0, nts = 0; const unsigned long long rt_entry = STAMP ? (unsigned long long)wall_clock64() : 0ull;
#define PG8_STAMP() do { if (STAMP && wid == 0 && nts < 64) { const unsigned long long _c = (unsigned long long)clock64(); \
        ts_lo = (lane == nts) ? (int)(unsigned)_c : ts_lo; ts_hi = (lane == nts) ? (int)(unsigned)(_c >> 32) : ts_hi; ++nts; } } while (0)
    PG8_STAMP();
    unsigned voffA[2], voffB[2];
#pragma unroll
    for (int i = 0; i < 2; ++i) { int R, C; stage_rc(tid * 16 + i * 8192, R, C); const int Rb = E.perm() ? ((R & ~31) + perm32(R & 31)) : R;
        voffA[i] = (unsigned)(R * K + C) * 2u; voffB[i] = (unsigned)(Rb * K + C) * 2u; }
    const size_t kstep = (size_t)(BK * 2);
    const size_t hstep = (size_t)HALF * K * 2;
    const size_t tstep = 2 * hstep;
    const unsigned ldsw = (unsigned)wid * 1024u;
    const int aoff = lds_byte(wr * 64 + fr, fq * 8), boff = lds_byte(wc * 32 + fr, fq * 8);
#define PG8_SA(b, h) (((b) * 2 + (h)) * HTB)
#define PG8_SB(b, h) ((4 + (b) * 2 + (h)) * HTB)
#define PG8_STAGE(bufoff, gbase, voff) do { _Pragma("unroll") for (int _i = 0; _i < 2; ++_i) \
        __builtin_amdgcn_global_load_lds((const unsigned*)((const char*)(gbase) + (voff)[_i]), (PG8_LAS unsigned*)(lds + (bufoff) + ldsw + _i * 8192), 16, 0, 0); } while (0)
#define PG8_LDA(dst, b, h) do { _Pragma("unroll") for (int m = 0; m < 4; ++m) _Pragma("unroll") for (int k = 0; k < 2; ++k) dst[m][k] = *(const PG8_LAS bf16x8*)(lds + PG8_SA(b, h) + aoff + m * 2048 + k * 1024); } while (0)
#define PG8_LDB(dst, b, h) do { _Pragma("unroll") for (int n = 0; n < 2; ++n) _Pragma("unroll") for (int k = 0; k < 2; ++k) dst[n][k] = *(const PG8_LAS bf16x8*)(lds + PG8_SB(b, h) + boff + n * 2048 + k * 1024); } while (0)
#define PG8_MMA(ai, bj, At, Bt) do { __builtin_amdgcn_s_setprio(1); _Pragma("unroll") for (int m = 0; m < 4; ++m) _Pragma("unroll") for (int n = 0; n < 2; ++n) _Pragma("unroll") for (int k = 0; k < 2; ++k) \
        acc[ai][bj][m][n] = __builtin_amdgcn_mfma_f32_16x16x32_bf16(Bt[n][k], At[m][k], acc[ai][bj][m][n], 0, 0, 0); __builtin_amdgcn_s_setprio(0); } while (0)
#define PG8_WAIT_V(n) asm volatile("s_waitcnt vmcnt(" #n ")" ::: "memory")
#define PG8_WAIT_L(n) asm volatile("s_waitcnt lgkmcnt(" #n ")" ::: "memory")
#define PG8_BAR __builtin_amdgcn_s_barrier()
#define PG8_SCHED __builtin_amdgcn_sched_barrier(0)
    Unit cur, nxt; int ui = 0;
    if (!S.next(0, cur)) return;
    nt = cur.nkt;
    f32x4 acc[2][2][4][2];
#pragma unroll
    for (int a = 0; a < 2; ++a)
#pragma unroll
        for (int b = 0; b < 2; ++b)
#pragma unroll
            for (int m = 0; m < 4; ++m)
#pragma unroll
                for (int n = 0; n < 2; ++n) acc[a][b][m][n] = (f32x4){0.f, 0.f, 0.f, 0.f};
    bf16x8 At[4][2], B0[2][2], B1[2][2];
    const char* cA = (const char*)g.A + (g.fake ? (size_t)0 : (size_t)cur.pm * tstep) + (size_t)cur.kt0 * (size_t)(BK * 2); const char* cB = (const char*)g.Bt + (g.fake ? (size_t)0 : (size_t)cur.pn * tstep) + (size_t)cur.kt0 * (size_t)(BK * 2);
    S.a_ready(cur);
    PG8_STAGE(PG8_SB(0, 0), cB, voffB); PG8_STAGE(PG8_SA(0, 0), cA, voffA); PG8_STAGE(PG8_SB(0, 1), cB + hstep, voffB); PG8_STAGE(PG8_SA(0, 1), cA + hstep, voffA);
    if (wr == 1) PG8_BAR;
    PG8_WAIT_V(4); PG8_BAR;
    PG8_STAGE(PG8_SB(1, 0), cB + kstep, voffB); PG8_STAGE(PG8_SA(1, 0), cA + kstep, voffA); PG8_STAGE(PG8_SB(1, 1), cB + hstep + kstep, voffB);
    PG8_WAIT_V(6); PG8_BAR;
    PG8_STAMP();
    for (;;) {
        const bool has_next = S.next(ui + 1, nxt);
        const char* nA = has_next ? (const char*)g.A + (g.fake ? (size_t)0 : (size_t)nxt.pm * tstep) + (size_t)nxt.kt0 * kstep : cA; const char* nB = has_next ? (const char*)g.Bt + (g.fake ? (size_t)0 : (size_t)nxt.pn * tstep) + (size_t)nxt.kt0 * kstep : cB;
        for (int t = 0; t < nt; t += 2) {
            const bool last = (t == nt - 2);
            const char* a1 = cA + (size_t)(t + 1) * kstep;
            const char* a2 = last ? nA : cA + (size_t)(t + 2) * kstep; const char* b2 = last ? nB : cB + (size_t)(t + 2) * kstep;
            const char* a3 = a2 + kstep; const char* b3 = b2 + kstep;
            if (last && has_next) S.a_ready(nxt);
            PG8_LDB(B0, 0, 0); PG8_SCHED; PG8_LDA(At, 0, 0); PG8_STAGE(PG8_SA(1, 1), a1 + hstep, voffA);
            PG8_WAIT_L(8); PG8_BAR; PG8_WAIT_L(0); PG8_MMA(0, 0, At, B0); PG8_BAR; PG8_SCHED;
            PG8_LDB(B1, 0, 1); PG8_STAGE(PG8_SB(0, 0), b2, voffB);
            PG8_BAR; PG8_WAIT_L(0); PG8_MMA(0, 1, At, B1); PG8_BAR;
            PG8_LDA(At, 0, 1); PG8_STAGE(PG8_SA(0, 0), a2, voffA);
            PG8_BAR; PG8_WAIT_L(0); PG8_MMA(1, 0, At, B0); PG8_BAR; PG8_SCHED;
            PG8_STAGE(PG8_SB(0, 1), b2 + hstep, voffB);
            PG8_WAIT_V(6); PG8_BAR; PG8_MMA(1, 1, At, B1); PG8_BAR;
            PG8_LDB(B0, 1, 0); PG8_SCHED; PG8_LDA(At, 1, 0); PG8_STAGE(PG8_SA(0, 1), a2 + hstep, voffA);
            PG8_WAIT_L(8); PG8_BAR; PG8_WAIT_L(0); PG8_MMA(0, 0, At, B0); PG8_BAR; PG8_SCHED;
            PG8_LDB(B1, 1, 1); PG8_STAGE(PG8_SB(1, 0), b3, voffB);
            PG8_BAR; PG8_WAIT_L(0); PG8_MMA(0, 1, At, B1); PG8_BAR;
            PG8_LDA(At, 1, 1); PG8_STAGE(PG8_SA(1, 0), a3, voffA);
            PG8_BAR; PG8_WAIT_L(0); PG8_MMA(1, 0, At, B0); PG8_BAR; PG8_SCHED;
            PG8_STAGE(PG8_SB(1, 1), b3 + hstep, voffB);
            PG8_WAIT_V(6); PG8_BAR; PG8_MMA(1, 1, At, B1); PG8_BAR;
        }
        PG8_STAMP();
        if constexpr (!Epi::AFTER_DRAIN) { E(acc, cur, wr, wc, fr, fq); S.done(cur); }
        PG8_STAMP();
        if (!has_next) break;
#pragma unroll
        for (int a = 0; a < 2; ++a)
#pragma unroll
            for (int b = 0; b < 2; ++b)
#pragma unroll
                for (int m = 0; m < 4; ++m)
#pragma unroll
                    for (int n = 0; n < 2; ++n) acc[a][b][m][n] = (f32x4){0.f, 0.f, 0.f, 0.f};
        cur = nxt; cA = nA; cB = nB; ++ui; nt = cur.nkt;
    }
    PG8_WAIT_V(0);
    if (wr == 0) PG8_BAR;
    PG8_BAR;
    if constexpr (Epi::AFTER_DRAIN) { E.fused(acc, cur, wr, wc, fr, fq, lds, wid, lane); S.done(cur); }
    PG8_STAMP();
    if (STAMP && wid == 0) { stamps[lane] = lane < nts ? (((unsigned long long)(unsigned)ts_hi << 32) | (unsigned)ts_lo) : 0ull;
        if (lane == 62) stamps[62] = rt_entry; if (lane == 63) stamps[63] = (unsigned long long)wall_clock64(); }
#undef PG8_STAMP
#undef PG8_SA
#undef PG8_SB
#undef PG8_STAGE
#undef PG8_LDA
#undef PG8_LDB
#undef PG8_MMA
#undef PG8_WAIT_V
#undef PG8_WAIT_L
#undef PG8_BAR
#undef PG8_SCHED
}
}
using pg8::bf16_t; using pg8::bf16x8; using pg8::f32x4; using pg8::u32x4;
typedef unsigned u32x2 __attribute__((ext_vector_type(2)));

constexpr int D = 2048, TP = 8208, NSS = 16;
constexpr int MROWS = 16672, MP = 16896, SROW0 = 16416;
constexpr int DFF = 5632, NGU = 11264, NINP = 6400, PLD = 6144;
constexpr int NSC = 274;
constexpr float EPS = 1e-6f;
constexpr int LDS_BYTES = 147456;
#ifndef TEST_MEMSET
#define TEST_MEMSET 0
#endif
#ifndef LRU_KEEP
#define LRU_KEEP 0
#endif
#ifndef PROBE_FAKE
#define PROBE_FAKE 1
#endif
#ifndef REP_MASK
#define REP_MASK 0
#endif
#ifndef TEST_SKIP
#define TEST_SKIP 0
#endif
#ifndef PH_MASK
#define PH_MASK 0x7fff
#endif
#define PH_ON(k) (((PH_MASK) >> (k)) & 1)
#ifndef N_LAUNCH_MODE
#define N_LAUNCH_MODE 1
#endif

constexpr size_t SZ_WGU = (size_t)NGU * D * 2, SZ_WD = (size_t)D * DFF * 2, SZ_WIN = (size_t)NINP * D * 2, SZ_WOUT = (size_t)D * D * 2;
constexpr size_t WS_WGU1 = 0, WS_WD1 = WS_WGU1 + SZ_WGU, WS_WGU2 = WS_WD1 + SZ_WD, WS_WD2 = WS_WGU2 + SZ_WGU, WS_WIN = WS_WD2 + SZ_WD, WS_WOUT = WS_WIN + SZ_WIN,
    WS_WG = WS_WOUT + SZ_WOUT, WS_X = WS_WG + 262144, WS_HN = WS_X + (size_t)MP * D * 4, WS_PROJ = WS_HN + (size_t)MP * D * 2, WS_GCH = WS_PROJ + (size_t)MP * PLD * 2,
    WS_BA = WS_GCH + (size_t)NSC * 8 * 73728, WS_GE = WS_BA + (size_t)MP * 16 * 4, WS_ACH = WS_GE + 16384, WS_BCH = WS_ACH + (size_t)NSC * 1024 * 4,
    WS_CARRY = WS_BCH + (size_t)NSC * 1024 * 4, WS_PART = WS_CARRY + (size_t)NSC * 1024 * 4, WS_BAR = WS_PART + (size_t)256 * 65536 * 4, WS_END = WS_BAR + 16384;
constexpr size_t O_YP = 0, O_YS = 33554432, O_PCA = 34078720, O_PLRU = 34091008, O_PCB = 34095104, O_PDL = 34131968, O_SCA = 34656256, O_SLRU = 34754560,
    O_SCB = 34787328, O_SDL = 35082240;
constexpr size_t OS_HL = 0, OS_AC = (size_t)MROWS * 1024;

__device__ __forceinline__ int fresh_tid() { int t = threadIdx.x; asm volatile("" : "+v"(t)); return t; }
__device__ __forceinline__ void unit_of(int L, int nM, int nN, int& pm, int& pn) {
    const int nwg = nM * nN; int wgid = L; { const int q = nwg / 8, r = nwg % 8, xcd = wgid % 8, off = wgid / 8; wgid = (xcd < r ? xcd * (q + 1) : r * (q + 1) + (xcd - r) * q) + off; }
    const int nig = 8 * nN, gid = wgid / nig, fm = gid * 8, gsz = (nM - fm) < 8 ? (nM - fm) : 8;
    pm = fm + ((wgid % nig) % gsz); pn = (wgid % nig) / gsz;
}
struct Params { const float* in[31]; float* out; unsigned char* ws; int ph_lo, ph_hi; };

typedef __bf16 bf16v2 __attribute__((ext_vector_type(2)));
__device__ __forceinline__ unsigned pk2(float lo, float hi) { bf16v2 v; v[0] = (__bf16)lo; v[1] = (__bf16)hi; return __builtin_bit_cast(unsigned, v); }
__device__ __forceinline__ float bflo(unsigned u) { return __uint_as_float(u << 16); }
__device__ __forceinline__ float bfhi(unsigned u) { return __uint_as_float(u & 0xffff0000u); }
__device__ __forceinline__ float bf2f(bf16_t b) { return __uint_as_float(((unsigned)b) << 16); }
__device__ __forceinline__ float sigmoidf_(float x) { return __builtin_amdgcn_rcpf(1.f + __expf(-x)); }
__device__ __forceinline__ float siluf_(float x) { return x * __builtin_amdgcn_rcpf(1.f + __expf(-x)); }
__device__ __forceinline__ float softplusf_(float x) { return x > 20.f ? x : log1pf(__expf(x)); }
__device__ __forceinline__ float gelu_tanh(float x) { const float y = 0.7978845608028654f * (x + 0.044715f * x * x * x); const float t = 1.f - 2.f * __builtin_amdgcn_rcpf(1.f + __expf(2.f * y)); return 0.5f * x * (1.f + t); }
__device__ __forceinline__ void unpack8(const u32x4 v, float (&f)[8]) { f[0] = bflo(v.x); f[1] = bfhi(v.x); f[2] = bflo(v.y); f[3] = bfhi(v.y); f[4] = bflo(v.z); f[5] = bfhi(v.z); f[6] = bflo(v.w); f[7] = bfhi(v.w); }
__device__ __forceinline__ u32x4 pack8(const float (&f)[8]) { u32x4 o; o.x = pk2(f[0], f[1]); o.y = pk2(f[2], f[3]); o.z = pk2(f[4], f[5]); o.w = pk2(f[6], f[7]); return o; }
__device__ __forceinline__ f32x4 mfma16(bf16x8 a, bf16x8 b, f32x4 c) { return __builtin_amdgcn_mfma_f32_16x16x32_bf16(a, b, c, 0, 0, 0); }

struct EpiGU {
    static constexpr bool PERM = false, AFTER_DRAIN = false;
    bf16_t* H;
    __device__ __forceinline__ void operator()(const f32x4 (&acc)[2][2][4][2], const pg8::Unit& u, int wr, int wc, int fr, int fq) const {
        const int row0 = u.pm * 256 + wr * 64 + fr, hc0 = u.pn * 128 + wc * 16 + 4 * fq;
#pragma unroll
        for (int ai = 0; ai < 2; ++ai)
#pragma unroll
            for (int m = 0; m < 4; ++m) { u32x2 o[2];
#pragma unroll
                for (int bj = 0; bj < 2; ++bj) { const f32x4 g = acc[ai][bj][m][0], up = acc[ai][bj][m][1];
                    o[bj].x = pk2(siluf_(g[0]) * up[0], siluf_(g[1]) * up[1]); o[bj].y = pk2(siluf_(g[2]) * up[2], siluf_(g[3]) * up[3]); }
                const auto rx = __builtin_amdgcn_permlane16_swap(o[0].x, o[1].x, false, false); const auto ry = __builtin_amdgcn_permlane16_swap(o[0].y, o[1].y, false, false);
                u32x4 w; w.x = rx[0]; w.y = ry[0]; w.z = rx[1]; w.w = ry[1];
                *(u32x4*)(H + (size_t)(row0 + ai * 128 + m * 16) * DFF + u.pn * 128 + 64 * (fq & 1) + wc * 16 + 8 * (fq >> 1)) = w; }
    }
};
struct EpiRes {
    static constexpr bool PERM = false, AFTER_DRAIN = false;
    float* X; float scale; float* PART;
    __device__ __forceinline__ void operator()(const f32x4 (&acc)[2][2][4][2], const pg8::Unit& u, int wr, int wc, int fr, int fq) const {
        const bool tail = u.part != 0;
        const int rl0 = wr * 64 + fr, cl0 = wc * 32 + 4 * fq;
        float* base = tail ? PART + (size_t)rl0 * 256 + cl0 : X + (size_t)(u.pm * 256 + rl0) * D + u.pn * 256 + cl0;
        const size_t ld = tail ? 256 : D;
#pragma unroll
        for (int ai = 0; ai < 2; ++ai)
#pragma unroll
            for (int m = 0; m < 4; ++m) { float* rowp = base + (size_t)(ai * 128 + m * 16) * ld;
#pragma unroll
                for (int bj = 0; bj < 2; ++bj)
#pragma unroll
                    for (int n = 0; n < 2; ++n) { f32x4* q = (f32x4*)(rowp + bj * 128 + n * 16); f32x4 v = acc[ai][bj][m][n] * scale; if (!tail) v = v + *q; *q = v; } }
    }
};
struct EpiProj {
    static constexpr bool PERM = true, AFTER_DRAIN = false;
    bf16_t* P; float* BA;
    __device__ __forceinline__ void operator()(const f32x4 (&acc)[2][2][4][2], const pg8::Unit& u, int wr, int wc, int fr, int fq) const {
        const int row0 = u.pm * 256 + wr * 64 + fr;
        if (u.pn < 24) {
            const int col0 = u.pn * 256 + wc * 32 + 8 * fq;
#pragma unroll
            for (int ai = 0; ai < 2; ++ai)
#pragma unroll
                for (int m = 0; m < 4; ++m) { bf16_t* rowp = P + (size_t)(row0 + ai * 128 + m * 16) * PLD + col0;
#pragma unroll
                    for (int bj = 0; bj < 2; ++bj) { const f32x4 v0 = acc[ai][bj][m][0], v1 = acc[ai][bj][m][1];
                        u32x4 w; w.x = pk2(v0[0], v0[1]); w.y = pk2(v0[2], v0[3]); w.z = pk2(v1[0], v1[1]); w.w = pk2(v1[2], v1[3]);
                        *(u32x4*)(rowp + bj * 128) = w; } }
        } else if (wc == 0 && fq < 2) {
#pragma unroll
            for (int ai = 0; ai < 2; ++ai)
#pragma unroll
                for (int m = 0; m < 4; ++m) { float* q = BA + (size_t)(row0 + ai * 128 + m * 16) * 16 + 8 * fq;
                    *(f32x4*)q = acc[ai][0][m][0]; *(f32x4*)(q + 4) = acc[ai][0][m][1]; }
        }
    }
};

struct EpiAll {
    static constexpr bool AFTER_DRAIN = false;
    int mode; bf16_t* Ob; float* Of; float* BA; float scale; float* PART;
    __device__ __forceinline__ bool perm() const { return mode == 2; }
    __device__ __forceinline__ void operator()(const f32x4 (&acc)[2][2][4][2], const pg8::Unit& u, int wr, int wc, int fr, int fq) const {
        if (mode == 3) {
            f32x4 s = {0.f, 0.f, 0.f, 0.f};
#pragma unroll
            for (int ai = 0; ai < 2; ++ai)
#pragma unroll
                for (int bj = 0; bj < 2; ++bj)
#pragma unroll
                    for (int m = 0; m < 4; ++m)
#pragma unroll
                        for (int n = 0; n < 2; ++n) s = s + acc[ai][bj][m][n];
            if (s[0] + s[1] + s[2] + s[3] == 12345.678f) BA[0] = s[0];
            return; }
        if (mode == 0) { EpiGU e; e.H = Ob; e(acc, u, wr, wc, fr, fq); }
        else if (mode == 1) { EpiRes e; e.X = Of; e.scale = scale; e.PART = PART; e(acc, u, wr, wc, fr, fq); }
        else { EpiProj e; e.P = Ob; e.BA = BA; e(acc, u, wr, wc, fr, fq); }
    }
};

__device__ __forceinline__ void tr_tile(const float* W, int K, int N, int kb, int nb, bf16_t* dst, int mode, float* tile) {
    const int tid = fresh_tid(), k0 = kb * 64, n0 = nb * 64;
    { const int nn = tid & 63, kq = tid >> 6, n = n0 + nn;
#pragma unroll
        for (int r = 0; r < 8; ++r) { const int kk = r * 8 + kq; tile[kk * 65 + nn] = (n < N) ? W[(size_t)(k0 + kk) * N + n] : 0.f; } }
    __syncthreads();
    { const int nn = tid >> 3, kc = tid & 7, n = n0 + nn; int drow = n;
        if (mode == 1) drow = (n >> 4) * 32 + (n & 15); else if (mode == 2) drow = (n >> 4) * 32 + 16 + (n & 15);
        const float* s = tile + (kc * 8) * 65 + nn; u32x4 o; o.x = pk2(s[0], s[65]); o.y = pk2(s[130], s[195]); o.z = pk2(s[260], s[325]); o.w = pk2(s[390], s[455]);
        *(u32x4*)(dst + (size_t)drow * K + k0 + kc * 8) = o; }
    __syncthreads();
}
struct TrJob { const float* W; bf16_t* dst; int K, N, mode, kb, nb; };
__device__ __forceinline__ TrJob prep_job(const Params& p, int l, int it) {
    TrJob j;
    if (it < 4224) { const int m = it / 704, r = it % 704, f = m / 3, w = m % 3;
        j.W = p.in[(f ? 27 : 8) + w] + (size_t)l * 2048 * 5632;
        if (w < 2) { j.K = 2048; j.N = 5632; j.kb = r / 22; j.nb = r % 22; j.mode = w + 1; j.dst = (bf16_t*)(p.ws + (f ? WS_WGU2 : WS_WGU1)); }
        else { j.K = 5632; j.N = 2048; j.kb = r / 8; j.nb = r % 8; j.mode = 0; j.dst = (bf16_t*)(p.ws + (f ? WS_WD2 : WS_WD1)); }
    } else if (it < 5024) { const int r = it - 4224; j.W = p.in[12] + (size_t)l * 2048 * 6160; j.K = 2048; j.N = 6160; j.kb = r / 25; j.nb = r % 25; j.mode = 0; j.dst = (bf16_t*)(p.ws + WS_WIN);
    } else { const int r = it - 5024; j.W = p.in[25] + (size_t)l * 2048 * 2048; j.K = 2048; j.N = 2048; j.kb = r / 8; j.nb = r % 8; j.mode = 0; j.dst = (bf16_t*)(p.ws + WS_WOUT); }
    return j;
}
__device__ __forceinline__ void tr_load(const TrJob& j, f32x4 (&v)[8], int tid) {
    const int lane = tid & 63, wid = tid >> 6, n = j.nb * 256 + lane * 4;
#pragma unroll
    for (int ps = 0; ps < 8; ++ps) v[ps] = (n < j.N) ? *(const f32x4*)(j.W + (size_t)(j.kb * 64 + ps * 8 + wid) * j.N + n) : (f32x4){0.f, 0.f, 0.f, 0.f};
}
__device__ __forceinline__ void prep_phase(const Params& p, int l, float* tile) {
    constexpr int NJ = 5280;
    const int tid = fresh_tid(), lane = tid & 63, wid = tid >> 6;
    int it = blockIdx.x; f32x4 v[8]; TrJob job;
    if (it < NJ) { job = prep_job(p, l, it); tr_load(job, v, tid); }
    while (it < NJ) {
#pragma unroll
        for (int ps = 0; ps < 8; ++ps) *(f32x4*)(tile + (ps * 8 + wid) * 260 + lane * 4) = v[ps];
        __syncthreads();
        const TrJob cur = job; it += gridDim.x;
        if (it < NJ) { job = prep_job(p, l, it); tr_load(job, v, tid); }
#pragma unroll
        for (int r = 0; r < 4; ++r) { const int q = tid + 512 * r, nl = q & 255, kc = q >> 8, n = cur.nb * 256 + nl; int drow = n;
            if (cur.mode == 1) drow = (n >> 4) * 32 + (n & 15); else if (cur.mode == 2) drow = (n >> 4) * 32 + 16 + (n & 15);
            const float* s = tile + (kc * 8) * 260 + nl; u32x4 o; o.x = pk2(s[0], s[260]); o.y = pk2(s[520], s[780]); o.z = pk2(s[1040], s[1300]); o.w = pk2(s[1560], s[1820]);
            *(u32x4*)(cur.dst + (size_t)drow * cur.K + cur.kb * 64 + kc * 8) = o; }
        __syncthreads();
    }
    for (int r = blockIdx.x; r < 32; r += gridDim.x) { const int n = r >> 1, g = r & 1; tr_tile(p.in[g ? 17 : 15] + (size_t)l * 65536 + n * 4096, 64, 64, 0, 0, (bf16_t*)(p.ws + WS_WG) + r * 4096, 0, tile); }
}

template <int MODE>
__device__ __forceinline__ void norm_phase(const Params& p, const float* w, int ndp) {
    const int tid = fresh_tid(), lane = tid & 63, wid = tid >> 6;
    float* X = (float*)(p.ws + WS_X); bf16_t* HN = (bf16_t*)(p.ws + WS_HN);
    for (int row = blockIdx.x * 8 + wid; row < MP; row += gridDim.x * 8) {
        if (row >= MROWS) {
            if (MODE != 2) {
#pragma unroll
                for (int q = 0; q < 8; ++q) { const int idx = 4 * lane + 256 * q; *(u32x2*)(HN + (size_t)row * D + idx) = (u32x2){0u, 0u};
                    if (MODE == 1) *(f32x4*)(X + (size_t)row * D + idx) = (f32x4){0.f, 0.f, 0.f, 0.f}; } }
            continue; }
        const float* src = X + (size_t)row * D; float* dsto = nullptr;
        if (MODE != 0) {
            if (row < SROW0) { const int b = row / TP, t = row % TP;
                if (MODE == 1) src = t < 16 ? p.in[6] + (size_t)t * D : p.in[0] + ((size_t)b * 8192 + (t - 16)) * D;
                else dsto = t < 16 ? nullptr : p.out + O_YP + ((size_t)b * 8192 + (t - 16)) * D;
            } else { const int r = row - SROW0; if (MODE == 1) src = p.in[1] + (size_t)r * D; else dsto = p.out + O_YS + (size_t)r * D; }
            if (MODE == 2 && dsto == nullptr) continue;
        }
        f32x4 v[8]; float ss = 0.f;
#pragma unroll
        for (int q = 0; q < 8; ++q) v[q] = *(const f32x4*)(src + 4 * lane + 256 * q);
        if (MODE != 1 && ndp > 0 && gridDim.x == 256) {
            const int pm = row >> 8, rl = row & 255;
#pragma unroll 1
            for (int j = 0; j < 16; ++j) { int upm, upn; unit_of(512 + j, MP / 256, 8, upm, upn);
                if (upm == pm) {
                    f32x4 s = {0.f, 0.f, 0.f, 0.f};
                    for (int ks = 0; ks < ndp; ++ks) s = s + *(const f32x4*)((const float*)(p.ws + WS_PART) + (size_t)(j * ndp + ks) * 65536 + rl * 256 + 4 * lane);
#pragma unroll
                    for (int q = 0; q < 8; ++q) if (upn == q) { v[q] = v[q] + s; *(f32x4*)(X + (size_t)row * D + 4 * lane + 256 * q) = v[q]; }
                } }
        }
#pragma unroll
        for (int q = 0; q < 8; ++q) { ss += v[q][0] * v[q][0] + v[q][1] * v[q][1] + v[q][2] * v[q][2] + v[q][3] * v[q][3]; }
#pragma unroll
        for (int o = 1; o < 64; o <<= 1) ss += __shfl_xor(ss, o);
        const float rs = rsqrtf(ss * (1.f / 2048.f) + EPS);
#pragma unroll
        for (int q = 0; q < 8; ++q) { const int idx = 4 * lane + 256 * q; const f32x4 wv = *(const f32x4*)(w + idx); const f32x4 y = v[q] * rs * wv;
            if (MODE == 2) *(f32x4*)(dsto + idx) = y;
            else { u32x2 o; o.x = pk2(y[0], y[1]); o.y = pk2(y[2], y[3]); *(u32x2*)(HN + (size_t)row * D + idx) = o; if (MODE == 1) *(f32x4*)(X + (size_t)row * D + idx) = v[q]; } }
    }
}

template <int MODE>
__device__ __forceinline__ void norm_phase2(const Params& p, const float* w, int ndp) {
    const int tid = fresh_tid(), lane = tid & 63, wid = tid >> 6;
    float* X = (float*)(p.ws + WS_X); bf16_t* HN = (bf16_t*)(p.ws + WS_HN);
    const int stride = gridDim.x * 8;
    for (int row0 = blockIdx.x * 8 + wid; row0 < MP; row0 += 2 * stride) {
        f32x4 v[2][8]; float* dsto[2]; bool act[2];
#pragma unroll
        for (int t = 0; t < 2; ++t) {
            const int row = row0 + t * stride; act[t] = row < MROWS; dsto[t] = nullptr;
            if (MODE == 0 && row >= MROWS && row < MP) {
#pragma unroll
                for (int q = 0; q < 8; ++q) *(u32x2*)(HN + (size_t)row * D + 4 * lane + 256 * q) = (u32x2){0u, 0u}; }
            if (MODE == 2 && act[t]) {
                if (row < SROW0) { const int b = row / TP, tt = row % TP; dsto[t] = tt < 16 ? nullptr : p.out + O_YP + ((size_t)b * 8192 + (tt - 16)) * D; }
                else dsto[t] = p.out + O_YS + (size_t)(row - SROW0) * D;
                act[t] = dsto[t] != nullptr; }
            if (act[t]) {
#pragma unroll
                for (int q = 0; q < 8; ++q) v[t][q] = *(const f32x4*)(X + (size_t)row * D + 4 * lane + 256 * q); }
        }
#pragma unroll
        for (int t = 0; t < 2; ++t) {
            if (!act[t]) continue;
            const int row = row0 + t * stride;
            if (ndp > 0 && gridDim.x == 256) {
                const int pm = row >> 8, rl = row & 255;
#pragma unroll 1
                for (int j = 0; j < 16; ++j) { int upm, upn; unit_of(512 + j, MP / 256, 8, upm, upn);
                    if (upm == pm) {
                        f32x4 s = {0.f, 0.f, 0.f, 0.f};
                        for (int ks = 0; ks < ndp; ++ks) s = s + *(const f32x4*)((const float*)(p.ws + WS_PART) + (size_t)(j * ndp + ks) * 65536 + rl * 256 + 4 * lane);
#pragma unroll
                        for (int q = 0; q < 8; ++q) if (upn == q) { v[t][q] = v[t][q] + s; *(f32x4*)(X + (size_t)row * D + 4 * lane + 256 * q) = v[t][q]; }
                    } }
            }
            float ss = 0.f;
#pragma unroll
            for (int q = 0; q < 8; ++q) ss += v[t][q][0] * v[t][q][0] + v[t][q][1] * v[t][q][1] + v[t][q][2] * v[t][q][2] + v[t][q][3] * v[t][q][3];
#pragma unroll
            for (int o = 1; o < 64; o <<= 1) ss += __shfl_xor(ss, o);
            const float rs = rsqrtf(ss * (1.f / 2048.f) + EPS);
#pragma unroll
            for (int q = 0; q < 8; ++q) { const int idx = 4 * lane + 256 * q; const f32x4 wv = *(const f32x4*)(w + idx); const f32x4 y = v[t][q] * rs * wv;
                if (MODE == 2) *(f32x4*)(dsto[t] + idx) = y;
                else { u32x2 o; o.x = pk2(y[0], y[1]); o.y = pk2(y[2], y[3]); *(u32x2*)(HN + (size_t)row * D + idx) = o; } }
        }
    }
}

struct ChunkGeo { int row0, tok0, valid_lo, samp; };
__device__ __forceinline__ ChunkGeo chunk_geo(int sc) {
    ChunkGeo g;
    if (sc < 258) { const int b = sc / 129, c = sc % 129; g.tok0 = 64 * c - 48; g.row0 = b * TP + g.tok0; g.valid_lo = c == 0 ? 48 : 0; g.samp = -1; }
    else { const int s = sc - 258; g.tok0 = -48; g.row0 = SROW0 + 16 * s - 48; g.valid_lo = 48; g.samp = s; }
    return g;
}

__device__ __forceinline__ void gdn_item(const Params& p, int l, int sc, int h, unsigned char* shm, bool taps_lds) {
    const int tid = fresh_tid(), L = tid & 63, w = tid >> 6;
    bf16_t* qs = (bf16_t*)shm; bf16_t* ks = (bf16_t*)(shm + 17408); float* sol = (float*)(shm + 34816); float* Lm = (float*)(shm + 100352); float* qkm = (float*)(shm + 116736);
    float* gcs = (float*)(shm + 134144); float* betas = gcs + 64; float* egcs = gcs + 128;
    const ChunkGeo G = chunk_geo(sc);
    const bf16_t* PROJ = (const bf16_t*)(p.ws + WS_PROJ); const float* BA = (const float*)(p.ws + WS_BA);
    const int item = sc * 8 + h; unsigned char* ib = p.ws + WS_GCH + (size_t)item * 73728;
    if (w == 0) {
        const int i = L; float beta = 0.f, g = 0.f;
        if (i >= G.valid_lo) { const float* ba = BA + (size_t)(G.row0 + i) * 16; beta = sigmoidf_(ba[h]); g = -__expf(p.in[22][l * 8 + h]) * softplusf_(ba[8 + h] + p.in[23][l * 8 + h]); }
#pragma unroll
        for (int o = 1; o < 64; o <<= 1) { const float v = __shfl_up(g, o); if (L >= o) g += v; }
        gcs[i] = g; betas[i] = beta; egcs[i] = __expf(g);
        if (L == 63) ((float*)(p.ws + WS_GE))[item] = __expf(g);
    }
    float pend[6][8];
#pragma unroll
    for (int r = 0; r < 6; ++r) {
        const int e = tid + 512 * r, pos = e / 48, cgi = e % 48, typ = cgi >> 4, c8 = (cgi & 15) * 8, col = typ * 1024 + h * 128 + c8;
        const bool valid = pos >= G.valid_lo;
        float acc[8];
#pragma unroll
        for (int k = 0; k < 8; ++k) acc[k] = 0.f;
        if (valid) {
#pragma unroll
            for (int j = 0; j < 4; ++j) {
                const int m = G.tok0 + pos - 3 + j; float xv[8]; bool have = true;
                if (m >= 0) { const u32x4 raw = *(const u32x4*)(PROJ + (size_t)(G.row0 + pos - 3 + j) * PLD + 2048 + col); unpack8(raw, xv); }
                else if (G.samp >= 0) { const float* sp = p.in[4] + ((size_t)(l * 16 + G.samp) * 3 + (3 + m)) * 3072 + col; const f32x4 a = *(const f32x4*)sp, b = *(const f32x4*)(sp + 4);
                    xv[0] = a[0]; xv[1] = a[1]; xv[2] = a[2]; xv[3] = a[3]; xv[4] = b[0]; xv[5] = b[1]; xv[6] = b[2]; xv[7] = b[3]; }
                else have = false;
                if (have) { f32x4 wa, wb;
                    if (taps_lds) { const float* wq = (const float*)(shm + 135168) + j * 384 + typ * 128 + c8; wa = *(const f32x4*)wq; wb = *(const f32x4*)(wq + 4); }
                    else { const float* wp = p.in[21] + (size_t)(l * 4 + j) * 3072 + col; wa = *(const f32x4*)wp; wb = *(const f32x4*)(wp + 4); }
                    acc[0] += xv[0] * wa[0]; acc[1] += xv[1] * wa[1]; acc[2] += xv[2] * wa[2]; acc[3] += xv[3] * wa[3];
                    acc[4] += xv[4] * wb[0]; acc[5] += xv[5] * wb[1]; acc[6] += xv[6] * wb[2]; acc[7] += xv[7] * wb[3]; }
            }
        }
        float ss = 0.f;
#pragma unroll
        for (int k = 0; k < 8; ++k) { acc[k] = siluf_(acc[k]); ss += acc[k] * acc[k]; }
        ss += __shfl_xor(ss, 1); ss += __shfl_xor(ss, 2); ss += __shfl_xor(ss, 4); ss += __shfl_xor(ss, 8);
        if (typ < 2) { const float scl = rsqrtf(ss + EPS) * (typ == 0 ? 0.08838834764831845f : 1.f);
#pragma unroll
            for (int k = 0; k < 8; ++k) acc[k] *= scl;
            *(u32x4*)((typ == 0 ? qs : ks) + pos * 136 + c8) = pack8(acc);
        }
#pragma unroll
        for (int k = 0; k < 8; ++k) pend[r][k] = acc[k];
    }
    __syncthreads();
#pragma unroll
    for (int r = 0; r < 6; ++r) {
        const int e = tid + 512 * r, pos = e / 48, cgi = e % 48, typ = cgi >> 4, c8 = (cgi & 15) * 8;
        if (typ >= 1) { const float f = typ == 1 ? betas[pos] * egcs[pos] : betas[pos]; float* d = sol + pos * 256 + (typ == 1 ? 128 : 0) + c8;
            *(f32x4*)d = (f32x4){f * pend[r][0], f * pend[r][1], f * pend[r][2], f * pend[r][3]}; *(f32x4*)(d + 4) = (f32x4){f * pend[r][4], f * pend[r][5], f * pend[r][6], f * pend[r][7]}; }
    }
    {
        const int mat = w >> 2, mt = w & 3, lr = L & 15, lq = L >> 4;
        const bf16_t* Asrc = mat ? qs : ks; bf16x8 a[4];
#pragma unroll
        for (int s = 0; s < 4; ++s) a[s] = *(const bf16x8*)(Asrc + (16 * mt + lr) * 136 + 32 * s + lq * 8);
#pragma unroll
        for (int nt = 0; nt < 4; ++nt) {
            f32x4 c = {0.f, 0.f, 0.f, 0.f};
#pragma unroll
            for (int s = 0; s < 4; ++s) { const bf16x8 b = *(const bf16x8*)(ks + (16 * nt + lr) * 136 + 32 * s + lq * 8); c = mfma16(a[s], b, c); }
            const int j = 16 * nt + lr; const float gj = gcs[j];
#pragma unroll
            for (int r = 0; r < 4; ++r) { const int i = 16 * mt + lq * 4 + r; const float dec = __expf(fminf(gcs[i] - gj, 0.f));
                if (mat == 0) Lm[i * 64 + j] = (i > j) ? betas[i] * dec * c[r] : 0.f;
                else qkm[i * 68 + j] = (i >= j) ? dec * c[r] : 0.f; }
        }
    }
    __syncthreads();
    {
        const int c = tid & 255; const bool mainw = tid < 256; const int t2 = tid - 256; const float gl = gcs[63];
#define GD_LOAD(ACC, B_) _Pragma("unroll") for (int r = 0; r < 16; ++r) ACC[r] = sol[(16 * (B_) + r) * 256 + c]
#define GD_STORE(ACC, B_) _Pragma("unroll") for (int r = 0; r < 16; ++r) sol[(16 * (B_) + r) * 256 + c] = ACC[r]
#define GD_PAIR(ACC, B_, JB_) do { float xj[16]; _Pragma("unroll") for (int k = 0; k < 16; ++k) xj[k] = sol[(16 * (JB_) + k) * 256 + c]; \
            _Pragma("unroll") for (int r = 0; r < 16; ++r) { const float* lr = Lm + (16 * (B_) + r) * 64 + 16 * (JB_); \
                _Pragma("unroll") for (int k4 = 0; k4 < 4; ++k4) { const f32x4 lv = *(const f32x4*)(lr + 4 * k4); \
                    ACC[r] -= lv[0] * xj[4 * k4]; ACC[r] -= lv[1] * xj[4 * k4 + 1]; ACC[r] -= lv[2] * xj[4 * k4 + 2]; ACC[r] -= lv[3] * xj[4 * k4 + 3]; } } } while (0)
#define GD_DIAG(ACC, B_) do { _Pragma("unroll") for (int r = 1; r < 16; ++r) { const float* lr = Lm + (16 * (B_) + r) * 64 + 16 * (B_); \
                _Pragma("unroll") for (int k4 = 0; k4 < (r + 3) / 4; ++k4) { const f32x4 lv = *(const f32x4*)(lr + 4 * k4); \
                    if (4 * k4 < r) ACC[r] -= lv[0] * ACC[4 * k4]; if (4 * k4 + 1 < r) ACC[r] -= lv[1] * ACC[4 * k4 + 1]; \
                    if (4 * k4 + 2 < r) ACC[r] -= lv[2] * ACC[4 * k4 + 2]; if (4 * k4 + 3 < r) ACC[r] -= lv[3] * ACC[4 * k4 + 3]; } } } while (0)
        float acc[16];
#pragma unroll 1
        for (int st = 0; st < 4; ++st) {
            if (mainw) { GD_LOAD(acc, st); if (st > 0) GD_PAIR(acc, st, st - 1); GD_DIAG(acc, st); GD_STORE(acc, st); }
            else if (st == 0) {
#pragma unroll
        for (int r = 0; r < 4; ++r) {
            const int q = t2 + 256 * r, Lq = q & 63, f = q >> 6, mt = f >> 2, s = f & 3, i = 16 * mt + (Lq & 15), k0 = 32 * s + (Lq >> 4) * 8;
            float v[8]; unpack8(*(const u32x4*)(qs + i * 136 + k0), v); const float e = egcs[i];
#pragma unroll
            for (int k = 0; k < 8; ++k) v[k] *= e;
            *(u32x4*)(ib + 16384 + (size_t)q * 16) = pack8(v); }
#pragma unroll
        for (int r = 0; r < 2; ++r) {
            const int q = t2 + 256 * r, Lq = q & 63, f = q >> 6, mt = f >> 1, s = f & 1, i = 16 * mt + (Lq & 15), j0 = 32 * s + (Lq >> 4) * 8;
            float v[8]; const f32x4 a = *(const f32x4*)(qkm + i * 68 + j0), b = *(const f32x4*)(qkm + i * 68 + j0 + 4);
            v[0] = a[0]; v[1] = a[1]; v[2] = a[2]; v[3] = a[3]; v[4] = b[0]; v[5] = b[1]; v[6] = b[2]; v[7] = b[3];
            *(u32x4*)(ib + 49152 + (size_t)q * 16) = pack8(v); }
            } else if (st < 3) {
#pragma unroll 1
                for (int Bp = st + 1; Bp < 4; ++Bp) { GD_LOAD(acc, Bp); GD_PAIR(acc, Bp, st - 1); GD_STORE(acc, Bp); }
            } else {
#pragma unroll
        for (int r = 0; r < 4; ++r) {
            const int q = t2 + 256 * r, Lq = q & 63, f = q >> 6, mt = f >> 1, s = f & 1, dk = 16 * mt + (Lq & 15), j0 = 32 * s + (Lq >> 4) * 8;
            float v[8];
#pragma unroll
            for (int k = 0; k < 8; ++k) v[k] = bf2f(ks[(j0 + k) * 136 + dk]) * __expf(fminf(gl - gcs[j0 + k], 0.f));
            *(u32x4*)(ib + 32768 + (size_t)q * 16) = pack8(v); }
            }
            if (st < 3) __syncthreads();
        }
#undef GD_LOAD
#undef GD_STORE
#undef GD_PAIR
#undef GD_DIAG
    }
    __syncthreads();
#pragma unroll
    for (int r = 0; r < 2; ++r) {
        const int q = tid + 512 * r, Lq = q & 63, f = q >> 6, mt = f >> 2, s = f & 3, i = 16 * mt + (Lq & 15), k0 = 32 * s + (Lq >> 4) * 8;
        float v[8]; const f32x4 a = *(const f32x4*)(sol + i * 256 + 128 + k0), b = *(const f32x4*)(sol + i * 256 + 128 + k0 + 4);
        v[0] = a[0]; v[1] = a[1]; v[2] = a[2]; v[3] = a[3]; v[4] = b[0]; v[5] = b[1]; v[6] = b[2]; v[7] = b[3];
        *(u32x4*)(ib + (size_t)q * 16) = pack8(v); }
#pragma unroll
    for (int r = 0; r < 4; ++r) {
        const int q = tid + 512 * r, Lq = q & 63, f = q >> 6, mt = f >> 3, ntile = f & 7, i0 = 16 * mt + (Lq >> 4) * 4, cc = 16 * ntile + (Lq & 15);
        u32x2 o; o.x = pk2(sol[i0 * 256 + cc], sol[(i0 + 1) * 256 + cc]); o.y = pk2(sol[(i0 + 2) * 256 + cc], sol[(i0 + 3) * 256 + cc]);
        *(u32x2*)(ib + 57344 + (size_t)q * 8) = o; }
    __syncthreads();
}

__device__ __forceinline__ void lru_item(const Params& p, int l, int sc, int n, unsigned char* shm) {
    const int tid = fresh_tid(), L = tid & 63, w = tid >> 6;
    bf16_t* xs = (bf16_t*)shm; float* xf = (float*)(shm + 9216); float* gr = (float*)(shm + 25856);
    const ChunkGeo G = chunk_geo(sc);
    const bf16_t* PROJ = (const bf16_t*)(p.ws + WS_PROJ);
    const int g_ = w >> 2, nt_ = w & 3, lr_ = L & 15, lq_ = L >> 4;
    bf16x8 bfr[2];
    { const bf16_t* WG = (const bf16_t*)(p.ws + WS_WG) + (size_t)(n * 2 + g_) * 4096;
#pragma unroll
        for (int s = 0; s < 2; ++s) bfr[s] = *(const bf16x8*)(WG + (16 * nt_ + lr_) * 64 + 32 * s + lq_ * 8); }
    const float bias_ = p.in[g_ ? 18 : 16][l * 1024 + n * 64 + 16 * nt_ + lr_];
    const float lam_ = p.in[19][l * 1024 + n * 64 + (tid & 63)];
    {
        const int pos = tid >> 3, cgi = tid & 7, ch0 = n * 64 + cgi * 8; float acc[8];
        { const float* bp = p.in[14] + l * 1024 + ch0; const f32x4 a = *(const f32x4*)bp, b = *(const f32x4*)(bp + 4);
            acc[0] = a[0]; acc[1] = a[1]; acc[2] = a[2]; acc[3] = a[3]; acc[4] = b[0]; acc[5] = b[1]; acc[6] = b[2]; acc[7] = b[3]; }
        if (pos >= G.valid_lo) {
#pragma unroll
            for (int j = 0; j < 4; ++j) {
                const int m = G.tok0 + pos - 3 + j; float xv[8]; bool have = true;
                if (m >= 0) { unpack8(*(const u32x4*)(PROJ + (size_t)(G.row0 + pos - 3 + j) * PLD + ch0), xv); }
                else if (G.samp >= 0) { const float* sp = p.in[2] + ((size_t)(l * 16 + G.samp) * 3 + (3 + m)) * 1024 + ch0; const f32x4 a = *(const f32x4*)sp, b = *(const f32x4*)(sp + 4);
                    xv[0] = a[0]; xv[1] = a[1]; xv[2] = a[2]; xv[3] = a[3]; xv[4] = b[0]; xv[5] = b[1]; xv[6] = b[2]; xv[7] = b[3]; }
                else have = false;
                if (have) { const float* wp = p.in[13] + (size_t)(l * 4 + j) * 1024 + ch0; const f32x4 wa = *(const f32x4*)wp, wb = *(const f32x4*)(wp + 4);
                    acc[0] += xv[0] * wa[0]; acc[1] += xv[1] * wa[1]; acc[2] += xv[2] * wa[2]; acc[3] += xv[3] * wa[3];
                    acc[4] += xv[4] * wb[0]; acc[5] += xv[5] * wb[1]; acc[6] += xv[6] * wb[2]; acc[7] += xv[7] * wb[3]; }
            }
        }
        *(u32x4*)(xs + pos * 72 + cgi * 8) = pack8(acc);
#pragma unroll
        for (int k = 0; k < 8; ++k) xf[pos * 65 + cgi * 8 + k] = acc[k];
    }
    __syncthreads();
    {
        const int g = g_, nt = nt_, lr = lr_, lq = lq_;
#pragma unroll
        for (int mt = 0; mt < 4; ++mt) {
            f32x4 c = {0.f, 0.f, 0.f, 0.f};
#pragma unroll
            for (int s = 0; s < 2; ++s) { const bf16x8 a = *(const bf16x8*)(xs + (16 * mt + lr) * 72 + 32 * s + lq * 8); c = mfma16(a, bfr[s], c); }
#pragma unroll
            for (int r = 0; r < 4; ++r) gr[g * 4160 + (16 * mt + lq * 4 + r) * 65 + 16 * nt + lr] = sigmoidf_(c[r] + bias_);
        }
    }
    __syncthreads();
    {
        const int ch = tid & 63; const float sp = softplusf_(-lam_);
#pragma unroll
        for (int k = 0; k < 8; ++k) { const int tok = (tid >> 6) + 8 * k, o = tok * 65 + ch;
            const float r = gr[o], ig = gr[4160 + o], x = xf[o]; const float la = -8.f * r * sp; float a = __expf(la); float bb = sqrtf(fmaxf(-expm1f(2.f * la), 0.f)) * ig * x;
            if (tok < G.valid_lo) { a = 1.f; bb = 0.f; }
            gr[o] = a; gr[4160 + o] = bb; }
    }
    __syncthreads();
    {
        const int ch = L; float A = 1.f, hh = 0.f, hs[8], As[8];
#pragma unroll
        for (int k = 0; k < 8; ++k) { const int tok = 8 * w + k; const float a = gr[tok * 65 + ch], b2 = gr[4160 + tok * 65 + ch]; hh = a * hh + b2; A *= a; hs[k] = hh; As[k] = A; }
        xf[w * 64 + ch] = A; xf[512 + w * 64 + ch] = hh;
        __syncthreads();
        float cA = 1.f, cH = 0.f;
#pragma unroll
        for (int j = 0; j < 7; ++j) { if (j < w) { const float sa = xf[j * 64 + ch], sh = xf[512 + j * 64 + ch]; cH = sa * cH + sh; cA *= sa; } }
        float* HL = p.out + OS_HL; bf16_t* AC = (bf16_t*)(p.out + OS_AC);
#pragma unroll
        for (int k = 0; k < 8; ++k) { const int tok = 8 * w + k; const float ht = hs[k] + As[k] * cH, At = As[k] * cA;
            if (tok >= G.valid_lo) { const size_t o = (size_t)(G.row0 + tok) * 1024 + n * 64 + ch; HL[o] = ht; AC[o] = (bf16_t)(pk2(At, 0.f) & 0xffffu); }
            if (w == 7 && k == 7) { ((float*)(p.ws + WS_ACH))[sc * 1024 + n * 64 + ch] = At; ((float*)(p.ws + WS_BCH))[sc * 1024 + n * 64 + ch] = ht; } }
    }
    __syncthreads();
}

struct Frags { bf16x8 a1[4]; bf16x8 a2[2]; bf16x8 ke[2]; u32x2 u[2]; float ge; };
__device__ __forceinline__ void chain_load(Frags& f, const unsigned char* ib, const float* GE, int item, int role, int mt, int w, int d, int L) {
    const unsigned char* a1b = ib + (role ? 16384 : 0);
#pragma unroll
    for (int s = 0; s < 4; ++s) f.a1[s] = *(const bf16x8*)(a1b + (size_t)((mt * 4 + s) * 64 + L) * 16);
    if (role) {
#pragma unroll
        for (int s = 0; s < 2; ++s) f.a2[s] = *(const bf16x8*)(ib + 49152 + (size_t)((mt * 2 + s) * 64 + L) * 16);
    } else {
#pragma unroll
        for (int nt = 0; nt < 2; ++nt) f.u[nt] = *(const u32x2*)(ib + 57344 + (size_t)((mt * 8 + 2 * d + nt) * 64 + L) * 8);
    }
#pragma unroll
    for (int s = 0; s < 2; ++s) f.ke[s] = *(const bf16x8*)(ib + 32768 + (size_t)((w * 2 + s) * 64 + L) * 16);
    f.ge = GE[item];
}
__device__ __forceinline__ void chain_step(const Frags& f, f32x4 (&S)[2], unsigned char* St, unsigned char* wt, int role, int mt, int w, int L, float* Orow, int valid_lo) {
    const int lr = L & 15, lq = L >> 4;
    f32x4 acc[2]; acc[0] = (f32x4){0.f, 0.f, 0.f, 0.f}; acc[1] = acc[0];
#pragma unroll
    for (int s = 0; s < 4; ++s)
#pragma unroll
        for (int nt = 0; nt < 2; ++nt) { const bf16x8 b = *(const bf16x8*)(St + (16 * nt + lr) * 272 + (32 * s + lq * 8) * 2); acc[nt] = mfma16(f.a1[s], b, acc[nt]); }
    if (!role) {
#pragma unroll
        for (int nt = 0; nt < 2; ++nt) { u32x2 o; o.x = pk2(bflo(f.u[nt].x) - acc[nt][0], bfhi(f.u[nt].x) - acc[nt][1]); o.y = pk2(bflo(f.u[nt].y) - acc[nt][2], bfhi(f.u[nt].y) - acc[nt][3]);
            *(u32x2*)(wt + (16 * nt + lr) * 144 + (16 * mt + lq * 4) * 2) = o; }
    }
    __syncthreads();
    bf16x8 bw[2][2];
#pragma unroll
    for (int nt = 0; nt < 2; ++nt)
#pragma unroll
        for (int s = 0; s < 2; ++s) bw[nt][s] = *(const bf16x8*)(wt + (16 * nt + lr) * 144 + (32 * s + lq * 8) * 2);
    if (role) {
#pragma unroll
        for (int nt = 0; nt < 2; ++nt) {
#pragma unroll
            for (int s = 0; s < 2; ++s) acc[nt] = mfma16(f.a2[s], bw[nt][s], acc[nt]);
#pragma unroll
            for (int r = 0; r < 4; ++r) { const int i = 16 * mt + lq * 4 + r; if (i >= valid_lo) Orow[(ptrdiff_t)i * 1024 + 16 * nt + lr] = acc[nt][r]; } }
    }
#pragma unroll
    for (int nt = 0; nt < 2; ++nt) { S[nt] = S[nt] * f.ge;
#pragma unroll
        for (int s = 0; s < 2; ++s) S[nt] = mfma16(f.ke[s], bw[nt][s], S[nt]);
        u32x2 o; o.x = pk2(S[nt][0], S[nt][1]); o.y = pk2(S[nt][2], S[nt][3]);
        *(u32x2*)(St + (16 * nt + lr) * 272 + (16 * w + lq * 4) * 2) = o; }
    __syncthreads();
}
__device__ __forceinline__ void gdn_chain(const Params& p, int l, int stream, int h, int d, unsigned char* shm) {
    const int tid = fresh_tid(), L = tid & 63, w = tid >> 6, role = w >> 2, mt = w & 3, lr = L & 15, lq = L >> 4;
    const bool samp = stream >= 2; const int s = stream - 2;
    const int sc0 = samp ? 258 + s : stream * 129, nsteps = samp ? 1 : 129;
    unsigned char* St = shm; unsigned char* wt = shm + 8704;
    const float* GE = (const float*)(p.ws + WS_GE);
    float* O = (float*)(p.ws + WS_HN);
    f32x4 S[2];
#pragma unroll
    for (int nt = 0; nt < 2; ++nt)
#pragma unroll
        for (int r = 0; r < 4; ++r) S[nt][r] = samp ? p.in[5][((size_t)((l * 16 + s) * 8 + h) * 128 + 16 * w + lq * 4 + r) * 128 + 32 * d + 16 * nt + lr] : 0.f;
#pragma unroll
    for (int nt = 0; nt < 2; ++nt) { u32x2 o; o.x = pk2(S[nt][0], S[nt][1]); o.y = pk2(S[nt][2], S[nt][3]); *(u32x2*)(St + (16 * nt + lr) * 272 + (16 * w + lq * 4) * 2) = o; }
    Frags fa, fb;
    const unsigned char* gch = p.ws + WS_GCH;
    chain_load(fa, gch + (size_t)(sc0 * 8 + h) * 73728, GE, sc0 * 8 + h, role, mt, w, d, L);
    __syncthreads();
    const ptrdiff_t rbase = samp ? (ptrdiff_t)(SROW0 + 16 * s - 48) : (ptrdiff_t)(stream * TP - 48);
    for (int c = 0; c < nsteps; c += 2) {
        if (c + 1 < nsteps) { const int it = (sc0 + c + 1) * 8 + h; chain_load(fb, gch + (size_t)it * 73728, GE, it, role, mt, w, d, L); }
        chain_step(fa, S, St, wt, role, mt, w, L, O + (rbase + 64 * c) * 1024 + h * 128 + 32 * d, (c == 0) ? 48 : 0);
        if (c + 1 < nsteps) {
            if (c + 2 < nsteps) { const int it = (sc0 + c + 2) * 8 + h; chain_load(fa, gch + (size_t)it * 73728, GE, it, role, mt, w, d, L); }
            chain_step(fb, S, St, wt, role, mt, w, L, O + (rbase + 64 * (c + 1)) * 1024 + h * 128 + 32 * d, 0);
        }
    }
    float* dst = p.out + (samp ? O_SDL + (size_t)((l * 16 + s) * 8 + h) * 16384 : O_PDL + (size_t)((l * 2 + stream) * 8 + h) * 16384);
#pragma unroll
    for (int nt = 0; nt < 2; ++nt)
#pragma unroll
        for (int r = 0; r < 4; ++r) dst[(size_t)(16 * w + lq * 4 + r) * 128 + 32 * d + 16 * nt + lr] = S[nt][r];
}
__device__ __forceinline__ void chain_phase(const Params& p, int l, unsigned char* shm) {
    const int bid = blockIdx.x;
    if (bid < 64) { const int pair = (bid & 7) * 2 + ((bid >> 3) >> 2), d = (bid >> 3) & 3; gdn_chain(p, l, pair >> 3, pair & 7, d, shm);
#if REP_MASK & 0x8000
        __syncthreads(); gdn_chain(p, l, pair >> 3, pair & 7, d, shm);
#endif
        return; }
#if REP_MASK & 0x10000
    for (int rr = 0; rr < 2; ++rr) {
#else
    {
#endif
    const int r = bid - 64, nr = gridDim.x - 64;
    const float* ACH = (const float*)(p.ws + WS_ACH); const float* BCH = (const float*)(p.ws + WS_BCH); float* CARRY = (float*)(p.ws + WS_CARRY);
    for (int g = r * 512 + fresh_tid(); g < 16384; g += nr * 512) { const int s = g >> 10, ch = g & 1023; CARRY[(size_t)(258 + s) * 1024 + ch] = p.in[3][(size_t)(l * 16 + s) * 1024 + ch]; }
    for (int q = r; q < 512; q += nr) { const int pair = q >> 2, d = q & 3; gdn_chain(p, l, 2 + (pair >> 3), pair & 7, d, shm); }
    __syncthreads();
    for (int li = LRU_KEEP + r; li < NSC * 16; li += nr) lru_item(p, l, li >> 4, li & 15, shm);
    unsigned* cnt = (unsigned*)(p.ws + WS_BAR) + 3600 + 64 * l;
    __syncthreads();
    if (threadIdx.x == 0) { __threadfence(); __hip_atomic_fetch_add(cnt, 1u, __ATOMIC_RELAXED, __HIP_MEMORY_SCOPE_AGENT); }
    if (r < 4) {
        if (threadIdx.x == 0) { unsigned sp = 0; while (__hip_atomic_load(cnt, __ATOMIC_RELAXED, __HIP_MEMORY_SCOPE_AGENT) < (unsigned)nr && ++sp < (1u << 22)) __builtin_amdgcn_s_sleep(2); __threadfence(); }
        __syncthreads();
        const int g = r * 512 + fresh_tid(), b2 = g >> 10, ch = g & 1023; float carry = 0.f;
#pragma unroll 1
        for (int c0 = 0; c0 < 129; c0 += 16) {
            float av[16], bv[16];
#pragma unroll
            for (int k = 0; k < 16; ++k) { const int c = (c0 + k < 129) ? c0 + k : 128; const size_t o = (size_t)(b2 * 129 + c) * 1024 + ch; av[k] = ACH[o]; bv[k] = BCH[o]; }
#pragma unroll
            for (int k = 0; k < 16; ++k) if (c0 + k < 129) { CARRY[(size_t)(b2 * 129 + c0 + k) * 1024 + ch] = carry; carry = av[k] * carry + bv[k]; }
        }
    }
    }
}

__device__ __forceinline__ void mix_out_phase(const Params& p, int l) {
    const int tid = fresh_tid(), lane = tid & 63, wid = tid >> 6;
    bf16_t* HN = (bf16_t*)(p.ws + WS_HN); const bf16_t* PROJ = (const bf16_t*)(p.ws + WS_PROJ);
    const float* HL = p.out + OS_HL; const bf16_t* AC = (const bf16_t*)(p.out + OS_AC); const float* CARRY = (const float*)(p.ws + WS_CARRY);
    for (int row = blockIdx.x * 8 + wid; row < MROWS; row += gridDim.x * 8) {
        int sc, t, T, stream; bool samp = row >= SROW0;
        if (!samp) { stream = row / TP; t = row % TP; T = TP; sc = stream * 129 + (t + 48) / 64; }
        else { const int r = row - SROW0; stream = r >> 4; t = r & 15; T = 16; sc = 258 + stream; }
        const float* Orow = (const float*)(HN + (size_t)row * D);
        f32x4 o4[4], h4[4]; float ssA = 0.f, ssB[4];
#pragma unroll
        for (int q = 0; q < 4; ++q) { const int idx = 4 * lane + 256 * q; o4[q] = *(const f32x4*)(Orow + idx);
            const f32x4 hl = *(const f32x4*)(HL + (size_t)row * 1024 + idx); const u32x2 ac = *(const u32x2*)(AC + (size_t)row * 1024 + idx); const f32x4 ci = *(const f32x4*)(CARRY + (size_t)sc * 1024 + idx);
            h4[q][0] = hl[0] + bflo(ac.x) * ci[0]; h4[q][1] = hl[1] + bfhi(ac.x) * ci[1]; h4[q][2] = hl[2] + bflo(ac.y) * ci[2]; h4[q][3] = hl[3] + bfhi(ac.y) * ci[3];
#if TEST_SKIP == 1 || TEST_SKIP == 3
            h4[q] = (f32x4){0.f, 0.f, 0.f, 0.f};
#elif TEST_SKIP == 2
            o4[q] = (f32x4){0.f, 0.f, 0.f, 0.f};
#endif
            ssA += h4[q][0] * h4[q][0] + h4[q][1] * h4[q][1] + h4[q][2] * h4[q][2] + h4[q][3] * h4[q][3];
            ssB[q] = o4[q][0] * o4[q][0] + o4[q][1] * o4[q][1] + o4[q][2] * o4[q][2] + o4[q][3] * o4[q][3]; }
#pragma unroll
        for (int o = 1; o < 64; o <<= 1) ssA += __shfl_xor(ssA, o);
#pragma unroll
        for (int q = 0; q < 4; ++q) {
#pragma unroll
            for (int o = 1; o < 32; o <<= 1) ssB[q] += __shfl_xor(ssB[q], o); }
        const float rsA = rsqrtf(ssA * (1.f / 1024.f) + EPS);
        u32x2 ga[4], zz[4];
#pragma unroll
        for (int q = 0; q < 4; ++q) { const int idx = 4 * lane + 256 * q; ga[q] = *(const u32x2*)(PROJ + (size_t)row * PLD + 1024 + idx); zz[q] = *(const u32x2*)(PROJ + (size_t)row * PLD + 5120 + idx); }
        asm volatile("s_waitcnt vmcnt(0)" ::: "memory");
#pragma unroll
        for (int q = 0; q < 4; ++q) { const int idx = 4 * lane + 256 * q;
            const f32x4 na = *(const f32x4*)(p.in[20] + l * 1024 + idx); const f32x4 nb = *(const f32x4*)(p.in[24] + l * 128 + (idx & 127));
            const float rsB = rsqrtf(ssB[q] * (1.f / 128.f) + EPS);
            const float g0 = gelu_tanh(bflo(ga[q].x)), g1 = gelu_tanh(bfhi(ga[q].x)), g2 = gelu_tanh(bflo(ga[q].y)), g3 = gelu_tanh(bfhi(ga[q].y));
            u32x2 ya; ya.x = pk2(h4[q][0] * rsA * na[0] * g0, h4[q][1] * rsA * na[1] * g1); ya.y = pk2(h4[q][2] * rsA * na[2] * g2, h4[q][3] * rsA * na[3] * g3);
            const float z0 = siluf_(bflo(zz[q].x)), z1 = siluf_(bfhi(zz[q].x)), z2 = siluf_(bflo(zz[q].y)), z3 = siluf_(bfhi(zz[q].y));
            u32x2 yb; yb.x = pk2(o4[q][0] * rsB * nb[0] * z0, o4[q][1] * rsB * nb[1] * z1); yb.y = pk2(o4[q][2] * rsB * nb[2] * z2, o4[q][3] * rsB * nb[3] * z3);
#if TEST_SKIP == 3
            yb.x = pk2(o4[q][0], o4[q][1]); yb.y = pk2(o4[q][2], o4[q][3]);
#endif
            *(u32x2*)(HN + (size_t)row * D + idx) = ya; *(u32x2*)(HN + (size_t)row * D + 1024 + idx) = yb; }
        if (t >= T - 3) {
            const int j = t - (T - 3);
            float* lru = p.out + (samp ? O_SLRU + (size_t)(l * 16 + stream) * 1024 : O_PLRU + (size_t)(l * 2 + stream) * 1024);
            float* ca = p.out + (samp ? O_SCA + ((size_t)(l * 16 + stream) * 3 + j) * 1024 : O_PCA + ((size_t)(l * 2 + stream) * 3 + j) * 1024);
            float* cb = p.out + (samp ? O_SCB + ((size_t)(l * 16 + stream) * 3 + j) * 3072 : O_PCB + ((size_t)(l * 2 + stream) * 3 + j) * 3072);
#pragma unroll
            for (int q = 0; q < 4; ++q) { const int idx = 4 * lane + 256 * q; if (t == T - 1) *(f32x4*)(lru + idx) = h4[q];
                const u32x2 v = *(const u32x2*)(PROJ + (size_t)row * PLD + idx); *(f32x4*)(ca + idx) = (f32x4){bflo(v.x), bfhi(v.x), bflo(v.y), bfhi(v.y)}; }
#pragma unroll
            for (int q = 0; q < 12; ++q) { const int idx = 4 * lane + 256 * q; const u32x2 v = *(const u32x2*)(PROJ + (size_t)row * PLD + 2048 + idx);
                *(f32x4*)(cb + idx) = (f32x4){bflo(v.x), bfhi(v.x), bflo(v.y), bfhi(v.y)}; }
        }
    }
}

#define XB_TMO      128
#define XB_XCNT(j)  (256  + 64 * (j))
#define XB_XSUB(j)  (1280 + 64 * (j))
#define XB_XGEN(j)  (2304 + 64 * (j))
#define XB_TOP      3328
#define XB_TOPGEN   3392
#define XCD_BAR_WORDS 3456
#define XB_SPIN_CAP (1u << 18)
#define XB_LAS __attribute__((address_space(3)))

__device__ __forceinline__ unsigned xb_ld(unsigned* p)              { return __hip_atomic_load(p, __ATOMIC_RELAXED, __HIP_MEMORY_SCOPE_AGENT); }
__device__ __forceinline__ unsigned xb_add(unsigned* p, unsigned v) { return __hip_atomic_fetch_add(p, v, __ATOMIC_RELAXED, __HIP_MEMORY_SCOPE_AGENT); }
__device__ __forceinline__ unsigned xb_xcc_id() { return (unsigned)__builtin_amdgcn_s_getreg((3 << 11) | 20) & 0xFu; }
#define XB_SPIN(cond, bar) do { unsigned _sp = 0; while (cond) { __builtin_amdgcn_s_sleep(1); \
    if ((++_sp & 255u) == 0u) { if (xb_ld(&(bar)[XB_TMO])) break; if (_sp > XB_SPIN_CAP) { atomicAdd(&(bar)[XB_TMO], 1u); break; } } } } while (0)

struct XcdBarrier {
    unsigned* bar; unsigned x;
    volatile XB_LAS unsigned* st;
};

__device__ __forceinline__ XcdBarrier xcd_barrier_post(unsigned* bar, volatile XB_LAS unsigned* st) {
    XcdBarrier b; b.bar = bar; b.x = xb_xcc_id(); b.st = st;
    if (threadIdx.x == 0) (void)xb_add(&bar[XB_XCNT(b.x)], 1u);
    return b;
}
__device__ __forceinline__ void xcd_barrier_complete(unsigned* bar, unsigned x, unsigned& nloc, unsigned& nx) {
    const unsigned G = gridDim.x * gridDim.y * gridDim.z;
    unsigned sum, cnt, mine, sp = 0u;
    for (;;) {
        sum = 0u; cnt = 0u; mine = 0u;
#pragma unroll
        for (unsigned j = 0; j < 16; ++j) { const unsigned c = xb_ld(&bar[XB_XCNT(j)]); sum += c; cnt += (c > 0u) ? 1u : 0u; mine = (j == x) ? c : mine; }
        if (sum == G) break;
        __builtin_amdgcn_s_sleep(1);
        if ((++sp & 255u) == 0u) { if (xb_ld(&bar[XB_TMO])) break; if (sp > XB_SPIN_CAP) { atomicAdd(&bar[XB_TMO], 1u); break; } }
    }
    nloc = mine > 0u ? mine : 1u; nx = cnt > 0u ? cnt : 1u;
}

__device__ __forceinline__ void xcd_barrier(const XcdBarrier& b) {
    asm volatile("s_waitcnt vmcnt(0)" ::: "memory");
    __syncthreads();
    if (threadIdx.x == 0) {
        unsigned* bar = b.bar;
        __builtin_amdgcn_s_waitcnt(0);
        unsigned nloc = b.st[0], nx = b.st[1];
        if (nloc == 0u) { xcd_barrier_complete(bar, b.x, nloc, nx); b.st[0] = nloc; b.st[1] = nx; }
        const unsigned old = xb_add(&bar[XB_XSUB(b.x)], 1u);
        const unsigned gen = old / nloc;
        if (old + 1u == (gen + 1u) * nloc) {
            __builtin_amdgcn_fence(__ATOMIC_RELEASE, "agent");
            asm volatile("s_waitcnt vmcnt(0)" ::: "memory");
            const unsigned og = xb_add(&bar[XB_TOP], 1u);
            const unsigned tg = og / nx;
            if (og + 1u == (tg + 1u) * nx) xb_add(&bar[XB_TOPGEN], 1u);
            else XB_SPIN(xb_ld(&bar[XB_TOPGEN]) == tg, bar);
            __builtin_amdgcn_fence(__ATOMIC_ACQUIRE, "agent");
            xb_add(&bar[XB_XGEN(b.x)], 1u);
            asm volatile("s_waitcnt vmcnt(0)" ::: "memory");
        } else {
            XB_SPIN(xb_ld(&bar[XB_XGEN(b.x)]) == gen, bar);
            __builtin_amdgcn_fence(__ATOMIC_ACQUIRE, "agent");
            asm volatile("s_waitcnt vmcnt(0)" ::: "memory");
        }
    }
    __syncthreads();
}

struct SchedAll {
    pg8::StaticOrder so; int mode, nkt_full, nM, nN, nsplit, G, c;
    __device__ __forceinline__ void init(int M, int N, int K, int G_, int c_, int mode_) {
        mode = mode_; nkt_full = K / 64; nM = M / 256; nN = N / 256; G = G_; c = c_; so.init(M, N, G_, c_);
        nsplit = (K == DFF) ? 11 : 8;
    }
    __device__ __forceinline__ bool next(int i, pg8::Unit& u) const {
        const int nwg = nM * nN, nfull = nwg / G;
        if (!mode || i < nfull) { if (!so.next(i, u)) return false; u.kt0 = 0; u.nkt = nkt_full; u.part = 0; return true; }
        if (i > nfull) return false;
        const int left = nwg - nfull * G;
        if (c >= left * nsplit) return false;
        const int j = c / nsplit, ks = c - j * nsplit;
        unit_of(nfull * G + j, nM, nN, u.pm, u.pn); u.nkt = nkt_full / nsplit; u.kt0 = ks * u.nkt; u.part = 1; return true;
    }
    __device__ __forceinline__ void a_ready(const pg8::Unit&) const {}
    __device__ __forceinline__ void done(const pg8::Unit&) const {}
};
template <class Epi> __device__ __forceinline__ void run_gemm_sk(unsigned char* shm, const bf16_t* A, const bf16_t* Bt, int N, int K, const Epi& E, int mode, int fake = 0) {
    pg8::Gemm g; g.A = A; g.Bt = Bt; g.M = MP; g.N = N; g.K = K; g.fake = fake;
    SchedAll S; S.init(MP, N, K, (int)gridDim.x, (int)blockIdx.x, mode);
    pg8::gemm_phase<Epi, SchedAll, false>((PG8_LAS unsigned char*)shm, g, S, E, nullptr);
}
template <class Epi> __device__ __forceinline__ void run_gemm(unsigned char* shm, const bf16_t* A, const bf16_t* Bt, int N, int K, const Epi& E) {
    pg8::Gemm g; g.A = A; g.Bt = Bt; g.M = MP; g.N = N; g.K = K; g.fake = 0;
    pg8::StaticOrder S; S.init(MP, N, (int)gridDim.x, (int)blockIdx.x);
    pg8::gemm_phase<Epi, pg8::StaticOrder, false>((PG8_LAS unsigned char*)shm, g, S, E, nullptr);
}

__global__ void __launch_bounds__(512, 2) mega(Params p) {
    extern __shared__ __attribute__((aligned(16))) unsigned char shm[];
    bf16_t* HN = (bf16_t*)(p.ws + WS_HN); bf16_t* HID = (bf16_t*)(p.ws + WS_PROJ); float* X = (float*)(p.ws + WS_X);
#if N_LAUNCH_MODE == 1
    volatile XB_LAS unsigned* xbw = (volatile XB_LAS unsigned*)(shm + LDS_BYTES - 16);
    if (threadIdx.x == 0) { xbw[0] = 0u; xbw[1] = 0u; }
    __syncthreads();
    const XcdBarrier xb = xcd_barrier_post((unsigned*)(p.ws + WS_BAR), xbw);
#endif
    for (int ph = p.ph_lo; ph < p.ph_hi; ++ph) {
        const int l = ph / 12, kind = (ph == 24) ? 12 : ph % 12;
#if REP_MASK
        for (int rep = 0; rep < (((REP_MASK) >> kind) & 1 ? 2 : 1); ++rep) {
        if (rep) { __threadfence(); cg::this_grid().sync(); }
#endif
        if (PH_ON(0) && kind == 0) { prep_phase(p, l, (float*)shm); if (l == 0) norm_phase<1>(p, p.in[7], 0); else norm_phase2<0>(p, p.in[7] + l * D, 11); }
        else if (PH_ON(1) && (kind == 1 || kind == 10 || kind == 2 || kind == 11 || kind == 8 || kind == 4)) {
            EpiAll E; E.mode = (kind == 1 || kind == 10) ? 0 : (kind == 4 ? 2 : 1); E.Ob = (E.mode == 0) ? HID : (bf16_t*)(p.ws + WS_PROJ); E.Of = X; E.BA = (float*)(p.ws + WS_BA); E.scale = kind == 8 ? 1.f : 0.5f;
            E.PART = (float*)(p.ws + WS_PART) + (size_t)blockIdx.x * 65536;
#if REP_MASK
            if (((REP_MASK) >> kind) & 1) E.scale *= 0.5f;
#endif
            const bf16_t* A = (kind == 2 || kind == 11) ? HID : HN;
            size_t wo; int N, K;
            if (kind == 1) { wo = WS_WGU1; N = NGU; K = D; } else if (kind == 10) { wo = WS_WGU2; N = NGU; K = D; } else if (kind == 2) { wo = WS_WD1; N = D; K = DFF; }
            else if (kind == 11) { wo = WS_WD2; N = D; K = DFF; } else if (kind == 8) { wo = WS_WOUT; N = D; K = D; } else { wo = WS_WIN; N = NINP; K = D; }
#if REP_MASK
            if (rep) { E.mode = 3; run_gemm_sk(shm, A, (const bf16_t*)(p.ws + wo), N, K, E, 0, PROBE_FAKE); } else
#endif
            run_gemm_sk(shm, A, (const bf16_t*)(p.ws + wo), N, K, E, (E.mode == 1 && gridDim.x == 256) ? 1 : 0); }
        else if (PH_ON(3) && kind == 3) norm_phase2<0>(p, p.in[11] + l * D, 11);
        else if (PH_ON(3) && kind == 9) norm_phase2<0>(p, p.in[26] + l * D, 8);
        else if (PH_ON(5) && kind == 5) {
            const bool taps = (gridDim.x & 7u) == 0u;
            if (taps) { const int hh = blockIdx.x & 7; float* wl = (float*)(shm + 135168);
                for (int i = fresh_tid(); i < 1536; i += 512) { const int j = i / 384, rem = i - j * 384, typ = rem >> 7, cc = rem & 127; wl[i] = p.in[21][(size_t)(l * 4 + j) * 3072 + typ * 1024 + hh * 128 + cc]; }
                __syncthreads(); }
            for (int it = blockIdx.x; it < NSC * 8 + LRU_KEEP; it += gridDim.x) {
                if (it < NSC * 8) gdn_item(p, l, it >> 3, it & 7, shm, taps);
                else { const int r = it - NSC * 8; lru_item(p, l, r >> 4, r & 15, shm); } }
        }
        else if (PH_ON(6) && kind == 6) chain_phase(p, l, shm);
        else if (PH_ON(7) && kind == 7) mix_out_phase(p, l);
        else if (PH_ON(12) && kind == 12) norm_phase2<2>(p, p.in[30], 11);
#if REP_MASK
        }
#endif
#if N_LAUNCH_MODE == 1
        if (ph + 1 < p.ph_hi) { if (p.ph_hi > 1000) cg::this_grid().sync(); else xcd_barrier(xb); }
#else
        if (ph + 1 < p.ph_hi) cg::this_grid().sync();
#endif
    }
}

extern "C" void kernel_launch(void* const* d_in, const int* in_sizes, int n_in, void* d_out, int out_size, void* d_ws, size_t ws_size, hipStream_t stream) {
    static int grid = 0;
    if (grid == 0) {
        if (n_in != 31 || ws_size < WS_END) { fprintf(stderr, "kernel_launch: unexpected n_in %d or ws_size %zu (need %zu)\n", n_in, ws_size, (size_t)WS_END); grid = -1; return; }
        int dev = 0, cus = 0, per_cu = 0;
        hipGetDevice(&dev); hipDeviceGetAttribute(&cus, hipDeviceAttributeMultiprocessorCount, dev);
        if (hipFuncSetAttribute((const void*)mega, hipFuncAttributeMaxDynamicSharedMemorySize, LDS_BYTES) != hipSuccess) { fprintf(stderr, "kernel_launch: hipFuncSetAttribute failed\n"); grid = -1; return; }
        if (hipOccupancyMaxActiveBlocksPerMultiprocessor(&per_cu, (const void*)mega, 512, LDS_BYTES) != hipSuccess || per_cu < 1) { fprintf(stderr, "kernel_launch: occupancy query says %d\n", per_cu); per_cu = 1; }
        (void)hipGetLastError();
        grid = cus;
        if (grid < 128) { fprintf(stderr, "kernel_launch: only %d CUs\n", grid); grid = -1; return; }
    }
    if (grid < 0) return;
    Params p{};
#if TEST_MEMSET
    (void)hipMemsetAsync((unsigned char*)d_ws + WS_X, 0, WS_END - WS_X, stream);
#endif
    for (int i = 0; i < 31; ++i) p.in[i] = (const float*)d_in[i];
    p.out = (float*)d_out; p.ws = (unsigned char*)d_ws;
#if N_LAUNCH_MODE == 1
    p.ph_lo = 0; p.ph_hi = 25;
    (void)hipMemsetAsync((unsigned char*)d_ws + WS_BAR, 0, 16384, stream);
    void* args[] = {&p};
    hipError_t e = hipLaunchCooperativeKernel((const void*)mega, dim3(grid), dim3(512), args, LDS_BYTES, stream);
    if (e != hipSuccess) fprintf(stderr, "cooperative launch failed: %s (grid %d)\n", hipGetErrorString(e), grid);
#else
    for (int ph = 0; ph < 25; ++ph) { p.ph_lo = ph; p.ph_hi = ph + 1; hipLaunchKernelGGL(mega, dim3(grid), dim3(512), LDS_BYTES, stream, p); }
#endif
}
```

```cpp
#include <hip/hip_runtime.h>
#include <hip/hip_cooperative_groups.h>
#include <cstdio>
namespace cg = cooperative_groups;
namespace pg8 {
#define PG8_LAS __attribute__((address_space(3)))
typedef unsigned short bf16_t;
typedef short bf16x8 __attribute__((ext_vector_type(8)));
typedef float f32x4 __attribute__((ext_vector_type(4)));
typedef unsigned u32x4 __attribute__((ext_vector_type(4)));
constexpr int BM = 256, BK = 64, HALF = 128, HTB = HALF * BK * 2  , STAGE_BYTES = 8 * HTB, NXCD = 8, WGM = 8;
__host__ __device__ __forceinline__ int lds_byte(int r, int c) { const int st = (r >> 4) * 2 + (c >> 5), rr = r & 15, cc = c & 31, ob = rr * 64 + cc * 2; return st * 1024 + (ob ^ (((ob >> 9) & 1) << 5)); }
__host__ __device__ __forceinline__ void stage_rc(int b, int& R, int& C) { const int st = b / 1024, sb = b % 1024, swz = sb ^ (((sb >> 9) & 1) << 5); R = (st >> 1) * 16 + swz / 64; C = (st & 1) * 32 + (swz % 64) / 2; }
__host__ __device__ __forceinline__ int perm32(int rho) { const int n = rho >> 4, i = rho & 15; return 8 * (i >> 2) + 4 * n + (i & 3); }
struct Unit { int pm, pn, kt0, nkt, part; };
struct Gemm { const bf16_t* A; const bf16_t* Bt; int M, N, K, fake; };
struct StaticOrder {
    int nM, nN, nwg, G, c;
    __host__ __device__ void init(int M, int N, int G_, int c_) { nM = M / BM; nN = N / BM; nwg = nM * nN; G = G_; c = c_; }
    __host__ __device__ bool next(int i, Unit& u) const {
        const long L = (long)i * G + c; if (L >= nwg) return false;
        int wgid = (int)L; { const int q = nwg / NXCD, r = nwg % NXCD, xcd = wgid % NXCD, off = wgid / NXCD; wgid = (xcd < r ? xcd * (q + 1) : r * (q + 1) + (xcd - r) * q) + off; }
        const int nig = WGM * nN, gid = wgid / nig, fm = gid * WGM, gsz = (nM - fm) < WGM ? (nM - fm) : WGM;
        u.pm = fm + ((wgid % nig) % gsz); u.pn = (wgid % nig) / gsz; return true;
    }
    __device__ __forceinline__ void a_ready(const Unit&) const {}
    __device__ __forceinline__ void done(const Unit&) const {}
};
__device__ __forceinline__ unsigned cvt_pk_bf16(float lo, float hi) { unsigned r; asm volatile("v_cvt_pk_bf16_f32 %0, %1, %2" : "=v"(r) : "v"(lo), "v"(hi)); return r; }
template <class Epi, class Sched, bool STAMP = false>
__device__ __forceinline__ void gemm_phase(PG8_LAS unsigned char* lds, const Gemm g, const Sched& S, const Epi& E, unsigned long long* stamps) {
    int tid_ = threadIdx.x; asm volatile("" : "+v"(tid_)); const int tid = tid_, wid = __builtin_amdgcn_readfirstlane(tid >> 6), lane = tid & 63, wr = wid >> 2, wc = wid & 3, fr = lane & 15, fq = lane >> 4;
    const int K = g.K; int nt;
    int ts_lo = 0, ts_hi = 0, nts = 0; const unsigned long long rt_entry = STAMP ? (unsigned long long)wall_clock64() : 0ull;
#define PG8_STAMP() do { if (STAMP && wid == 0 && nts < 64) { const unsigned long long _c = (unsigned long long)clock64(); \
        ts_lo = (lane == nts) ? (int)(unsigned)_c : ts_lo; ts_hi = (lane == nts) ? (int)(unsigned)(_c >> 32) : ts_hi; ++nts; } } while (0)
    PG8_STAMP();
    unsigned voffA[2], voffB[2];
#pragma unroll
    for (int i = 0; i < 2; ++i) { int R, C; stage_rc(tid * 16 + i * 8192, R, C); const int Rb = E.perm() ? ((R & ~31) + perm32(R & 31)) : R;
        voffA[i] = (unsigned)(R * K + C) * 2u; voffB[i] = (unsigned)(Rb * K + C) * 2u; }
    const size_t kstep = (size_t)(BK * 2);
    const size_t hstep = (size_t)HALF * K * 2;
    const size_t tstep = 2 * hstep;
    const unsigned ldsw = (unsigned)wid * 1024u;
    const int aoff = lds_byte(wr * 64 + fr, fq * 8), boff = lds_byte(wc * 32 + fr, fq * 8);
#define PG8_SA(b, h) (((b) * 2 + (h)) * HTB)
#define PG8_SB(b, h) ((4 + (b) * 2 + (h)) * HTB)
#define PG8_STAGE(bufoff, gbase, voff) do { _Pragma("unroll") for (int _i = 0; _i < 2; ++_i) \
        __builtin_amdgcn_global_load_lds((const unsigned*)((const char*)(gbase) + (voff)[_i]), (PG8_LAS unsigned*)(lds + (bufoff) + ldsw + _i * 8192), 16, 0, 0); } while (0)
#define PG8_LDA(dst, b, h) do { _Pragma("unroll") for (int m = 0; m < 4; ++m) _Pragma("unroll") for (int k = 0; k < 2; ++k) dst[m][k] = *(const PG8_LAS bf16x8*)(lds + PG8_SA(b, h) + aoff + m * 2048 + k * 1024); } while (0)
#define PG8_LDB(dst, b, h) do { _Pragma("unroll") for (int n = 0; n < 2; ++n) _Pragma("unroll") for (int k = 0; k < 2; ++k) dst[n][k] = *(const PG8_LAS bf16x8*)(lds + PG8_SB(b, h) + boff + n * 2048 + k * 1024); } while (0)
#define PG8_MMA(ai, bj, At, Bt) do { __builtin_amdgcn_s_setprio(1); _Pragma("unroll") for (int m = 0; m < 4; ++m) _Pragma("unroll") for (int n = 0; n < 2; ++n) _Pragma("unroll") for (int k = 0; k < 2; ++k) \
        acc[ai][bj][m][n] = __builtin_amdgcn_mfma_f32_16x16x32_bf16(Bt[n][k], At[m][k], acc[ai][bj][m][n], 0, 0, 0); __builtin_amdgcn_s_setprio(0); } while (0)
#define PG8_WAIT_V(n) asm volatile("s_waitcnt vmcnt(" #n ")" ::: "memory")
#define PG8_WAIT_L(n) asm volatile("s_waitcnt lgkmcnt(" #n ")" ::: "memory")
#define PG8_BAR __builtin_amdgcn_s_barrier()
#define PG8_SCHED __builtin_amdgcn_sched_barrier(0)
    Unit cur, nxt; int ui = 0;
    if (!S.next(0, cur)) return;
    nt = cur.nkt;
    f32x4 acc[2][2][4][2];
#pragma unroll
    for (int a = 0; a < 2; ++a)
#pragma unroll
        for (int b = 0; b < 2; ++b)
#pragma unroll
            for (int m = 0; m < 4; ++m)
#pragma unroll
                for (int n = 0; n < 2; ++n) acc[a][b][m][n] = (f32x4){0.f, 0.f, 0.f, 0.f};
    bf16x8 At[4][2], B0[2][2], B1[2][2];
    const char* cA = (const char*)g.A + (g.fake ? (size_t)0 : (size_t)cur.pm * tstep) + (size_t)cur.kt0 * (size_t)(BK * 2); const char* cB = (const char*)g.Bt + (g.fake ? (size_t)0 : (size_t)cur.pn * tstep) + (size_t)cur.kt0 * (size_t)(BK * 2);
    S.a_ready(cur);
    PG8_STAGE(PG8_SB(0, 0), cB, voffB); PG8_STAGE(PG8_SA(0, 0), cA, voffA); PG8_STAGE(PG8_SB(0, 1), cB + hstep, voffB); PG8_STAGE(PG8_SA(0, 1), cA + hstep, voffA);
    if (wr == 1) PG8_BAR;
    PG8_WAIT_V(4); PG8_BAR;
    PG8_STAGE(PG8_SB(1, 0), cB + kstep, voffB); PG8_STAGE(PG8_SA(1, 0), cA + kstep, voffA); PG8_STAGE(PG8_SB(1, 1), cB + hstep + kstep, voffB);
    PG8_WAIT_V(6); PG8_BAR;
    PG8_STAMP();
    for (;;) {
        const bool has_next = S.next(ui + 1, nxt);
        const char* nA = has_next ? (const char*)g.A + (g.fake ? (size_t)0 : (size_t)nxt.pm * tstep) + (size_t)nxt.kt0 * kstep : cA; const char* nB = has_next ? (const char*)g.Bt + (g.fake ? (size_t)0 : (size_t)nxt.pn * tstep) + (size_t)nxt.kt0 * kstep : cB;
        for (int t = 0; t < nt; t += 2) {
            const bool last = (t == nt - 2);
            const char* a1 = cA + (size_t)(t + 1) * kstep;
            const char* a2 = last ? nA : cA + (size_t)(t + 2) * kstep; const char* b2 = last ? nB : cB + (size_t)(t + 2) * kstep;
            const char* a3 = a2 + kstep; const char* b3 = b2 + kstep;
            if (last && has_next) S.a_ready(nxt);
            PG8_LDB(B0, 0, 0); PG8_SCHED; PG8_LDA(At, 0, 0); PG8_STAGE(PG8_SA(1, 1), a1 + hstep, voffA);
            PG8_WAIT_L(8); PG8_BAR; PG8_WAIT_L(0); PG8_MMA(0, 0, At, B0); PG8_BAR; PG8_SCHED;
            PG8_LDB(B1, 0, 1); PG8_STAGE(PG8_SB(0, 0), b2, voffB);
            PG8_BAR; PG8_WAIT_L(0); PG8_MMA(0, 1, At, B1); PG8_BAR;
            PG8_LDA(At, 0, 1); PG8_STAGE(PG8_SA(0, 0), a2, voffA);
            PG8_BAR; PG8_WAIT_L(0); PG8_MMA(1, 0, At, B0); PG8_BAR; PG8_SCHED;
            PG8_STAGE(PG8_SB(0, 1), b2 + hstep, voffB);
            PG8_WAIT_V(6); PG8_BAR; PG8_MMA(1, 1, At, B1); PG8_BAR;
            PG8_LDB(B0, 1, 0); PG8_SCHED; PG8_LDA(At, 1, 0); PG8_STAGE(PG8_SA(0, 1), a2 + hstep, voffA);
            PG8_WAIT_L(8); PG8_BAR; PG8_WAIT_L(0); PG8_MMA(0, 0, At, B0); PG8_BAR; PG8_SCHED;
            PG8_LDB(B1, 1, 1); PG8_STAGE(PG8_SB(1, 0), b3, voffB);
            PG8_BAR; PG8_WAIT_L(0); PG8_MMA(0, 1, At, B1); PG8_BAR;
            PG8_LDA(At, 1, 1); PG8_STAGE(PG8_SA(1, 0), a3, voffA);
            PG8_BAR; PG8_WAIT_L(0); PG8_MMA(1, 0, At, B0); PG8_BAR; PG8_SCHED;
            PG8_STAGE(PG8_SB(1, 1), b3 + hstep, voffB);
            PG8_WAIT_V(6); PG8_BAR; PG8_MMA(1, 1, At, B1); PG8_BAR;
        }
        PG8_STAMP();
        if constexpr (!Epi::AFTER_DRAIN) { E(acc, cur, wr, wc, fr, fq); S.done(cur); }
        PG8_STAMP();
        if (!has_next) break;
#pragma unroll
        for (int a = 0; a < 2; ++a)
#pragma unroll
            for (int b = 0; b < 2; ++b)
#pragma unroll
                for (int m = 0; m < 4; ++m)
#pragma unroll
                    for (int n = 0; n < 2; ++n) acc[a][b][m][n] = (f32x4){0.f, 0.f, 0.f, 0.f};
        cur = nxt; cA = nA; cB = nB; ++ui; nt = cur.nkt;
    }
    PG8_WAIT_V(0);
    if (wr == 0) PG8_BAR;
    PG8_BAR;
    if constexpr (Epi::AFTER_DRAIN) { E.fused(acc, cur, wr, wc, fr, fq, lds, wid, lane); S.done(cur); }
    PG8_STAMP();
    if (STAMP && wid == 0) { stamps[lane] = lane < nts ? (((unsigned long long)(unsigned)ts_hi << 32) | (unsigned)ts_lo) : 0ull;
        if (lane == 62) stamps[62] = rt_entry; if (lane == 63) stamps[63] = (unsigned long long)wall_clock64(); }
#undef PG8_STAMP
#undef PG8_SA
#undef PG8_SB
#undef PG8_STAGE
#undef PG8_LDA
#undef PG8_LDB
#undef PG8_MMA
#undef PG8_WAIT_V
#undef PG8_WAIT_L
#undef PG8_BAR
#undef PG8_SCHED
}
}
using pg8::bf16_t; using pg8::bf16x8; using pg8::f32x4; using pg8::u32x4;
typedef unsigned u32x2 __attribute__((ext_vector_type(2)));

constexpr int D = 2048, TP = 8208, NSS = 16;
constexpr int MROWS = 16672, MP = 16896, SROW0 = 16416;
constexpr int DFF = 5632, NGU = 11264, NINP = 6400, PLD = 6144;
constexpr int NSC = 274;
constexpr float EPS = 1e-6f;
constexpr int LDS_BYTES = 147456;
#ifndef TEST_MEMSET
#define TEST_MEMSET 0
#endif
#ifndef LRU_KEEP
#define LRU_KEEP 0
#endif
#ifndef PROBE_FAKE
#define PROBE_FAKE 1
#endif
#ifndef REP_MASK
#define REP_MASK 0
#endif
#ifndef TEST_SKIP
#define TEST_SKIP 0
#endif
#ifndef PH_MASK
#define PH_MASK 0x7fff
#endif
#define PH_ON(k) (((PH_MASK) >> (k)) & 1)
#ifndef N_LAUNCH_MODE
#define N_LAUNCH_MODE 1
#endif

constexpr size_t SZ_WGU = (size_t)NGU * D * 2, SZ_WD = (size_t)D * DFF * 2, SZ_WIN = (size_t)NINP * D * 2, SZ_WOUT = (size_t)D * D * 2;
constexpr size_t WS_WGU1 = 0, WS_WD1 = WS_WGU1 + SZ_WGU, WS_WGU2 = WS_WD1 + SZ_WD, WS_WD2 = WS_WGU2 + SZ_WGU, WS_WIN = WS_WD2 + SZ_WD, WS_WOUT = WS_WIN + SZ_WIN,
    WS_WG = WS_WOUT + SZ_WOUT, WS_X = WS_WG + 262144, WS_HN = WS_X + (size_t)MP * D * 4, WS_PROJ = WS_HN + (size_t)MP * D * 2, WS_GCH = WS_PROJ + (size_t)MP * PLD * 2,
    WS_BA = WS_GCH + (size_t)NSC * 8 * 73728, WS_GE = WS_BA + (size_t)MP * 16 * 4, WS_ACH = WS_GE + 16384, WS_BCH = WS_ACH + (size_t)NSC * 1024 * 4,
    WS_CARRY = WS_BCH + (size_t)NSC * 1024 * 4, WS_PART = WS_CARRY + (size_t)NSC * 1024 * 4, WS_BAR = WS_PART + (size_t)256 * 65536 * 4, WS_END = WS_BAR + 16384;
constexpr size_t O_YP = 0, O_YS = 33554432, O_PCA = 34078720, O_PLRU = 34091008, O_PCB = 34095104, O_PDL = 34131968, O_SCA = 34656256, O_SLRU = 34754560,
    O_SCB = 34787328, O_SDL = 35082240;
constexpr size_t OS_HL = 0, OS_AC = (size_t)MROWS * 1024;

__device__ __forceinline__ int fresh_tid() { int t = threadIdx.x; asm volatile("" : "+v"(t)); return t; }
__device__ __forceinline__ void unit_of(int L, int nM, int nN, int& pm, int& pn) {
    const int nwg = nM * nN; int wgid = L; { const int q = nwg / 8, r = nwg % 8, xcd = wgid % 8, off = wgid / 8; wgid = (xcd < r ? xcd * (q + 1) : r * (q + 1) + (xcd - r) * q) + off; }
    const int nig = 8 * nN, gid = wgid / nig, fm = gid * 8, gsz = (nM - fm) < 8 ? (nM - fm) : 8;
    pm = fm + ((wgid % nig) % gsz); pn = (wgid % nig) / gsz;
}
struct Params { const float* in[31]; float* out; unsigned char* ws; int ph_lo, ph_hi; };

typedef __bf16 bf16v2 __attribute__((ext_vector_type(2)));
__device__ __forceinline__ unsigned pk2(float lo, float hi) { bf16v2 v; v[0] = (__bf16)lo; v[1] = (__bf16)hi; return __builtin_bit_cast(unsigned, v); }
__device__ __forceinline__ float bflo(unsigned u) { return __uint_as_float(u << 16); }
__device__ __forceinline__ float bfhi(unsigned u) { return __uint_as_float(u & 0xffff0000u); }
__device__ __forceinline__ float bf2f(bf16_t b) { return __uint_as_float(((unsigned)b) << 16); }
__device__ __forceinline__ float sigmoidf_(float x) { return __builtin_amdgcn_rcpf(1.f + __expf(-x)); }
__device__ __forceinline__ float siluf_(float x) { return x * __builtin_amdgcn_rcpf(1.f + __expf(-x)); }
__device__ __forceinline__ float softplusf_(float x) { return x > 20.f ? x : log1pf(__expf(x)); }
__device__ __forceinline__ float gelu_tanh(float x) { const float y = 0.7978845608028654f * (x + 0.044715f * x * x * x); const float t = 1.f - 2.f * __builtin_amdgcn_rcpf(1.f + __expf(2.f * y)); return 0.5f * x * (1.f + t); }
__device__ __forceinline__ void unpack8(const u32x4 v, float (&f)[8]) { f[0] = bflo(v.x); f[1] = bfhi(v.x); f[2] = bflo(v.y); f[3] = bfhi(v.y); f[4] = bflo(v.z); f[5] = bfhi(v.z); f[6] = bflo(v.w); f[7] = bfhi(v.w); }
__device__ __forceinline__ u32x4 pack8(const float (&f)[8]) { u32x4 o; o.x = pk2(f[0], f[1]); o.y = pk2(f[2], f[3]); o.z = pk2(f[4], f[5]); o.w = pk2(f[6], f[7]); return o; }
__device__ __forceinline__ f32x4 mfma16(bf16x8 a, bf16x8 b, f32x4 c) { return __builtin_amdgcn_mfma_f32_16x16x32_bf16(a, b, c, 0, 0, 0); }

struct EpiGU {
    static constexpr bool PERM = false, AFTER_DRAIN = false;
    bf16_t* H;
    __device__ __forceinline__ void operator()(const f32x4 (&acc)[2][2][4][2], const pg8::Unit& u, int wr, int wc, int fr, int fq) const {
        const int row0 = u.pm * 256 + wr * 64 + fr, hc0 = u.pn * 128 + wc * 16 + 4 * fq;
#pragma unroll
        for (int ai = 0; ai < 2; ++ai)
#pragma unroll
            for (int m = 0; m < 4; ++m) { u32x2 o[2];
#pragma unroll
                for (int bj = 0; bj < 2; ++bj) { const f32x4 g = acc[ai][bj][m][0], up = acc[ai][bj][m][1];
                    o[bj].x = pk2(siluf_(g[0]) * up[0], siluf_(g[1]) * up[1]); o[bj].y = pk2(siluf_(g[2]) * up[2], siluf_(g[3]) * up[3]); }
                const auto rx = __builtin_amdgcn_permlane16_swap(o[0].x, o[1].x, false, false); const auto ry = __builtin_amdgcn_permlane16_swap(o[0].y, o[1].y, false, false);
                u32x4 w; w.x = rx[0]; w.y = ry[0]; w.z = rx[1]; w.w = ry[1];
                *(u32x4*)(H + (size_t)(row0 + ai * 128 + m * 16) * DFF + u.pn * 128 + 64 * (fq & 1) + wc * 16 + 8 * (fq >> 1)) = w; }
    }
};
struct EpiRes {
    static constexpr bool PERM = false, AFTER_DRAIN = false;
    float* X; float scale; float* PART;
    __device__ __forceinline__ void operator()(const f32x4 (&acc)[2][2][4][2], const pg8::Unit& u, int wr, int wc, int fr, int fq) const {
        const bool tail = u.part != 0;
        const int rl0 = wr * 64 + fr, cl0 = wc * 32 + 4 * fq;
        float* base = tail ? PART + (size_t)rl0 * 256 + cl0 : X + (size_t)(u.pm * 256 + rl0) * D + u.pn * 256 + cl0;
        const size_t ld = tail ? 256 : D;
#pragma unroll
        for (int ai = 0; ai < 2; ++ai)
#pragma unroll
            for (int m = 0; m < 4; ++m) { float* rowp = base + (size_t)(ai * 128 + m * 16) * ld;
#pragma unroll
                for (int bj = 0; bj < 2; ++bj)
#pragma unroll
                    for (int n = 0; n < 2; ++n) { f32x4* q = (f32x4*)(rowp + bj * 128 + n * 16); f32x4 v = acc[ai][bj][m][n] * scale; if (!tail) v = v + *q; *q = v; } }
    }
};
struct EpiProj {
    static constexpr bool PERM = true, AFTER_DRAIN = false;
    bf16_t* P; float* BA;
    __device__ __forceinline__ void operator()(const f32x4 (&acc)[2][2][4][2], const pg8::Unit& u, int wr, int wc, int fr, int fq) const {
        const int row0 = u.pm * 256 + wr * 64 + fr;
        if (u.pn < 24) {
            const int col0 = u.pn * 256 + wc * 32 + 8 * fq;
#pragma unroll
            for (int ai = 0; ai < 2; ++ai)
#pragma unroll
                for (int m = 0; m < 4; ++m) { bf16_t* rowp = P + (size_t)(row0 + ai * 128 + m * 16) * PLD + col0;
#pragma unroll
                    for (int bj = 0; bj < 2; ++bj) { const f32x4 v0 = acc[ai][bj][m][0], v1 = acc[ai][bj][m][1];
                        u32x4 w; w.x = pk2(v0[0], v0[1]); w.y = pk2(v0[2], v0[3]); w.z = pk2(v1[0], v1[1]); w.w = pk2(v1[2], v1[3]);
                        *(u32x4*)(rowp + bj * 128) = w; } }
        } else if (wc == 0 && fq < 2) {
#pragma unroll
            for (int ai = 0; ai < 2; ++ai)
#pragma unroll
                for (int m = 0; m < 4; ++m) { float* q = BA + (size_t)(row0 + ai * 128 + m * 16) * 16 + 8 * fq;
                    *(f32x4*)q = acc[ai][0][m][0]; *(f32x4*)(q + 4) = acc[ai][0][m][1]; }
        }
    }
};

struct EpiAll {
    static constexpr bool AFTER_DRAIN = false;
    int mode; bf16_t* Ob; float* Of; float* BA; float scale; float* PART;
    __device__ __forceinline__ bool perm() const { return mode == 2; }
    __device__ __forceinline__ void operator()(const f32x4 (&acc)[2][2][4][2], const pg8::Unit& u, int wr, int wc, int fr, int fq) const {
        if (mode == 3) {
            f32x4 s = {0.f, 0.f, 0.f, 0.f};
#pragma unroll
            for (int ai = 0; ai < 2; ++ai)
#pragma unroll
                for (int bj = 0; bj < 2; ++bj)
#pragma unroll
                    for (int m = 0; m < 4; ++m)
#pragma unroll
                        for (int n = 0; n < 2; ++n) s = s + acc[ai][bj][m][n];
            if (s[0] + s[1] + s[2] + s[3] == 12345.678f) BA[0] = s[0];
            return; }
        if (mode == 0) { EpiGU e; e.H = Ob; e(acc, u, wr, wc, fr, fq); }
        else if (mode == 1) { EpiRes e; e.X = Of; e.scale = scale; e.PART = PART; e(acc, u, wr, wc, fr, fq); }
        else { EpiProj e; e.P = Ob; e.BA = BA; e(acc, u, wr, wc, fr, fq); }
    }
};

__device__ __forceinline__ void tr_tile(const float* W, int K, int N, int kb, int nb, bf16_t* dst, int mode, float* tile) {
    const int tid = fresh_tid(), k0 = kb * 64, n0 = nb * 64;
    { const int nn = tid & 63, kq = tid >> 6, n = n0 + nn;
#pragma unroll
        for (int r = 0; r < 8; ++r) { const int kk = r * 8 + kq; tile[kk * 65 + nn] = (n < N) ? W[(size_t)(k0 + kk) * N + n] : 0.f; } }
    __syncthreads();
    { const int nn = tid >> 3, kc = tid & 7, n = n0 + nn; int drow = n;
        if (mode == 1) drow = (n >> 4) * 32 + (n & 15); else if (mode == 2) drow = (n >> 4) * 32 + 16 + (n & 15);
        const float* s = tile + (kc * 8) * 65 + nn; u32x4 o; o.x = pk2(s[0], s[65]); o.y = pk2(s[130], s[195]); o.z = pk2(s[260], s[325]); o.w = pk2(s[390], s[455]);
        *(u32x4*)(dst + (size_t)drow * K + k0 + kc * 8) = o; }
    __syncthreads();
}
struct TrJob { const float* W; bf16_t* dst; int K, N, mode, kb, nb; };
__device__ __forceinline__ TrJob prep_job(const Params& p, int l, int it) {
    TrJob j;
    if (it < 4224) { const int m = it / 704, r = it % 704, f = m / 3, w = m % 3;
        j.W = p.in[(f ? 27 : 8) + w] + (size_t)l * 2048 * 5632;
        if (w < 2) { j.K = 2048; j.N = 5632; j.kb = r / 22; j.nb = r % 22; j.mode = w + 1; j.dst = (bf16_t*)(p.ws + (f ? WS_WGU2 : WS_WGU1)); }
        else { j.K = 5632; j.N = 2048; j.kb = r / 8; j.nb = r % 8; j.mode = 0; j.dst = (bf16_t*)(p.ws + (f ? WS_WD2 : WS_WD1)); }
    } else if (it < 5024) { const int r = it - 4224; j.W = p.in[12] + (size_t)l * 2048 * 6160; j.K = 2048; j.N = 6160; j.kb = r / 25; j.nb = r % 25; j.mode = 0; j.dst = (bf16_t*)(p.ws + WS_WIN);
    } else { const int r = it - 5024; j.W = p.in[25] + (size_t)l * 2048 * 2048; j.K = 2048; j.N = 2048; j.kb = r / 8; j.nb = r % 8; j.mode = 0; j.dst = (bf16_t*)(p.ws + WS_WOUT); }
    return j;
}
__device__ __forceinline__ void tr_load(const TrJob& j, f32x4 (&v)[8], int tid) {
    const int lane = tid & 63, wid = tid >> 6, n = j.nb * 256 + lane * 4;
#pragma unroll
    for (int ps = 0; ps < 8; ++ps) v[ps] = (n < j.N) ? *(const f32x4*)(j.W + (size_t)(j.kb * 64 + ps * 8 + wid) * j.N + n) : (f32x4){0.f, 0.f, 0.f, 0.f};
}
__device__ __forceinline__ void prep_phase(const Params& p, int l, float* tile) {
    constexpr int NJ = 5280;
    const int tid = fresh_tid(), lane = tid & 63, wid = tid >> 6;
    int it = blockIdx.x; f32x4 v[8]; TrJob job;
    if (it < NJ) { job = prep_job(p, l, it); tr_load(job, v, tid); }
    while (it < NJ) {
#pragma unroll
        for (int ps = 0; ps < 8; ++ps) *(f32x4*)(tile + (ps * 8 + wid) * 260 + lane * 4) = v[ps];
        __syncthreads();
        const TrJob cur = job; it += gridDim.x;
        if (it < NJ) { job = prep_job(p, l, it); tr_load(job, v, tid); }
#pragma unroll
        for (int r = 0; r < 4; ++r) { const int q = tid + 512 * r, nl = q & 255, kc = q >> 8, n = cur.nb * 256 + nl; int drow = n;
            if (cur.mode == 1) drow = (n >> 4) * 32 + (n & 15); else if (cur.mode == 2) drow = (n >> 4) * 32 + 16 + (n & 15);
            const float* s = tile + (kc * 8) * 260 + nl; u32x4 o; o.x = pk2(s[0], s[260]); o.y = pk2(s[520], s[780]); o.z = pk2(s[1040], s[1300]); o.w = pk2(s[1560], s[1820]);
            *(u32x4*)(cur.dst + (size_t)drow * cur.K + cur.kb * 64 + kc * 8) = o; }
        __syncthreads();
    }
    for (int r = blockIdx.x; r < 32; r += gridDim.x) { const int n = r >> 1, g = r & 1; tr_tile(p.in[g ? 17 : 15] + (size_t)l * 65536 + n * 4096, 64, 64, 0, 0, (bf16_t*)(p.ws + WS_WG) + r * 4096, 0, tile); }
}

template <int MODE>
__device__ __forceinline__ void norm_phase(const Params& p, const float* w, int ndp) {
    const int tid = fresh_tid(), lane = tid & 63, wid = tid >> 6;
    float* X = (float*)(p.ws + WS_X); bf16_t* HN = (bf16_t*)(p.ws + WS_HN);
    for (int row = blockIdx.x * 8 + wid; row < MP; row += gridDim.x * 8) {
        if (row >= MROWS) {
            if (MODE != 2) {
#pragma unroll
                for (int q = 0; q < 8; ++q) { const int idx = 4 * lane + 256 * q; *(u32x2*)(HN + (size_t)row * D + idx) = (u32x2){0u, 0u};
                    if (MODE == 1) *(f32x4*)(X + (size_t)row * D + idx) = (f32x4){0.f, 0.f, 0.f, 0.f}; } }
            continue; }
        const float* src = X + (size_t)row * D; float* dsto = nullptr;
        if (MODE != 0) {
            if (row < SROW0) { const int b = row / TP, t = row % TP;
                if (MODE == 1) src = t < 16 ? p.in[6] + (size_t)t * D : p.in[0] + ((size_t)b * 8192 + (t - 16)) * D;
                else dsto = t < 16 ? nullptr : p.out + O_YP + ((size_t)b * 8192 + (t - 16)) * D;
            } else { const int r = row - SROW0; if (MODE == 1) src = p.in[1] + (size_t)r * D; else dsto = p.out + O_YS + (size_t)r * D; }
            if (MODE == 2 && dsto == nullptr) continue;
        }
        f32x4 v[8]; float ss = 0.f;
#pragma unroll
        for (int q = 0; q < 8; ++q) v[q] = *(const f32x4*)(src + 4 * lane + 256 * q);
        if (MODE != 1 && ndp > 0 && gridDim.x == 256) {
            const int pm = row >> 8, rl = row & 255;
#pragma unroll 1
            for (int j = 0; j < 16; ++j) { int upm, upn; unit_of(512 + j, MP / 256, 8, upm, upn);
                if (upm == pm) {
                    f32x4 s = {0.f, 0.f, 0.f, 0.f};
                    for (int ks = 0; ks < ndp; ++ks) s = s + *(const f32x4*)((const float*)(p.ws + WS_PART) + (size_t)(j * ndp + ks) * 65536 + rl * 256 + 4 * lane);
#pragma unroll
                    for (int q = 0; q < 8; ++q) if (upn == q) { v[q] = v[q] + s; *(f32x4*)(X + (size_t)row * D + 4 * lane + 256 * q) = v[q]; }
                } }
        }
#pragma unroll
        for (int q = 0; q < 8; ++q) { ss += v[q][0] * v[q][0] + v[q][1] * v[q][1] + v[q][2] * v[q][2] + v[q][3] * v[q][3]; }
#pragma unroll
        for (int o = 1; o < 64; o <<= 1) ss += __shfl_xor(ss, o);
        const float rs = rsqrtf(ss * (1.f / 2048.f) + EPS);
#pragma unroll
        for (int q = 0; q < 8; ++q) { const int idx = 4 * lane + 256 * q; const f32x4 wv = *(const f32x4*)(w + idx); const f32x4 y = v[q] * rs * wv;
            if (MODE == 2) *(f32x4*)(dsto + idx) = y;
            else { u32x2 o; o.x = pk2(y[0], y[1]); o.y = pk2(y[2], y[3]); *(u32x2*)(HN + (size_t)row * D + idx) = o; if (MODE == 1) *(f32x4*)(X + (size_t)row * D + idx) = v[q]; } }
    }
}

template <int MODE>
__device__ __forceinline__ void norm_phase2(const Params& p, const float* w, int ndp) {
    const int tid = fresh_tid(), lane = tid & 63, wid = tid >> 6;
    float* X = (float*)(p.ws + WS_X); bf16_t* HN = (bf16_t*)(p.ws + WS_HN);
    const int stride = gridDim.x * 8;
    for (int row0 = blockIdx.x * 8 + wid; row0 < MP; row0 += 2 * stride) {
        f32x4 v[2][8]; float* dsto[2]; bool act[2];
#pragma unroll
        for (int t = 0; t < 2; ++t) {
            const int row = row0 + t * stride; act[t] = row < MROWS; dsto[t] = nullptr;
            if (MODE == 0 && row >= MROWS && row < MP) {
#pragma unroll
                for (int q = 0; q < 8; ++q) *(u32x2*)(HN + (size_t)row * D + 4 * lane + 256 * q) = (u32x2){0u, 0u}; }
            if (MODE == 2 && act[t]) {
                if (row < SROW0) { const int b = row / TP, tt = row % TP; dsto[t] = tt < 16 ? nullptr : p.out + O_YP + ((size_t)b * 8192 + (tt - 16)) * D; }
                else dsto[t] = p.out + O_YS + (size_t)(row - SROW0) * D;
                act[t] = dsto[t] != nullptr; }
            if (act[t]) {
#pragma unroll
                for (int q = 0; q < 8; ++q) v[t][q] = *(const f32x4*)(X + (size_t)row * D + 4 * lane + 256 * q); }
        }
#pragma unroll
        for (int t = 0; t < 2; ++t) {
            if (!act[t]) continue;
            const int row = row0 + t * stride;
            if (ndp > 0 && gridDim.x == 256) {
                const int pm = row >> 8, rl = row & 255;
#pragma unroll 1
                for (int j = 0; j < 16; ++j) { int upm, upn; unit_of(512 + j, MP / 256, 8, upm, upn);
                    if (upm == pm) {
                        f32x4 s = {0.f, 0.f, 0.f, 0.f};
                        for (int ks = 0; ks < ndp; ++ks) s = s + *(const f32x4*)((const float*)(p.ws + WS_PART) + (size_t)(j * ndp + ks) * 65536 + rl * 256 + 4 * lane);
#pragma unroll
                        for (int q = 0; q < 8; ++q) if (upn == q) { v[t][q] = v[t][q] + s; *(f32x4*)(X + (size_t)row * D + 4 * lane + 256 * q) = v[t][q]; }
                    } }
            }
            float ss = 0.f;
#pragma unroll
            for (int q = 0; q < 8; ++q) ss += v[t][q][0] * v[t][q][0] + v[t][q][1] * v[t][q][1] + v[t][q][2] * v[t][q][2] + v[t][q][3] * v[t][q][3];
#pragma unroll
            for (int o = 1; o < 64; o <<= 1) ss += __shfl_xor(ss, o);
            const float rs = rsqrtf(ss * (1.f / 2048.f) + EPS);
#pragma unroll
            for (int q = 0; q < 8; ++q) { const int idx = 4 * lane + 256 * q; const f32x4 wv = *(const f32x4*)(w + idx); const f32x4 y = v[t][q] * rs * wv;
                if (MODE == 2) *(f32x4*)(dsto[t] + idx) = y;
                else { u32x2 o; o.x = pk2(y[0], y[1]); o.y = pk2(y[2], y[3]); *(u32x2*)(HN + (size_t)row * D + idx) = o; } }
        }
    }
}

struct ChunkGeo { int row0, tok0, valid_lo, samp; };
__device__ __forceinline__ ChunkGeo chunk_geo(int sc) {
    ChunkGeo g;
    if (sc < 258) { const int b = sc / 129, c = sc % 129; g.tok0 = 64 * c - 48; g.row0 = b * TP + g.tok0; g.valid_lo = c == 0 ? 48 : 0; g.samp = -1; }
    else { const int s = sc - 258; g.tok0 = -48; g.row0 = SROW0 + 16 * s - 48; g.valid_lo = 48; g.samp = s; }
    return g;
}

__device__ __forceinline__ void gdn_item(const Params& p, int l, int sc, int h, unsigned char* shm, bool taps_lds) {
    const int tid = fresh_tid(), L = tid & 63, w = tid >> 6;
    bf16_t* qs = (bf16_t*)shm; bf16_t* ks = (bf16_t*)(shm + 17408); float* sol = (float*)(shm + 34816); float* Lm = (float*)(shm + 100352); float* qkm = (float*)(shm + 116736);
    float* gcs = (float*)(shm + 134144); float* betas = gcs + 64; float* egcs = gcs + 128;
    const ChunkGeo G = chunk_geo(sc);
    const bf16_t* PROJ = (const bf16_t*)(p.ws + WS_PROJ); const float* BA = (const float*)(p.ws + WS_BA);
    const int item = sc * 8 + h; unsigned char* ib = p.ws + WS_GCH + (size_t)item * 73728;
    if (w == 0) {
        const int i = L; float beta = 0.f, g = 0.f;
        if (i >= G.valid_lo) { const float* ba = BA + (size_t)(G.row0 + i) * 16; beta = sigmoidf_(ba[h]); g = -__expf(p.in[22][l * 8 + h]) * softplusf_(ba[8 + h] + p.in[23][l * 8 + h]); }
#pragma unroll
        for (int o = 1; o < 64; o <<= 1) { const float v = __shfl_up(g, o); if (L >= o) g += v; }
        gcs[i] = g; betas[i] = beta; egcs[i] = __expf(g);
        if (L == 63) ((float*)(p.ws + WS_GE))[item] = __expf(g);
    }
    float pend[6][8];
#pragma unroll
    for (int r = 0; r < 6; ++r) {
        const int e = tid + 512 * r, pos = e / 48, cgi = e % 48, typ = cgi >> 4, c8 = (cgi & 15) * 8, col = typ * 1024 + h * 128 + c8;
        const bool valid = pos >= G.valid_lo;
        float acc[8];
#pragma unroll
        for (int k = 0; k < 8; ++k) acc[k] = 0.f;
        if (valid) {
#pragma unroll
            for (int j = 0; j < 4; ++j) {
                const int m = G.tok0 + pos - 3 + j; float xv[8]; bool have = true;
                if (m >= 0) { const u32x4 raw = *(const u32x4*)(PROJ + (size_t)(G.row0 + pos - 3 + j) * PLD + 2048 + col); unpack8(raw, xv); }
                else if (G.samp >= 0) { const float* sp = p.in[4] + ((size_t)(l * 16 + G.samp) * 3 + (3 + m)) * 3072 + col; const f32x4 a = *(const f32x4*)sp, b = *(const f32x4*)(sp + 4);
                    xv[0] = a[0]; xv[1] = a[1]; xv[2] = a[2]; xv[3] = a[3]; xv[4] = b[0]; xv[5] = b[1]; xv[6] = b[2]; xv[7] = b[3]; }
                else have = false;
                if (have) { f32x4 wa, wb;
                    if (taps_lds) { const float* wq = (const float*)(shm + 135168) + j * 384 + typ * 128 + c8; wa = *(const f32x4*)wq; wb = *(const f32x4*)(wq + 4); }
                    else { const float* wp = p.in[21] + (size_t)(l * 4 + j) * 3072 + col; wa = *(const f32x4*)wp; wb = *(const f32x4*)(wp + 4); }
                    acc[0] += xv[0] * wa[0]; acc[1] += xv[1] * wa[1]; acc[2] += xv[2] * wa[2]; acc[3] += xv[3] * wa[3];
                    acc[4] += xv[4] * wb[0]; acc[5] += xv[5] * wb[1]; acc[6] += xv[6] * wb[2]; acc[7] += xv[7] * wb[3]; }
            }
        }
        float ss = 0.f;
#pragma unroll
        for (int k = 0; k < 8; ++k) { acc[k] = siluf_(acc[k]); ss += acc[k] * acc[k]; }
        ss += __shfl_xor(ss, 1); ss += __shfl_xor(ss, 2); ss += __shfl_xor(ss, 4); ss += __shfl_xor(ss, 8);
        if (typ < 2) { const float scl = rsqrtf(ss + EPS) * (typ == 0 ? 0.08838834764831845f : 1.f);
#pragma unroll
            for (int k = 0; k < 8; ++k) acc[k] *= scl;
            *(u32x4*)((typ == 0 ? qs : ks) + pos * 136 + c8) = pack8(acc);
        }
#pragma unroll
        for (int k = 0; k < 8; ++k) pend[r][k] = acc[k];
    }
    __syncthreads();
#pragma unroll
    for (int r = 0; r < 6; ++r) {
        const int e = tid + 512 * r, pos = e / 48, cgi = e % 48, typ = cgi >> 4, c8 = (cgi & 15) * 8;
        if (typ >= 1) { const float f = typ == 1 ? betas[pos] * egcs[pos] : betas[pos]; float* d = sol + pos * 256 + (typ == 1 ? 128 : 0) + c8;
            *(f32x4*)d = (f32x4){f * pend[r][0], f * pend[r][1], f * pend[r][2], f * pend[r][3]}; *(f32x4*)(d + 4) = (f32x4){f * pend[r][4], f * pend[r][5], f * pend[r][6], f * pend[r][7]}; }
    }
    {
        const int mat = w >> 2, mt = w & 3, lr = L & 15, lq = L >> 4;
        const bf16_t* Asrc = mat ? qs : ks; bf16x8 a[4];
#pragma unroll
        for (int s = 0; s < 4; ++s) a[s] = *(const bf16x8*)(Asrc + (16 * mt + lr) * 136 + 32 * s + lq * 8);
#pragma unroll
        for (int nt = 0; nt < 4; ++nt) {
            f32x4 c = {0.f, 0.f, 0.f, 0.f};
#pragma unroll
            for (int s = 0; s < 4; ++s) { const bf16x8 b = *(const bf16x8*)(ks + (16 * nt + lr) * 136 + 32 * s + lq * 8); c = mfma16(a[s], b, c); }
            const int j = 16 * nt + lr; const float gj = gcs[j];
#pragma unroll
            for (int r = 0; r < 4; ++r) { const int i = 16 * mt + lq * 4 + r; const float dec = __expf(fminf(gcs[i] - gj, 0.f));
                if (mat == 0) Lm[i * 64 + j] = (i > j) ? betas[i] * dec * c[r] : 0.f;
                else qkm[i * 68 + j] = (i >= j) ? dec * c[r] : 0.f; }
        }
    }
    __syncthreads();
    {
        const int c = tid & 255; const bool mainw = tid < 256; const int t2 = tid - 256; const float gl = gcs[63];
#define GD_LOAD(ACC, B_) _Pragma("unroll") for (int r = 0; r < 16; ++r) ACC[r] = sol[(16 * (B_) + r) * 256 + c]
#define GD_STORE(ACC, B_) _Pragma("unroll") for (int r = 0; r < 16; ++r) sol[(16 * (B_) + r) * 256 + c] = ACC[r]
#define GD_PAIR(ACC, B_, JB_) do { float xj[16]; _Pragma("unroll") for (int k = 0; k < 16; ++k) xj[k] = sol[(16 * (JB_) + k) * 256 + c]; \
            _Pragma("unroll") for (int r = 0; r < 16; ++r) { const float* lr = Lm + (16 * (B_) + r) * 64 + 16 * (JB_); \
                _Pragma("unroll") for (int k4 = 0; k4 < 4; ++k4) { const f32x4 lv = *(const f32x4*)(lr + 4 * k4); \
                    ACC[r] -= lv[0] * xj[4 * k4]; ACC[r] -= lv[1] * xj[4 * k4 + 1]; ACC[r] -= lv[2] * xj[4 * k4 + 2]; ACC[r] -= lv[3] * xj[4 * k4 + 3]; } } } while (0)
#define GD_DIAG(ACC, B_) do { _Pragma("unroll") for (int r = 1; r < 16; ++r) { const float* lr = Lm + (16 * (B_) + r) * 64 + 16 * (B_); \
                _Pragma("unroll") for (int k4 = 0; k4 < (r + 3) / 4; ++k4) { const f32x4 lv = *(const f32x4*)(lr + 4 * k4); \
                    if (4 * k4 < r) ACC[r] -= lv[0] * ACC[4 * k4]; if (4 * k4 + 1 < r) ACC[r] -= lv[1] * ACC[4 * k4 + 1]; \
                    if (4 * k4 + 2 < r) ACC[r] -= lv[2] * ACC[4 * k4 + 2]; if (4 * k4 + 3 < r) ACC[r] -= lv[3] * ACC[4 * k4 + 3]; } } } while (0)
        float acc[16];
        const int st0 = (G.valid_lo == 48) ? 3 : 0;
#pragma unroll 1
        for (int st = st0; st < 4; ++st) {
            if (mainw) { GD_LOAD(acc, st); if (st > 0) GD_PAIR(acc, st, st - 1); GD_DIAG(acc, st); GD_STORE(acc, st); }
            else { if (st == st0) {
#pragma unroll
        for (int r = 0; r < 4; ++r) {
            const int q = t2 + 256 * r, Lq = q & 63, f = q >> 6, mt = f >> 2, s = f & 3, i = 16 * mt + (Lq & 15), k0 = 32 * s + (Lq >> 4) * 8;
            float v[8]; unpack8(*(const u32x4*)(qs + i * 136 + k0), v); const float e = egcs[i];
#pragma unroll
            for (int k = 0; k < 8; ++k) v[k] *= e;
            *(u32x4*)(ib + 16384 + (size_t)q * 16) = pack8(v); }
#pragma unroll
        for (int r = 0; r < 2; ++r) {
            const int q = t2 + 256 * r, Lq = q & 63, f = q >> 6, mt = f >> 1, s = f & 1, i = 16 * mt + (Lq & 15), j0 = 32 * s + (Lq >> 4) * 8;
            float v[8]; const f32x4 a = *(const f32x4*)(qkm + i * 68 + j0), b = *(const f32x4*)(qkm + i * 68 + j0 + 4);
            v[0] = a[0]; v[1] = a[1]; v[2] = a[2]; v[3] = a[3]; v[4] = b[0]; v[5] = b[1]; v[6] = b[2]; v[7] = b[3];
            *(u32x4*)(ib + 49152 + (size_t)q * 16) = pack8(v); }
            } if (st > 0 && st < 3) {
#pragma unroll 1
                for (int Bp = st + 1; Bp < 4; ++Bp) { GD_LOAD(acc, Bp); GD_PAIR(acc, Bp, st - 1); GD_STORE(acc, Bp); }
            } if (st == 3) {
#pragma unroll
        for (int r = 0; r < 4; ++r) {
            const int q = t2 + 256 * r, Lq = q & 63, f = q >> 6, mt = f >> 1, s = f & 1, dk = 16 * mt + (Lq & 15), j0 = 32 * s + (Lq >> 4) * 8;
            float v[8];
#pragma unroll
            for (int k = 0; k < 8; ++k) v[k] = bf2f(ks[(j0 + k) * 136 + dk]) * __expf(fminf(gl - gcs[j0 + k], 0.f));
            *(u32x4*)(ib + 32768 + (size_t)q * 16) = pack8(v); }
            } }
            if (st < 3) __syncthreads();
        }
#undef GD_LOAD
#undef GD_STORE
#undef GD_PAIR
#undef GD_DIAG
    }
    __syncthreads();
#pragma unroll
    for (int r = 0; r < 2; ++r) {
        const int q = tid + 512 * r, Lq = q & 63, f = q >> 6, mt = f >> 2, s = f & 3, i = 16 * mt + (Lq & 15), k0 = 32 * s + (Lq >> 4) * 8;
        float v[8]; const f32x4 a = *(const f32x4*)(sol + i * 256 + 128 + k0), b = *(const f32x4*)(sol + i * 256 + 128 + k0 + 4);
        v[0] = a[0]; v[1] = a[1]; v[2] = a[2]; v[3] = a[3]; v[4] = b[0]; v[5] = b[1]; v[6] = b[2]; v[7] = b[3];
        *(u32x4*)(ib + (size_t)q * 16) = pack8(v); }
#pragma unroll
    for (int r = 0; r < 4; ++r) {
        const int q = tid + 512 * r, Lq = q & 63, f = q >> 6, mt = f >> 3, ntile = f & 7, i0 = 16 * mt + (Lq >> 4) * 4, cc = 16 * ntile + (Lq & 15);
        u32x2 o; o.x = pk2(sol[i0 * 256 + cc], sol[(i0 + 1) * 256 + cc]); o.y = pk2(sol[(i0 + 2) * 256 + cc], sol[(i0 + 3) * 256 + cc]);
        *(u32x2*)(ib + 57344 + (size_t)q * 8) = o; }
    __syncthreads();
}

__device__ __forceinline__ void lru_item(const Params& p, int l, int sc, int n, unsigned char* shm) {
    const int tid = fresh_tid(), L = tid & 63, w = tid >> 6;
    bf16_t* xs = (bf16_t*)shm; float* xf = (float*)(shm + 9216); float* gr = (float*)(shm + 25856);
    const ChunkGeo G = chunk_geo(sc);
    const bf16_t* PROJ = (const bf16_t*)(p.ws + WS_PROJ);
    const int g_ = w >> 2, nt_ = w & 3, lr_ = L & 15, lq_ = L >> 4;
    bf16x8 bfr[2];
    { const bf16_t* WG = (const bf16_t*)(p.ws + WS_WG) + (size_t)(n * 2 + g_) * 4096;
#pragma unroll
        for (int s = 0; s < 2; ++s) bfr[s] = *(const bf16x8*)(WG + (16 * nt_ + lr_) * 64 + 32 * s + lq_ * 8); }
    const float bias_ = p.in[g_ ? 18 : 16][l * 1024 + n * 64 + 16 * nt_ + lr_];
    const float lam_ = p.in[19][l * 1024 + n * 64 + (tid & 63)];
    {
        const int pos = tid >> 3, cgi = tid & 7, ch0 = n * 64 + cgi * 8; float acc[8];
        { const float* bp = p.in[14] + l * 1024 + ch0; const f32x4 a = *(const f32x4*)bp, b = *(const f32x4*)(bp + 4);
            acc[0] = a[0]; acc[1] = a[1]; acc[2] = a[2]; acc[3] = a[3]; acc[4] = b[0]; acc[5] = b[1]; acc[6] = b[2]; acc[7] = b[3]; }
        if (pos >= G.valid_lo) {
#pragma unroll
            for (int j = 0; j < 4; ++j) {
                const int m = G.tok0 + pos - 3 + j; float xv[8]; bool have = true;
                if (m >= 0) { unpack8(*(const u32x4*)(PROJ + (size_t)(G.row0 + pos - 3 + j) * PLD + ch0), xv); }
                else if (G.samp >= 0) { const float* sp = p.in[2] + ((size_t)(l * 16 + G.samp) * 3 + (3 + m)) * 1024 + ch0; const f32x4 a = *(const f32x4*)sp, b = *(const f32x4*)(sp + 4);
                    xv[0] = a[0]; xv[1] = a[1]; xv[2] = a[2]; xv[3] = a[3]; xv[4] = b[0]; xv[5] = b[1]; xv[6] = b[2]; xv[7] = b[3]; }
                else have = false;
                if (have) { const float* wp = p.in[13] + (size_t)(l * 4 + j) * 1024 + ch0; const f32x4 wa = *(const f32x4*)wp, wb = *(const f32x4*)(wp + 4);
                    acc[0] += xv[0] * wa[0]; acc[1] += xv[1] * wa[1]; acc[2] += xv[2] * wa[2]; acc[3] += xv[3] * wa[3];
                    acc[4] += xv[4] * wb[0]; acc[5] += xv[5] * wb[1]; acc[6] += xv[6] * wb[2]; acc[7] += xv[7] * wb[3]; }
            }
        }
        *(u32x4*)(xs + pos * 72 + cgi * 8) = pack8(acc);
#pragma unroll
        for (int k = 0; k < 8; ++k) xf[pos * 65 + cgi * 8 + k] = acc[k];
    }
    __syncthreads();
    {
        const int g = g_, nt = nt_, lr = lr_, lq = lq_;
#pragma unroll
        for (int mt = 0; mt < 4; ++mt) {
            f32x4 c = {0.f, 0.f, 0.f, 0.f};
#pragma unroll
            for (int s = 0; s < 2; ++s) { const bf16x8 a = *(const bf16x8*)(xs + (16 * mt + lr) * 72 + 32 * s + lq * 8); c = mfma16(a, bfr[s], c); }
#pragma unroll
            for (int r = 0; r < 4; ++r) gr[g * 4160 + (16 * mt + lq * 4 + r) * 65 + 16 * nt + lr] = sigmoidf_(c[r] + bias_);
        }
    }
    __syncthreads();
    {
        const int ch = tid & 63; const float sp = softplusf_(-lam_);
#pragma unroll
        for (int k = 0; k < 8; ++k) { const int tok = (tid >> 6) + 8 * k, o = tok * 65 + ch;
            const float r = gr[o], ig = gr[4160 + o], x = xf[o]; const float la = -8.f * r * sp; float a = __expf(la); float bb = sqrtf(fmaxf(-expm1f(2.f * la), 0.f)) * ig * x;
            if (tok < G.valid_lo) { a = 1.f; bb = 0.f; }
            gr[o] = a; gr[4160 + o] = bb; }
    }
    __syncthreads();
    {
        const int ch = L; float A = 1.f, hh = 0.f, hs[8], As[8];
#pragma unroll
        for (int k = 0; k < 8; ++k) { const int tok = 8 * w + k; const float a = gr[tok * 65 + ch], b2 = gr[4160 + tok * 65 + ch]; hh = a * hh + b2; A *= a; hs[k] = hh; As[k] = A; }
        xf[w * 64 + ch] = A; xf[512 + w * 64 + ch] = hh;
        __syncthreads();
        float cA = 1.f, cH = 0.f;
#pragma unroll
        for (int j = 0; j < 7; ++j) { if (j < w) { const float sa = xf[j * 64 + ch], sh = xf[512 + j * 64 + ch]; cH = sa * cH + sh; cA *= sa; } }
        float* HL = p.out + OS_HL; bf16_t* AC = (bf16_t*)(p.out + OS_AC);
#pragma unroll
        for (int k = 0; k < 8; ++k) { const int tok = 8 * w + k; const float ht = hs[k] + As[k] * cH, At = As[k] * cA;
            if (tok >= G.valid_lo) { const size_t o = (size_t)(G.row0 + tok) * 1024 + n * 64 + ch; HL[o] = ht; AC[o] = (bf16_t)(pk2(At, 0.f) & 0xffffu); }
            if (w == 7 && k == 7) { ((float*)(p.ws + WS_ACH))[sc * 1024 + n * 64 + ch] = At; ((float*)(p.ws + WS_BCH))[sc * 1024 + n * 64 + ch] = ht; } }
    }
    __syncthreads();
}

struct Frags { bf16x8 a1[4]; bf16x8 a2[2]; bf16x8 ke[2]; u32x2 u[2]; float ge; };
__device__ __forceinline__ void chain_load(Frags& f, const unsigned char* ib, const float* GE, int item, int role, int mt, int w, int d, int L) {
    const unsigned char* a1b = ib + (role ? 16384 : 0);
#pragma unroll
    for (int s = 0; s < 4; ++s) f.a1[s] = *(const bf16x8*)(a1b + (size_t)((mt * 4 + s) * 64 + L) * 16);
    if (role) {
#pragma unroll
        for (int s = 0; s < 2; ++s) f.a2[s] = *(const bf16x8*)(ib + 49152 + (size_t)((mt * 2 + s) * 64 + L) * 16);
    } else {
#pragma unroll
        for (int nt = 0; nt < 2; ++nt) f.u[nt] = *(const u32x2*)(ib + 57344 + (size_t)((mt * 8 + 2 * d + nt) * 64 + L) * 8);
    }
#pragma unroll
    for (int s = 0; s < 2; ++s) f.ke[s] = *(const bf16x8*)(ib + 32768 + (size_t)((w * 2 + s) * 64 + L) * 16);
    f.ge = GE[item];
}
__device__ __forceinline__ void chain_step(const Frags& f, f32x4 (&S)[2], unsigned char* St, unsigned char* wt, int role, int mt, int w, int L, float* Orow, int valid_lo) {
    const int lr = L & 15, lq = L >> 4;
    f32x4 acc[2]; acc[0] = (f32x4){0.f, 0.f, 0.f, 0.f}; acc[1] = acc[0];
#pragma unroll
    for (int s = 0; s < 4; ++s)
#pragma unroll
        for (int nt = 0; nt < 2; ++nt) { const bf16x8 b = *(const bf16x8*)(St + (16 * nt + lr) * 272 + (32 * s + lq * 8) * 2); acc[nt] = mfma16(f.a1[s], b, acc[nt]); }
    if (!role) {
#pragma unroll
        for (int nt = 0; nt < 2; ++nt) { u32x2 o; o.x = pk2(bflo(f.u[nt].x) - acc[nt][0], bfhi(f.u[nt].x) - acc[nt][1]); o.y = pk2(bflo(f.u[nt].y) - acc[nt][2], bfhi(f.u[nt].y) - acc[nt][3]);
            *(u32x2*)(wt + (16 * nt + lr) * 144 + (16 * mt + lq * 4) * 2) = o; }
    }
    __syncthreads();
    bf16x8 bw[2][2];
#pragma unroll
    for (int nt = 0; nt < 2; ++nt)
#pragma unroll
        for (int s = 0; s < 2; ++s) bw[nt][s] = *(const bf16x8*)(wt + (16 * nt + lr) * 144 + (32 * s + lq * 8) * 2);
    if (role) {
#pragma unroll
        for (int nt = 0; nt < 2; ++nt) {
#pragma unroll
            for (int s = 0; s < 2; ++s) acc[nt] = mfma16(f.a2[s], bw[nt][s], acc[nt]);
#pragma unroll
            for (int r = 0; r < 4; ++r) { const int i = 16 * mt + lq * 4 + r; if (i >= valid_lo) Orow[(ptrdiff_t)i * 1024 + 16 * nt + lr] = acc[nt][r]; } }
    }
#pragma unroll
    for (int nt = 0; nt < 2; ++nt) { S[nt] = S[nt] * f.ge;
#pragma unroll
        for (int s = 0; s < 2; ++s) S[nt] = mfma16(f.ke[s], bw[nt][s], S[nt]);
        u32x2 o; o.x = pk2(S[nt][0], S[nt][1]); o.y = pk2(S[nt][2], S[nt][3]);
        *(u32x2*)(St + (16 * nt + lr) * 272 + (16 * w + lq * 4) * 2) = o; }
    __syncthreads();
}
__device__ __forceinline__ void gdn_chain(const Params& p, int l, int stream, int h, int d, unsigned char* shm) {
    const int tid = fresh_tid(), L = tid & 63, w = tid >> 6, role = w >> 2, mt = w & 3, lr = L & 15, lq = L >> 4;
    const bool samp = stream >= 2; const int s = stream - 2;
    const int sc0 = samp ? 258 + s : stream * 129, nsteps = samp ? 1 : 129;
    unsigned char* St = shm; unsigned char* wt = shm + 8704;
    const float* GE = (const float*)(p.ws + WS_GE);
    float* O = (float*)(p.ws + WS_HN);
    f32x4 S[2];
#pragma unroll
    for (int nt = 0; nt < 2; ++nt)
#pragma unroll
        for (int r = 0; r < 4; ++r) S[nt][r] = samp ? p.in[5][((size_t)((l * 16 + s) * 8 + h) * 128 + 16 * w + lq * 4 + r) * 128 + 32 * d + 16 * nt + lr] : 0.f;
#pragma unroll
    for (int nt = 0; nt < 2; ++nt) { u32x2 o; o.x = pk2(S[nt][0], S[nt][1]); o.y = pk2(S[nt][2], S[nt][3]); *(u32x2*)(St + (16 * nt + lr) * 272 + (16 * w + lq * 4) * 2) = o; }
    Frags fa, fb;
    const unsigned char* gch = p.ws + WS_GCH;
    chain_load(fa, gch + (size_t)(sc0 * 8 + h) * 73728, GE, sc0 * 8 + h, role, mt, w, d, L);
    __syncthreads();
    const ptrdiff_t rbase = samp ? (ptrdiff_t)(SROW0 + 16 * s - 48) : (ptrdiff_t)(stream * TP - 48);
    for (int c = 0; c < nsteps; c += 2) {
        if (c + 1 < nsteps) { const int it = (sc0 + c + 1) * 8 + h; chain_load(fb, gch + (size_t)it * 73728, GE, it, role, mt, w, d, L); }
        chain_step(fa, S, St, wt, role, mt, w, L, O + (rbase + 64 * c) * 1024 + h * 128 + 32 * d, (c == 0) ? 48 : 0);
        if (c + 1 < nsteps) {
            if (c + 2 < nsteps) { const int it = (sc0 + c + 2) * 8 + h; chain_load(fa, gch + (size_t)it * 73728, GE, it, role, mt, w, d, L); }
            chain_step(fb, S, St, wt, role, mt, w, L, O + (rbase + 64 * (c + 1)) * 1024 + h * 128 + 32 * d, 0);
        }
    }
    float* dst = p.out + (samp ? O_SDL + (size_t)((l * 16 + s) * 8 + h) * 16384 : O_PDL + (size_t)((l * 2 + stream) * 8 + h) * 16384);
#pragma unroll
    for (int nt = 0; nt < 2; ++nt)
#pragma unroll
        for (int r = 0; r < 4; ++r) dst[(size_t)(16 * w + lq * 4 + r) * 128 + 32 * d + 16 * nt + lr] = S[nt][r];
}
__device__ __forceinline__ void chain_phase(const Params& p, int l, unsigned char* shm) {
    const int bid = blockIdx.x;
    if (bid < 64) { const int pair = (bid & 7) * 2 + ((bid >> 3) >> 2), d = (bid >> 3) & 3; gdn_chain(p, l, pair >> 3, pair & 7, d, shm);
#if REP_MASK & 0x8000
        __syncthreads(); gdn_chain(p, l, pair >> 3, pair & 7, d, shm);
#endif
        return; }
#if REP_MASK & 0x10000
    for (int rr = 0; rr < 2; ++rr) {
#else
    {
#endif
    const int r = bid - 64, nr = gridDim.x - 64;
    const float* ACH = (const float*)(p.ws + WS_ACH); const float* BCH = (const float*)(p.ws + WS_BCH); float* CARRY = (float*)(p.ws + WS_CARRY);
    for (int g = r * 512 + fresh_tid(); g < 16384; g += nr * 512) { const int s = g >> 10, ch = g & 1023; CARRY[(size_t)(258 + s) * 1024 + ch] = p.in[3][(size_t)(l * 16 + s) * 1024 + ch]; }
    for (int q = r; q < 512; q += nr) { const int pair = q >> 2, d = q & 3; gdn_chain(p, l, 2 + (pair >> 3), pair & 7, d, shm); }
    __syncthreads();
    for (int li = LRU_KEEP + r; li < NSC * 16; li += nr) lru_item(p, l, li >> 4, li & 15, shm);
    unsigned* cnt = (unsigned*)(p.ws + WS_BAR) + 3600 + 64 * l;
    __syncthreads();
    if (threadIdx.x == 0) { __threadfence(); __hip_atomic_fetch_add(cnt, 1u, __ATOMIC_RELAXED, __HIP_MEMORY_SCOPE_AGENT); }
    if (r < 4) {
        if (threadIdx.x == 0) { unsigned sp = 0; while (__hip_atomic_load(cnt, __ATOMIC_RELAXED, __HIP_MEMORY_SCOPE_AGENT) < (unsigned)nr && ++sp < (1u << 22)) __builtin_amdgcn_s_sleep(2); __threadfence(); }
        __syncthreads();
        const int g = r * 512 + fresh_tid(), b2 = g >> 10, ch = g & 1023; float carry = 0.f;
#pragma unroll 1
        for (int c0 = 0; c0 < 129; c0 += 16) {
            float av[16], bv[16];
#pragma unroll
            for (int k = 0; k < 16; ++k) { const int c = (c0 + k < 129) ? c0 + k : 128; const size_t o = (size_t)(b2 * 129 + c) * 1024 + ch; av[k] = ACH[o]; bv[k] = BCH[o]; }
#pragma unroll
            for (int k = 0; k < 16; ++k) if (c0 + k < 129) { CARRY[(size_t)(b2 * 129 + c0 + k) * 1024 + ch] = carry; carry = av[k] * carry + bv[k]; }
        }
    }
    }
}

__device__ __forceinline__ void mix_out_phase(const Params& p, int l) {
    const int tid = fresh_tid(), lane = tid & 63, wid = tid >> 6;
    bf16_t* HN = (bf16_t*)(p.ws + WS_HN); const bf16_t* PROJ = (const bf16_t*)(p.ws + WS_PROJ);
    const float* HL = p.out + OS_HL; const bf16_t* AC = (const bf16_t*)(p.out + OS_AC); const float* CARRY = (const float*)(p.ws + WS_CARRY);
    for (int row = blockIdx.x * 8 + wid; row < MROWS; row += gridDim.x * 8) {
        int sc, t, T, stream; bool samp = row >= SROW0;
        if (!samp) { stream = row / TP; t = row % TP; T = TP; sc = stream * 129 + (t + 48) / 64; }
        else { const int r = row - SROW0; stream = r >> 4; t = r & 15; T = 16; sc = 258 + stream; }
        const float* Orow = (const float*)(HN + (size_t)row * D);
        f32x4 o4[4], h4[4]; float ssA = 0.f, ssB[4];
#pragma unroll
        for (int q = 0; q < 4; ++q) { const int idx = 4 * lane + 256 * q; o4[q] = *(const f32x4*)(Orow + idx);
            const f32x4 hl = *(const f32x4*)(HL + (size_t)row * 1024 + idx); const u32x2 ac = *(const u32x2*)(AC + (size_t)row * 1024 + idx); const f32x4 ci = *(const f32x4*)(CARRY + (size_t)sc * 1024 + idx);
            h4[q][0] = hl[0] + bflo(ac.x) * ci[0]; h4[q][1] = hl[1] + bfhi(ac.x) * ci[1]; h4[q][2] = hl[2] + bflo(ac.y) * ci[2]; h4[q][3] = hl[3] + bfhi(ac.y) * ci[3];
#if TEST_SKIP == 1 || TEST_SKIP == 3
            h4[q] = (f32x4){0.f, 0.f, 0.f, 0.f};
#elif TEST_SKIP == 2
            o4[q] = (f32x4){0.f, 0.f, 0.f, 0.f};
#endif
            ssA += h4[q][0] * h4[q][0] + h4[q][1] * h4[q][1] + h4[q][2] * h4[q][2] + h4[q][3] * h4[q][3];
            ssB[q] = o4[q][0] * o4[q][0] + o4[q][1] * o4[q][1] + o4[q][2] * o4[q][2] + o4[q][3] * o4[q][3]; }
#pragma unroll
        for (int o = 1; o < 64; o <<= 1) ssA += __shfl_xor(ssA, o);
#pragma unroll
        for (int q = 0; q < 4; ++q) {
#pragma unroll
            for (int o = 1; o < 32; o <<= 1) ssB[q] += __shfl_xor(ssB[q], o); }
        const float rsA = rsqrtf(ssA * (1.f / 1024.f) + EPS);
        u32x2 ga[4], zz[4];
#pragma unroll
        for (int q = 0; q < 4; ++q) { const int idx = 4 * lane + 256 * q; ga[q] = *(const u32x2*)(PROJ + (size_t)row * PLD + 1024 + idx); zz[q] = *(const u32x2*)(PROJ + (size_t)row * PLD + 5120 + idx); }
        asm volatile("s_waitcnt vmcnt(0)" ::: "memory");
#pragma unroll
        for (int q = 0; q < 4; ++q) { const int idx = 4 * lane + 256 * q;
            const f32x4 na = *(const f32x4*)(p.in[20] + l * 1024 + idx); const f32x4 nb = *(const f32x4*)(p.in[24] + l * 128 + (idx & 127));
            const float rsB = rsqrtf(ssB[q] * (1.f / 128.f) + EPS);
            const float g0 = gelu_tanh(bflo(ga[q].x)), g1 = gelu_tanh(bfhi(ga[q].x)), g2 = gelu_tanh(bflo(ga[q].y)), g3 = gelu_tanh(bfhi(ga[q].y));
            u32x2 ya; ya.x = pk2(h4[q][0] * rsA * na[0] * g0, h4[q][1] * rsA * na[1] * g1); ya.y = pk2(h4[q][2] * rsA * na[2] * g2, h4[q][3] * rsA * na[3] * g3);
            const float z0 = siluf_(bflo(zz[q].x)), z1 = siluf_(bfhi(zz[q].x)), z2 = siluf_(bflo(zz[q].y)), z3 = siluf_(bfhi(zz[q].y));
            u32x2 yb; yb.x = pk2(o4[q][0] * rsB * nb[0] * z0, o4[q][1] * rsB * nb[1] * z1); yb.y = pk2(o4[q][2] * rsB * nb[2] * z2, o4[q][3] * rsB * nb[3] * z3);
#if TEST_SKIP == 3
            yb.x = pk2(o4[q][0], o4[q][1]); yb.y = pk2(o4[q][2], o4[q][3]);
#endif
            *(u32x2*)(HN + (size_t)row * D + idx) = ya; *(u32x2*)(HN + (size_t)row * D + 1024 + idx) = yb; }
        if (t >= T - 3) {
            const int j = t - (T - 3);
            float* lru = p.out + (samp ? O_SLRU + (size_t)(l * 16 + stream) * 1024 : O_PLRU + (size_t)(l * 2 + stream) * 1024);
            float* ca = p.out + (samp ? O_SCA + ((size_t)(l * 16 + stream) * 3 + j) * 1024 : O_PCA + ((size_t)(l * 2 + stream) * 3 + j) * 1024);
            float* cb = p.out + (samp ? O_SCB + ((size_t)(l * 16 + stream) * 3 + j) * 3072 : O_PCB + ((size_t)(l * 2 + stream) * 3 + j) * 3072);
#pragma unroll
            for (int q = 0; q < 4; ++q) { const int idx = 4 * lane + 256 * q; if (t == T - 1) *(f32x4*)(lru + idx) = h4[q];
                const u32x2 v = *(const u32x2*)(PROJ + (size_t)row * PLD + idx); *(f32x4*)(ca + idx) = (f32x4){bflo(v.x), bfhi(v.x), bflo(v.y), bfhi(v.y)}; }
#pragma unroll
            for (int q = 0; q < 12; ++q) { const int idx = 4 * lane + 256 * q; const u32x2 v = *(const u32x2*)(PROJ + (size_t)row * PLD + 2048 + idx);
                *(f32x4*)(cb + idx) = (f32x4){bflo(v.x), bfhi(v.x), bflo(v.y), bfhi(v.y)}; }
        }
    }
}

#define XB_TMO      128
#define XB_XCNT(j)  (256  + 64 * (j))
#define XB_XSUB(j)  (1280 + 64 * (j))
#define XB_XGEN(j)  (2304 + 64 * (j))
#define XB_TOP      3328
#define XB_TOPGEN   3392
#define XCD_BAR_WORDS 3456
#define XB_SPIN_CAP (1u << 18)
#define XB_LAS __attribute__((address_space(3)))

__device__ __forceinline__ unsigned xb_ld(unsigned* p)              { return __hip_atomic_load(p, __ATOMIC_RELAXED, __HIP_MEMORY_SCOPE_AGENT); }
__device__ __forceinline__ unsigned xb_add(unsigned* p, unsigned v) { return __hip_atomic_fetch_add(p, v, __ATOMIC_RELAXED, __HIP_MEMORY_SCOPE_AGENT); }
__device__ __forceinline__ unsigned xb_xcc_id() { return (unsigned)__builtin_amdgcn_s_getreg((3 << 11) | 20) & 0xFu; }
#define XB_SPIN(cond, bar) do { unsigned _sp = 0; while (cond) { __builtin_amdgcn_s_sleep(1); \
    if ((++_sp & 255u) == 0u) { if (xb_ld(&(bar)[XB_TMO])) break; if (_sp > XB_SPIN_CAP) { atomicAdd(&(bar)[XB_TMO], 1u); break; } } } } while (0)

struct XcdBarrier {
    unsigned* bar; unsigned x;
    volatile XB_LAS unsigned* st;
};

__device__ __forceinline__ XcdBarrier xcd_barrier_post(unsigned* bar, volatile XB_LAS unsigned* st) {
    XcdBarrier b; b.bar = bar; b.x = xb_xcc_id(); b.st = st;
    if (threadIdx.x == 0) (void)xb_add(&bar[XB_XCNT(b.x)], 1u);
    return b;
}
__device__ __forceinline__ void xcd_barrier_complete(unsigned* bar, unsigned x, unsigned& nloc, unsigned& nx) {
    const unsigned G = gridDim.x * gridDim.y * gridDim.z;
    unsigned sum, cnt, mine, sp = 0u;
    for (;;) {
        sum = 0u; cnt = 0u; mine = 0u;
#pragma unroll
        for (unsigned j = 0; j < 16; ++j) { const unsigned c = xb_ld(&bar[XB_XCNT(j)]); sum += c; cnt += (c > 0u) ? 1u : 0u; mine = (j == x) ? c : mine; }
        if (sum == G) break;
        __builtin_amdgcn_s_sleep(1);
        if ((++sp & 255u) == 0u) { if (xb_ld(&bar[XB_TMO])) break; if (sp > XB_SPIN_CAP) { atomicAdd(&bar[XB_TMO], 1u); break; } }
    }
    nloc = mine > 0u ? mine : 1u; nx = cnt > 0u ? cnt : 1u;
}

__device__ __forceinline__ void xcd_barrier(const XcdBarrier& b) {
    asm volatile("s_waitcnt vmcnt(0)" ::: "memory");
    __syncthreads();
    if (threadIdx.x == 0) {
        unsigned* bar = b.bar;
        __builtin_amdgcn_s_waitcnt(0);
        unsigned nloc = b.st[0], nx = b.st[1];
        if (nloc == 0u) { xcd_barrier_complete(bar, b.x, nloc, nx); b.st[0] = nloc; b.st[1] = nx; }
        const unsigned old = xb_add(&bar[XB_XSUB(b.x)], 1u);
        const unsigned gen = old / nloc;
        if (old + 1u == (gen + 1u) * nloc) {
            __builtin_amdgcn_fence(__ATOMIC_RELEASE, "agent");
            asm volatile("s_waitcnt vmcnt(0)" ::: "memory");
            const unsigned og = xb_add(&bar[XB_TOP], 1u);
            const unsigned tg = og / nx;
            if (og + 1u == (tg + 1u) * nx) xb_add(&bar[XB_TOPGEN], 1u);
            else XB_SPIN(xb_ld(&bar[XB_TOPGEN]) == tg, bar);
            __builtin_amdgcn_fence(__ATOMIC_ACQUIRE, "agent");
            xb_add(&bar[XB_XGEN(b.x)], 1u);
            asm volatile("s_waitcnt vmcnt(0)" ::: "memory");
        } else {
            XB_SPIN(xb_ld(&bar[XB_XGEN(b.x)]) == gen, bar);
            __builtin_amdgcn_fence(__ATOMIC_ACQUIRE, "agent");
            asm volatile("s_waitcnt vmcnt(0)" ::: "memory");
        }
    }
    __syncthreads();
}

struct SchedAll {
    pg8::StaticOrder so; int mode, nkt_full, nM, nN, nsplit, G, c;
    __device__ __forceinline__ void init(int M, int N, int K, int G_, int c_, int mode_) {
        mode = mode_; nkt_full = K / 64; nM = M / 256; nN = N / 256; G = G_; c = c_; so.init(M, N, G_, c_);
        nsplit = (K == DFF) ? 11 : 8;
    }
    __device__ __forceinline__ bool next(int i, pg8::Unit& u) const {
        const int nwg = nM * nN, nfull = nwg / G;
        if (!mode || i < nfull) { if (!so.next(i, u)) return false; u.kt0 = 0; u.nkt = nkt_full; u.part = 0; return true; }
        if (i > nfull) return false;
        const int left = nwg - nfull * G;
        if (c >= left * nsplit) return false;
        const int j = c / nsplit, ks = c - j * nsplit;
        unit_of(nfull * G + j, nM, nN, u.pm, u.pn); u.nkt = nkt_full / nsplit; u.kt0 = ks * u.nkt; u.part = 1; return true;
    }
    __device__ __forceinline__ void a_ready(const pg8::Unit&) const {}
    __device__ __forceinline__ void done(const pg8::Unit&) const {}
};
template <class Epi> __device__ __forceinline__ void run_gemm_sk(unsigned char* shm, const bf16_t* A, const bf16_t* Bt, int N, int K, const Epi& E, int mode, int fake = 0) {
    pg8::Gemm g; g.A = A; g.Bt = Bt; g.M = MP; g.N = N; g.K = K; g.fake = fake;
    SchedAll S; S.init(MP, N, K, (int)gridDim.x, (int)blockIdx.x, mode);
    pg8::gemm_phase<Epi, SchedAll, false>((PG8_LAS unsigned char*)shm, g, S, E, nullptr);
}
template <class Epi> __device__ __forceinline__ void run_gemm(unsigned char* shm, const bf16_t* A, const bf16_t* Bt, int N, int K, const Epi& E) {
    pg8::Gemm g; g.A = A; g.Bt = Bt; g.M = MP; g.N = N; g.K = K; g.fake = 0;
    pg8::StaticOrder S; S.init(MP, N, (int)gridDim.x, (int)blockIdx.x);
    pg8::gemm_phase<Epi, pg8::StaticOrder, false>((PG8_LAS unsigned char*)shm, g, S, E, nullptr);
}

__global__ void __launch_bounds__(512, 2) mega(Params p) {
    extern __shared__ __attribute__((aligned(16))) unsigned char shm[];
    bf16_t* HN = (bf16_t*)(p.ws + WS_HN); bf16_t* HID = (bf16_t*)(p.ws + WS_PROJ); float* X = (float*)(p.ws + WS_X);
#if N_LAUNCH_MODE == 1
    volatile XB_LAS unsigned* xbw = (volatile XB_LAS unsigned*)(shm + LDS_BYTES - 16);
    if (threadIdx.x == 0) { xbw[0] = 0u; xbw[1] = 0u; }
    __syncthreads();
    const XcdBarrier xb = xcd_barrier_post((unsigned*)(p.ws + WS_BAR), xbw);
#endif
    for (int ph = p.ph_lo; ph < p.ph_hi; ++ph) {
        const int l = ph / 12, kind = (ph == 24) ? 12 : ph % 12;
#if REP_MASK
        for (int rep = 0; rep < (((REP_MASK) >> kind) & 1 ? 2 : 1); ++rep) {
        if (rep) { __threadfence(); cg::this_grid().sync(); }
#endif
        if (PH_ON(0) && kind == 0) { prep_phase(p, l, (float*)shm); if (l == 0) norm_phase<1>(p, p.in[7], 0); else norm_phase2<0>(p, p.in[7] + l * D, 11); }
        else if (PH_ON(1) && (kind == 1 || kind == 10 || kind == 2 || kind == 11 || kind == 8 || kind == 4)) {
            EpiAll E; E.mode = (kind == 1 || kind == 10) ? 0 : (kind == 4 ? 2 : 1); E.Ob = (E.mode == 0) ? HID : (bf16_t*)(p.ws + WS_PROJ); E.Of = X; E.BA = (float*)(p.ws + WS_BA); E.scale = kind == 8 ? 1.f : 0.5f;
            E.PART = (float*)(p.ws + WS_PART) + (size_t)blockIdx.x * 65536;
#if REP_MASK
            if (((REP_MASK) >> kind) & 1) E.scale *= 0.5f;
#endif
            const bf16_t* A = (kind == 2 || kind == 11) ? HID : HN;
            size_t wo; int N, K;
            if (kind == 1) { wo = WS_WGU1; N = NGU; K = D; } else if (kind == 10) { wo = WS_WGU2; N = NGU; K = D; } else if (kind == 2) { wo = WS_WD1; N = D; K = DFF; }
            else if (kind == 11) { wo = WS_WD2; N = D; K = DFF; } else if (kind == 8) { wo = WS_WOUT; N = D; K = D; } else { wo = WS_WIN; N = NINP; K = D; }
#if REP_MASK
            if (rep) { E.mode = 3; run_gemm_sk(shm, A, (const bf16_t*)(p.ws + wo), N, K, E, 0, PROBE_FAKE); } else
#endif
            run_gemm_sk(shm, A, (const bf16_t*)(p.ws + wo), N, K, E, (E.mode == 1 && gridDim.x == 256) ? 1 : 0); }
        else if (PH_ON(3) && kind == 3) norm_phase2<0>(p, p.in[11] + l * D, 11);
        else if (PH_ON(3) && kind == 9) norm_phase2<0>(p, p.in[26] + l * D, 8);
        else if (PH_ON(5) && kind == 5) {
            const bool taps = (gridDim.x & 7u) == 0u;
            if (taps) { const int hh = blockIdx.x & 7; float* wl = (float*)(shm + 135168);
                for (int i = fresh_tid(); i < 1536; i += 512) { const int j = i / 384, rem = i - j * 384, typ = rem >> 7, cc = rem & 127; wl[i] = p.in[21][(size_t)(l * 4 + j) * 3072 + typ * 1024 + hh * 128 + cc]; }
                __syncthreads(); }
            for (int it = blockIdx.x; it < NSC * 8 + LRU_KEEP; it += gridDim.x) {
                if (it < NSC * 8) gdn_item(p, l, it >> 3, it & 7, shm, taps);
                else { const int r = it - NSC * 8; lru_item(p, l, r >> 4, r & 15, shm); } }
        }
        else if (PH_ON(6) && kind == 6) chain_phase(p, l, shm);
        else if (PH_ON(7) && kind == 7) mix_out_phase(p, l);
        else if (PH_ON(12) && kind == 12) norm_phase2<2>(p, p.in[30], 11);
#if REP_MASK
        }
#endif
#if N_LAUNCH_MODE == 1
        if (ph + 1 < p.ph_hi) { if (p.ph_hi > 1000) cg::this_grid().sync(); else xcd_barrier(xb); }
#else
        if (ph + 1 < p.ph_hi) cg::this_grid().sync();
#endif
    }
}

extern "C" void kernel_launch(void* const* d_in, const int* in_sizes, int n_in, void* d_out, int out_size, void* d_ws, size_t ws_size, hipStream_t stream) {
    static int grid = 0;
    if (grid == 0) {
        if (n_in != 31 || ws_size < WS_END) { fprintf(stderr, "kernel_launch: unexpected n_in %d or ws_size %zu (need %zu)\n", n_in, ws_size, (size_t)WS_END); grid = -1; return; }
        int dev = 0, cus = 0, per_cu = 0;
        hipGetDevice(&dev); hipDeviceGetAttribute(&cus, hipDeviceAttributeMultiprocessorCount, dev);
        if (hipFuncSetAttribute((const void*)mega, hipFuncAttributeMaxDynamicSharedMemorySize, LDS_BYTES) != hipSuccess) { fprintf(stderr, "kernel_launch: hipFuncSetAttribute failed\n"); grid = -1; return; }
        if (hipOccupancyMaxActiveBlocksPerMultiprocessor(&per_cu, (const void*)mega, 512, LDS_BYTES) != hipSuccess || per_cu < 1) { fprintf(stderr, "kernel_launch: occupancy query says %d\n", per_cu); per_cu = 1; }
        (void)hipGetLastError();
        grid = cus;
        if (grid < 128) { fprintf(stderr, "kernel_launch: only %d CUs\n", grid); grid = -1; return; }
    }
    if (grid < 0) return;
    Params p{};
#if TEST_MEMSET
    (void)hipMemsetAsync((unsigned char*)d_ws + WS_X, 0, WS_END - WS_X, stream);
#endif
    for (int i = 0; i < 31; ++i) p.in[i] = (const float*)d_in[i];
    p.out = (float*)d_out; p.ws = (unsigned char*)d_ws;
#if N_LAUNCH_MODE == 1
    p.ph_lo = 0; p.ph_hi = 25;
    (void)hipMemsetAsync((unsigned char*)d_ws + WS_BAR, 0, 16384, stream);
    void* args[] = {&p};
    hipError_t e = hipLaunchCooperativeKernel((const void*)mega, dim3(grid), dim3(512), args, LDS_BYTES, stream);
    if (e != hipSuccess) fprintf(stderr, "cooperative launch failed: %s (grid %d)\n", hipGetErrorString(e), grid);
#else
    for (int ph = 0; ph < 25; ++ph) { p.ph_lo = ph; p.ph_hi = ph + 1; hipLaunchKernelGGL(mega, dim3(grid), dim3(512), LDS_BYTES, stream, p); }
#endif
}
```
